# Optimizing an MI355X kernel written in HIP

```python
import jax, jax.numpy as jnp
from jax import lax
import numpy as np

D_MODEL = 1024
BATCH = 2
SEQ = 16384
DEPTH = 2

EPS = 1e-6
ROPE_THETA = 500000.0
POOL_GROUPS = 4
POOL_WINDOWS = (2, 4, 8, 16)
POOL_GROUP_DIM = D_MODEL // 8
POOL_WIDTH = POOL_GROUPS * POOL_GROUP_DIM
NSA_HEADS = D_MODEL // 128
NSA_KV_GROUPS = 2
NSA_HEAD_DIM = 64
NSA_ROT_DIM = NSA_HEAD_DIM // 4
NSA_WIDTH = NSA_HEADS * NSA_HEAD_DIM
NSA_KV_WIDTH = NSA_KV_GROUPS * NSA_HEAD_DIM
CMP_BLOCK = 32
CMP_STRIDE = 16
SEL_BLOCK = 64
SEL_TOPK = 16
WINDOW = 512
Q_BLOCK = 128
GLA_HEADS = 4
GLA_DK = D_MODEL // 16
GLA_DV = D_MODEL // 8
GLA_GATE_RANK = 16
GLA_TAU = 16.0
GLA_CHUNK = 64
GLA_WIDTH = GLA_HEADS * GLA_DV
N_BRANCHES = 3
BRANCH_WIDTH = D_MODEL // 2
D_FF = 4 * D_MODEL
PLE_DIM = 256
IN_SIZES = (POOL_WIDTH, NSA_WIDTH, 6 * NSA_KV_WIDTH, 3 * NSA_HEADS, GLA_HEADS * GLA_DK, GLA_HEADS * GLA_DK, GLA_WIDTH, GLA_GATE_RANK, GLA_WIDTH, N_BRANCHES * D_MODEL)
IN_WIDTH = sum(IN_SIZES)

kernel_name = "hybrid_pool_nsa_gla_gated_merge"


def rmsnorm(x, g):
    xf = x.astype(jnp.float32)
    y = xf * lax.rsqrt(jnp.mean(xf * xf, axis=-1, keepdims=True) + EPS)
    return (y * g.astype(jnp.float32)).astype(x.dtype)


def partial_rope(x, positions):
    half = NSA_ROT_DIM // 2
    inv_freq = jnp.power(ROPE_THETA, -jnp.arange(half, dtype=jnp.float32) * (2.0 / NSA_ROT_DIM))
    ang = positions.astype(jnp.float32)[..., None] * inv_freq
    cos = jnp.cos(ang)[:, :, None, :]
    sin = jnp.sin(ang)[:, :, None, :]
    xr = x[..., :NSA_ROT_DIM].astype(jnp.float32)
    x1, x2 = xr[..., :half], xr[..., half:]
    rot = jnp.concatenate([x1 * cos - x2 * sin, x2 * cos + x1 * sin], axis=-1).astype(x.dtype)
    return jnp.concatenate([rot, x[..., NSA_ROT_DIM:]], axis=-1)


def masked_softmax(s, mask):
    s = jnp.where(mask, s.astype(jnp.float32), -jnp.inf)
    m = jnp.max(s, axis=-1, keepdims=True)
    m = jnp.where(jnp.isfinite(m), m, 0.0)
    e = jnp.exp(s - m)
    return e / jnp.maximum(jnp.sum(e, axis=-1, keepdims=True), 1e-30)


def pool_mixer(u, w_pool, scale):
    B, S, _ = u.shape
    ug = u.reshape(B, S, POOL_GROUPS, POOL_GROUP_DIM).astype(jnp.float32)
    cs = jnp.concatenate([jnp.zeros_like(ug[:, :1]), jnp.cumsum(ug, axis=1)], axis=1)
    t = jnp.arange(S)
    win = jnp.array(POOL_WINDOWS, dtype=jnp.int32)
    start = jnp.maximum(t[:, None] + 1 - win[None, :], 0)
    cnt = (t[:, None] + 1 - start).astype(jnp.float32)
    g_idx = jnp.arange(POOL_GROUPS)[None, :]
    lower = cs[:, start, g_idx, :]
    pooled = (cs[:, 1:] - lower) / cnt[None, :, :, None] - ug
    y = jnp.einsum('bsgc,gcd->bsgd', pooled, w_pool.astype(jnp.float32))
    y = y * scale.astype(jnp.float32).reshape(POOL_GROUPS, POOL_GROUP_DIM)
    return y.reshape(B, S, POOL_WIDTH).astype(u.dtype)


def nsa_mixer(q, kv, gate_logits, positions, cmp_pos_k, cmp_w_k, cmp_pos_v, cmp_w_v):
    B, S, _ = q.shape
    H, G, Dh = NSA_HEADS, NSA_KV_GROUPS, NSA_HEAD_DIM
    HG = H // G
    dt = q.dtype
    q = partial_rope(q.reshape(B, S, H, Dh), positions) * (Dh ** -0.5)
    kv = kv.reshape(B, S, 6, G, Dh)
    kc = partial_rope(kv[:, :, 0], positions)
    vc = kv[:, :, 1]
    ks = partial_rope(kv[:, :, 2], positions)
    vs = kv[:, :, 3]
    kw = partial_rope(kv[:, :, 4], positions)
    vw = kv[:, :, 5]

    n_cmp = (S - CMP_BLOCK) // CMP_STRIDE + 1
    blk_start = jnp.arange(n_cmp) * CMP_STRIDE
    idx = blk_start[:, None] + jnp.arange(CMP_BLOCK)[None, :]

    def compress(t, pos, w):
        blk = t[:, idx] + pos[None, None, :, None, :]
        blk = jnp.moveaxis(blk, 3, 2).reshape(B, n_cmp, G, CMP_BLOCK * Dh)
        return jnp.einsum('bngf,fd->bngd', blk, w)

    kc_cmp = compress(kc, cmp_pos_k, cmp_w_k)
    vc_cmp = compress(vc, cmp_pos_v, cmp_w_v)
    cmp_end = blk_start + CMP_BLOCK - 1

    n_sel = S // SEL_BLOCK
    sel_start = jnp.arange(n_sel) * SEL_BLOCK
    overlap = ((blk_start[:, None] < sel_start[None, :] + SEL_BLOCK) & (blk_start[:, None] + CMP_BLOCK > sel_start[None, :])).astype(jnp.float32)
    top_k = min(SEL_TOPK, n_sel)

    ks_g = ks.transpose(0, 2, 1, 3)
    vs_g = vs.transpose(0, 2, 1, 3)
    kw_pad = jnp.pad(kw, ((0, 0), (WINDOW, 0), (0, 0), (0, 0)))
    vw_pad = jnp.pad(vw, ((0, 0), (WINDOW, 0), (0, 0), (0, 0)))
    gates = jax.nn.sigmoid(gate_logits.astype(jnp.float32)).astype(dt).reshape(B, S, H, 3)
    j_sel = jnp.arange(n_sel)
    n_keys = top_k * SEL_BLOCK

    def query_block(qb):
        t0 = qb * Q_BLOCK
        qblk = lax.dynamic_slice_in_dim(q, t0, Q_BLOCK, axis=1).reshape(B, Q_BLOCK, G, HG, Dh)
        tq = t0 + jnp.arange(Q_BLOCK)
        s = jnp.einsum('bqghd,bngd->bghqn', qblk, kc_cmp)
        p_cmp = masked_softmax(s, cmp_end[None, :] <= tq[:, None])
        o_cmp = jnp.einsum('bghqn,bngd->bqghd', p_cmp.astype(dt), vc_cmp)
        imp = jnp.einsum('bghqn,nj->bgqj', p_cmp, overlap)
        cur = tq // SEL_BLOCK
        valid = j_sel[None, :] <= cur[:, None]
        forced = (j_sel[None, :] == 0) | (j_sel[None, :] == cur[:, None]) | (j_sel[None, :] == cur[:, None] - 1)
        score = jnp.where(forced, jnp.inf, jnp.where(valid, imp, -jnp.inf))
        _, sel = lax.top_k(score, top_k)
        tok = (sel[..., None] * SEL_BLOCK + jnp.arange(SEL_BLOCK)).reshape(B, G, Q_BLOCK * n_keys)
        k_sel = jnp.take_along_axis(ks_g, tok[..., None], axis=2).reshape(B, G, Q_BLOCK, n_keys, Dh)
        v_sel = jnp.take_along_axis(vs_g, tok[..., None], axis=2).reshape(B, G, Q_BLOCK, n_keys, Dh)
        tok_r = tok.reshape(B, G, Q_BLOCK, n_keys)
        s = jnp.einsum('bqghd,bgqkd->bghqk', qblk, k_sel)
        p_slc = masked_softmax(s, (tok_r <= tq[:, None])[:, :, None])
        o_slc = jnp.einsum('bghqk,bgqkd->bqghd', p_slc.astype(dt), v_sel)
        kwb = lax.dynamic_slice_in_dim(kw_pad, t0, Q_BLOCK + WINDOW, axis=1)
        vwb = lax.dynamic_slice_in_dim(vw_pad, t0, Q_BLOCK + WINDOW, axis=1)
        kpos = t0 - WINDOW + jnp.arange(Q_BLOCK + WINDOW)
        diff = tq[:, None] - kpos[None, :]
        wmask = (diff >= 0) & (diff < WINDOW) & (kpos[None, :] >= 0)
        s = jnp.einsum('bqghd,bkgd->bghqk', qblk, kwb)
        o_win = jnp.einsum('bghqk,bkgd->bqghd', masked_softmax(s, wmask).astype(dt), vwb)
        g = lax.dynamic_slice_in_dim(gates, t0, Q_BLOCK, axis=1).reshape(B, Q_BLOCK, G, HG, 3)
        o = g[..., 0:1] * o_cmp + g[..., 1:2] * o_slc + g[..., 2:3] * o_win
        return o.reshape(B, Q_BLOCK, H * Dh)

    out = lax.map(query_block, jnp.arange(S // Q_BLOCK))
    return out.transpose(1, 0, 2, 3).reshape(B, S, NSA_WIDTH)


def gla_mixer(q, k, v, gate_low, r, w_gate2, b_gate, norm_g):
    B, S, _ = q.shape
    H, Dk, Dv, C = GLA_HEADS, GLA_DK, GLA_DV, GLA_CHUNK
    nC = S // C
    f32 = jnp.float32
    z = jnp.einsum('bsr,rd->bsd', gate_low, w_gate2) + b_gate
    log_a = (jax.nn.log_sigmoid(z.astype(f32)) / GLA_TAU).reshape(B, nC, C, H, Dk)
    bcum = jnp.cumsum(log_a, axis=2)
    b_last = bcum[:, :, -1]
    qf = q.astype(f32).reshape(B, nC, C, H, Dk) * (Dk ** -0.5)
    kf = k.astype(f32).reshape(B, nC, C, H, Dk)
    vf = v.astype(f32).reshape(B, nC, C, H, Dv)
    q_s = qf * jnp.exp(bcum)
    k_s = kf * jnp.exp(-bcum)
    k_t = kf * jnp.exp(b_last[:, :, None] - bcum)
    causal = jnp.tril(jnp.ones((C, C), dtype=bool))
    A = jnp.where(causal, jnp.einsum('bnihd,bnjhd->bnhij', q_s, k_s), 0.0)
    o_intra = jnp.einsum('bnhij,bnjhv->bnihv', A, vf)

    def step(state, xs):
        qn, kn, vn, bl = xs
        o = jnp.einsum('bihd,bhdv->bihv', qn, state)
        state = state * jnp.exp(bl)[..., None] + jnp.einsum('bjhd,bjhv->bhdv', kn, vn)
        return state, o

    xs = (jnp.moveaxis(q_s, 1, 0), jnp.moveaxis(k_t, 1, 0), jnp.moveaxis(vf, 1, 0), jnp.moveaxis(b_last, 1, 0))
    _, o_inter = lax.scan(step, jnp.zeros((B, H, Dk, Dv), f32), xs)
    o = (o_intra + jnp.moveaxis(o_inter, 0, 1)).reshape(B, S, H, Dv)
    o = rmsnorm(o, norm_g).reshape(B, S, GLA_WIDTH)
    return (o * jax.nn.silu(r.astype(f32))).astype(q.dtype)


def setup_inputs(seed: int = 0) -> dict:
    key = jax.random.key(seed)
    ks = jax.random.split(key, 24)
    f32 = jnp.float32

    def nrm(k, shape, scale):
        return jax.random.normal(k, shape, f32) * scale

    def gain(k, shape):
        return 1.0 + 0.02 * jax.random.normal(k, shape, f32)

    return {
        "x": nrm(ks[0], (BATCH, SEQ, D_MODEL), 1.0),
        "p": nrm(ks[1], (DEPTH, BATCH, SEQ, PLE_DIM), 1.0),
        "positions": jnp.broadcast_to(jnp.arange(SEQ, dtype=jnp.int32), (BATCH, SEQ)),
        "norm_mix": gain(ks[2], (DEPTH, D_MODEL)),
        "w_in": nrm(ks[3], (DEPTH, D_MODEL, IN_WIDTH), D_MODEL ** -0.5),
        "pool_w": nrm(ks[4], (DEPTH, POOL_GROUPS, POOL_GROUP_DIM, POOL_GROUP_DIM), POOL_GROUP_DIM ** -0.5),
        "pool_scale": gain(ks[5], (DEPTH, POOL_WIDTH)),
        "cmp_pos_k": nrm(ks[6], (DEPTH, CMP_BLOCK, NSA_HEAD_DIM), 0.1),
        "cmp_w_k": nrm(ks[7], (DEPTH, CMP_BLOCK * NSA_HEAD_DIM, NSA_HEAD_DIM), (CMP_BLOCK * NSA_HEAD_DIM) ** -0.5),
        "cmp_pos_v": nrm(ks[8], (DEPTH, CMP_BLOCK, NSA_HEAD_DIM), 0.1),
        "cmp_w_v": nrm(ks[9], (DEPTH, CMP_BLOCK * NSA_HEAD_DIM, NSA_HEAD_DIM), (CMP_BLOCK * NSA_HEAD_DIM) ** -0.5),
        "gla_w_gate": nrm(ks[10], (DEPTH, GLA_GATE_RANK, GLA_HEADS * GLA_DK), GLA_GATE_RANK ** -0.5),
        "gla_b_gate": nrm(ks[11], (DEPTH, GLA_HEADS * GLA_DK), 0.1),
        "gla_norm": gain(ks[12], (DEPTH, GLA_DV)),
        "w_branch": nrm(ks[13], (DEPTH, N_BRANCHES, BRANCH_WIDTH, D_MODEL), BRANCH_WIDTH ** -0.5),
        "w_out": nrm(ks[14], (DEPTH, D_MODEL, D_MODEL), D_MODEL ** -0.5),
        "norm_ffn": gain(ks[15], (DEPTH, D_MODEL)),
        "w_ff1": nrm(ks[16], (DEPTH, D_MODEL, D_FF), D_MODEL ** -0.5),
        "w_ff2": nrm(ks[17], (DEPTH, D_FF, D_MODEL), 0.5 * D_FF ** -0.5),
        "norm_ple": gain(ks[18], (DEPTH, D_MODEL)),
        "w_ple_gate": nrm(ks[19], (DEPTH, D_MODEL, D_MODEL), D_MODEL ** -0.5),
        "w_ple_proj": nrm(ks[20], (DEPTH, PLE_DIM, D_MODEL), PLE_DIM ** -0.5),
        "norm_final": gain(ks[21], (D_MODEL,)),
    }


def reference(x, p, positions, norm_mix, w_in, pool_w, pool_scale, cmp_pos_k, cmp_w_k, cmp_pos_v, cmp_w_v, gla_w_gate, gla_b_gate, gla_norm, w_branch, w_out, norm_ffn, w_ff1, w_ff2, norm_ple, w_ple_gate, w_ple_proj, norm_final):
    B, S, D = x.shape
    h = x
    for i in range(DEPTH):
        a = rmsnorm(h, norm_mix[i])
        proj = jnp.einsum('bsd,df->bsf', a, w_in[i])
        parts = []
        off = 0
        for sz in IN_SIZES:
            parts.append(proj[..., off:off + sz])
            off += sz
        u_pool, q_nsa, kv_nsa, g_nsa, q_gla, k_gla, v_gla, a_gla, r_gla, g_merge = parts

        y_a = pool_mixer(u_pool, pool_w[i], pool_scale[i])
        y_b = nsa_mixer(q_nsa, kv_nsa, g_nsa, positions, cmp_pos_k[i], cmp_w_k[i], cmp_pos_v[i], cmp_w_v[i])
        y_c = gla_mixer(q_gla, k_gla, v_gla, a_gla, r_gla, gla_w_gate[i], gla_b_gate[i], gla_norm[i])

        gm = jax.nn.sigmoid(g_merge.astype(jnp.float32)).astype(x.dtype).reshape(B, S, N_BRANCHES, D)
        merged = gm[:, :, 0] * jnp.einsum('bsw,wd->bsd', y_a, w_branch[i, 0])
        merged = merged + gm[:, :, 1] * jnp.einsum('bsw,wd->bsd', y_b, w_branch[i, 1])
        merged = merged + gm[:, :, 2] * jnp.einsum('bsw,wd->bsd', y_c, w_branch[i, 2])
        h = h + jnp.einsum('bsd,de->bse', merged, w_out[i])

        f = rmsnorm(h, norm_ffn[i])
        f = jnp.square(jax.nn.relu(jnp.einsum('bsd,df->bsf', f, w_ff1[i])))
        h = h + jnp.einsum('bsf,fd->bsd', f, w_ff2[i])

        gate = jax.nn.sigmoid(jnp.einsum('bsd,de->bse', rmsnorm(h, norm_ple[i]), w_ple_gate[i]).astype(jnp.float32)).astype(x.dtype)
        h = h + gate * jnp.einsum('bsk,kd->bsd', p[i], w_ple_proj[i])
    return rmsnorm(h, norm_final)
```

```cpp
#include <hip/hip_runtime.h>
#include <cstdio>
#include <cstdint>
#include <cmath>
namespace pg8 {
#define PG8_LAS __attribute__((address_space(3)))
typedef unsigned short bf16_t;
typedef short bf16x8 __attribute__((ext_vector_type(8)));
typedef float f32x4 __attribute__((ext_vector_type(4)));
typedef unsigned u32x4 __attribute__((ext_vector_type(4)));
constexpr int BM = 256, BK = 64, HALF = 128, HTB = HALF * BK * 2  , STAGE_BYTES = 8 * HTB, NXCD = 8, WGM = 8;

__host__ __device__ __forceinline__ int lds_byte(int r, int c) { const int st = (r >> 4) * 2 + (c >> 5), rr = r & 15, cc = c & 31, ob = rr * 64 + cc * 2; return st * 1024 + (ob ^ (((ob >> 9) & 1) << 5)); }
__host__ __device__ __forceinline__ void stage_rc(int b, int& R, int& C) { const int st = b / 1024, sb = b % 1024, swz = sb ^ (((sb >> 9) & 1) << 5); R = (st >> 1) * 16 + swz / 64; C = (st & 1) * 32 + (swz % 64) / 2; }
__host__ __device__ __forceinline__ int perm32(int rho) { const int n = rho >> 4, i = rho & 15; return 8 * (i >> 2) + 4 * n + (i & 3); }

struct Unit { int pm, pn; };
struct Gemm { const bf16_t* A; const bf16_t* Bt; int M, N, K; };

struct StaticOrder {
    int nM, nN, nwg, G, c;
    __host__ __device__ void init(int M, int N, int G_, int c_) { nM = M / BM; nN = N / BM; nwg = nM * nN; G = G_; c = c_; }
    __host__ __device__ bool next(int i, Unit& u) const {
        const long L = (long)i * G + c; if (L >= nwg) return false;
        int wgid = (int)L; { const int q = nwg / NXCD, r = nwg % NXCD, xcd = wgid % NXCD, off = wgid / NXCD; wgid = (xcd < r ? xcd * (q + 1) : r * (q + 1) + (xcd - r) * q) + off; }
        const int nig = WGM * nN, gid = wgid / nig, fm = gid * WGM, gsz = (nM - fm) < WGM ? (nM - fm) : WGM;
        u.pm = fm + ((wgid % nig) % gsz); u.pn = (wgid % nig) / gsz; return true;
    }
    __device__ __forceinline__ void a_ready(const Unit&) const {}
    __device__ __forceinline__ void done(const Unit&) const {}
};

__device__ __forceinline__ unsigned cvt_pk_bf16(float lo, float hi) { unsigned r; asm volatile("v_cvt_pk_bf16_f32 %0, %1, %2" : "=v"(r) : "v"(lo), "v"(hi)); return r; }
typedef float f32x2 __attribute__((ext_vector_type(2)));
__device__ __forceinline__ f32x2 gelu_pk(f32x2 v) {
    const f32x2 av = __builtin_elementwise_abs(v), d = av * 0.2316418882f + 1.0f;
    f32x2 t; t.x = __builtin_amdgcn_rcpf(d.x); t.y = __builtin_amdgcn_rcpf(d.y);
    f32x2 q = t * 0.5307027145f + (-0.7265760135f); q = q * t + 0.7107068705f; q = q * t + (-0.142248368f); q = q * t + 0.127414796f; q = q * t;
    const f32x2 s = (v * v) * (-0.72134752044f);
    f32x2 e; e.x = __builtin_amdgcn_exp2f(s.x); e.y = __builtin_amdgcn_exp2f(s.y);
    const f32x2 m = v * (q * e), r = v - m;
    f32x2 o; o.x = v.x < 0.f ? m.x : r.x; o.y = v.y < 0.f ? m.y : r.y; return o;
}

template <int ACT  > struct EpiBf16 {
    static constexpr bool PERM = true, AFTER_DRAIN = false; static_assert(ACT == 0 || ACT == 1, "EpiBf16: ACT is 0 (none) or 1 (gelu_pk)");
    bf16_t* O; int ldc; const float* bias; int split_cols; size_t split_stride; float scale0;
    __device__ __forceinline__ void operator()(const f32x4 (&acc)[2][2][4][2], const Unit& u, int wr, int wc, int fr, int fq) const {
        const int row0 = u.pm * BM + wr * 64 + fr; int colt = u.pn * BM; bf16_t* base = O;
        float sc = 1.f; if (split_cols) { const int t = colt / split_cols; base += (size_t)t * split_stride; colt -= t * split_cols; if (t == 0) sc = scale0; }
        const int col0 = colt + wc * 32 + 8 * fq, bcol0 = u.pn * BM + wc * 32 + 8 * fq;
        f32x4 bv[2][2];
#pragma unroll
        for (int bj = 0; bj < 2; ++bj)
#pragma unroll
            for (int n = 0; n < 2; ++n) bv[bj][n] = bias ? *(const f32x4*)(bias + bcol0 + bj * HALF + 4 * n) : (f32x4){0.f, 0.f, 0.f, 0.f};
#pragma unroll
        for (int ai = 0; ai < 2; ++ai)
#pragma unroll
            for (int m = 0; m < 4; ++m) { bf16_t* rowp = base + (size_t)(row0 + ai * HALF + m * 16) * ldc + col0;
#pragma unroll
                for (int bj = 0; bj < 2; ++bj) { f32x4 v0 = acc[ai][bj][m][0] + bv[bj][0], v1 = acc[ai][bj][m][1] + bv[bj][1];
                    if (ACT == 1) { f32x2 a = gelu_pk((f32x2){v0[0], v0[1]}), b = gelu_pk((f32x2){v0[2], v0[3]}), c = gelu_pk((f32x2){v1[0], v1[1]}), d = gelu_pk((f32x2){v1[2], v1[3]});
                        v0 = (f32x4){a.x, a.y, b.x, b.y}; v1 = (f32x4){c.x, c.y, d.x, d.y}; }
                    v0 = v0 * sc; v1 = v1 * sc; u32x4 w; w.x = cvt_pk_bf16(v0[0], v0[1]); w.y = cvt_pk_bf16(v0[2], v0[3]); w.z = cvt_pk_bf16(v1[0], v1[1]); w.w = cvt_pk_bf16(v1[2], v1[3]);
                    *(u32x4*)(rowp + bj * HALF) = w; } }
    }
};
template <class Epi, class Sched, bool ALIGN_EPI = false, bool SP2 = false>
__device__ __forceinline__ void gemm_phase(PG8_LAS unsigned char* lds, const Gemm g, const Sched& S, const Epi& E) {
    int tid_ = threadIdx.x; asm volatile("" : "+v"(tid_));
    const int tid = tid_, wid = __builtin_amdgcn_readfirstlane(tid >> 6), lane = tid & 63, wr = wid >> 2, wc = wid & 3, fr = lane & 15, fq = lane >> 4;
    const int K = g.K, nt = K / BK;
    unsigned voffA[2], voffB[2];
#pragma unroll
    for (int i = 0; i < 2; ++i) { int R, C; stage_rc(tid * 16 + i * 8192, R, C); const int Rb = Epi::PERM ? ((R & ~31) + perm32(R & 31)) : R;
        voffA[i] = (unsigned)(R * K + C) * 2u; voffB[i] = (unsigned)(Rb * K + C) * 2u; }
    const size_t kstep = (size_t)(BK * 2);
    const size_t hstep = (size_t)HALF * K * 2;
    const size_t tstep = 2 * hstep;
    const unsigned ldsw = (unsigned)wid * 1024u;
    const int aoff = lds_byte(wr * 64 + fr, fq * 8), boff = lds_byte(wc * 32 + fr, fq * 8);
#define PG8_SA(b, h) (((b) * 2 + (h)) * HTB)
#define PG8_SB(b, h) ((4 + (b) * 2 + (h)) * HTB)
#define PG8_STAGE(bufoff, gbase, voff) do { _Pragma("unroll") for (int _i = 0; _i < 2; ++_i) \
        __builtin_amdgcn_global_load_lds((const unsigned*)((const char*)(gbase) + (voff)[_i]), (PG8_LAS unsigned*)(lds + (bufoff) + ldsw + _i * 8192), 16, 0, 0); } while (0)
#define PG8_LDA(dst, b, h) do { _Pragma("unroll") for (int m = 0; m < 4; ++m) _Pragma("unroll") for (int k = 0; k < 2; ++k) dst[m][k] = *(const PG8_LAS bf16x8*)(lds + PG8_SA(b, h) + aoff + m * 2048 + k * 1024); } while (0)
#define PG8_LDB(dst, b, h) do { _Pragma("unroll") for (int n = 0; n < 2; ++n) _Pragma("unroll") for (int k = 0; k < 2; ++k) dst[n][k] = *(const PG8_LAS bf16x8*)(lds + PG8_SB(b, h) + boff + n * 2048 + k * 1024); } while (0)
#define PG8_MMA(ai, bj, At, Bt) do { __builtin_amdgcn_s_setprio(1); _Pragma("unroll") for (int m = 0; m < 4; ++m) _Pragma("unroll") for (int n = 0; n < 2; ++n) _Pragma("unroll") for (int k = 0; k < 2; ++k) \
        acc[ai][bj][m][n] = __builtin_amdgcn_mfma_f32_16x16x32_bf16(Bt[n][k], At[m][k], acc[ai][bj][m][n], 0, 0, 0); __builtin_amdgcn_s_setprio(0); } while (0)
#define PG8_WAIT_V(n) asm volatile("s_waitcnt vmcnt(" #n ")" ::: "memory")
#define PG8_WAIT_L(n) asm volatile("s_waitcnt lgkmcnt(" #n ")" ::: "memory")
#define PG8_BAR __builtin_amdgcn_s_barrier()
#define PG8_SCHED __builtin_amdgcn_sched_barrier(0)
    Unit cur, nxt; int ui = 0;
    if (!S.next(0, cur)) return;
    f32x4 acc[2][2][4][2];
#pragma unroll
    for (int a = 0; a < 2; ++a)
#pragma unroll
        for (int b = 0; b < 2; ++b)
#pragma unroll
            for (int m = 0; m < 4; ++m)
#pragma unroll
                for (int n = 0; n < 2; ++n) acc[a][b][m][n] = (f32x4){0.f, 0.f, 0.f, 0.f};
    bf16x8 At[4][2], B0[2][2], B1[2][2];
    const char* cA = (const char*)g.A + (size_t)cur.pm * tstep; const char* cB = (const char*)g.Bt + (size_t)cur.pn * tstep;
    S.a_ready(cur);
    if constexpr (SP2) {
        PG8_STAGE(PG8_SB(0, 0), cB, voffB); PG8_STAGE(PG8_SB(0, 1), cB + hstep, voffB); PG8_STAGE(PG8_SA(0, 0), cA, voffA); PG8_STAGE(PG8_SA(0, 1), cA + hstep, voffA);
        if (wr == 1) PG8_BAR;
        PG8_WAIT_V(2); PG8_BAR;
        PG8_STAGE(PG8_SB(1, 0), cB + kstep, voffB); PG8_STAGE(PG8_SA(1, 0), cA + kstep, voffA); PG8_STAGE(PG8_SB(1, 1), cB + hstep + kstep, voffB);
        PG8_WAIT_V(6); PG8_BAR;
    } else {
        PG8_STAGE(PG8_SB(0, 0), cB, voffB); PG8_STAGE(PG8_SA(0, 0), cA, voffA); PG8_STAGE(PG8_SB(0, 1), cB + hstep, voffB); PG8_STAGE(PG8_SA(0, 1), cA + hstep, voffA);
        if (wr == 1) PG8_BAR;
        PG8_WAIT_V(4); PG8_BAR;
        PG8_STAGE(PG8_SB(1, 0), cB + kstep, voffB); PG8_STAGE(PG8_SA(1, 0), cA + kstep, voffA); PG8_STAGE(PG8_SB(1, 1), cB + hstep + kstep, voffB);
        PG8_WAIT_V(6); PG8_BAR;
    }
    for (;;) {
        const bool has_next = S.next(ui + 1, nxt);
        const char* nA = has_next ? (const char*)g.A + (size_t)nxt.pm * tstep : cA; const char* nB = has_next ? (const char*)g.Bt + (size_t)nxt.pn * tstep : cB;
        for (int t = 0; t < nt; t += 2) {
            const bool last = (t == nt - 2);
            const char* a1 = cA + (size_t)(t + 1) * kstep;
            const char* a2 = last ? nA : cA + (size_t)(t + 2) * kstep; const char* b2 = last ? nB : cB + (size_t)(t + 2) * kstep;
            const char* a3 = a2 + kstep; const char* b3 = b2 + kstep;
            if (last && has_next) S.a_ready(nxt);
            if constexpr (SP2) {
            PG8_LDB(B0, 0, 0); PG8_LDB(B1, 0, 1); PG8_SCHED; PG8_LDA(At, 0, 0); PG8_STAGE(PG8_SA(1, 1), a1 + hstep, voffA);
            PG8_WAIT_V(8); PG8_WAIT_L(0); PG8_BAR; PG8_MMA(0, 0, At, B0); PG8_MMA(0, 1, At, B1); PG8_BAR; PG8_SCHED;
            PG8_LDA(At, 0, 1); PG8_STAGE(PG8_SB(0, 0), b2, voffB); PG8_STAGE(PG8_SB(0, 1), b2 + hstep, voffB); PG8_STAGE(PG8_SA(0, 0), a2, voffA);
            PG8_WAIT_V(8); PG8_WAIT_L(0); PG8_BAR; PG8_MMA(1, 0, At, B0); PG8_MMA(1, 1, At, B1); PG8_BAR; PG8_SCHED;
            PG8_LDB(B0, 1, 0); PG8_LDB(B1, 1, 1); PG8_SCHED; PG8_LDA(At, 1, 0); PG8_STAGE(PG8_SA(0, 1), a2 + hstep, voffA);
            PG8_WAIT_V(8); PG8_WAIT_L(0); PG8_BAR; PG8_MMA(0, 0, At, B0); PG8_MMA(0, 1, At, B1); PG8_BAR; PG8_SCHED;
            PG8_LDA(At, 1, 1); PG8_STAGE(PG8_SB(1, 0), b3, voffB); PG8_STAGE(PG8_SB(1, 1), b3 + hstep, voffB); PG8_STAGE(PG8_SA(1, 0), a3, voffA);
            PG8_WAIT_V(8); PG8_WAIT_L(0); PG8_BAR; PG8_MMA(1, 0, At, B0); PG8_MMA(1, 1, At, B1); PG8_BAR; PG8_SCHED;
            } else {
            PG8_LDB(B0, 0, 0); PG8_SCHED; PG8_LDA(At, 0, 0); PG8_STAGE(PG8_SA(1, 1), a1 + hstep, voffA);
            PG8_WAIT_L(8); PG8_BAR; PG8_WAIT_L(0); PG8_MMA(0, 0, At, B0); PG8_BAR; PG8_SCHED;
            PG8_LDB(B1, 0, 1); PG8_STAGE(PG8_SB(0, 0), b2, voffB);
            PG8_BAR; PG8_WAIT_L(0); PG8_MMA(0, 1, At, B1); PG8_BAR;
            PG8_LDA(At, 0, 1); PG8_STAGE(PG8_SA(0, 0), a2, voffA);
            PG8_BAR; PG8_WAIT_L(0); PG8_MMA(1, 0, At, B0); PG8_BAR; PG8_SCHED;
            PG8_STAGE(PG8_SB(0, 1), b2 + hstep, voffB);
            PG8_WAIT_V(6); PG8_BAR; PG8_MMA(1, 1, At, B1); PG8_BAR;
            PG8_LDB(B0, 1, 0); PG8_SCHED; PG8_LDA(At, 1, 0); PG8_STAGE(PG8_SA(0, 1), a2 + hstep, voffA);
            PG8_WAIT_L(8); PG8_BAR; PG8_WAIT_L(0); PG8_MMA(0, 0, At, B0); PG8_BAR; PG8_SCHED;
            PG8_LDB(B1, 1, 1); PG8_STAGE(PG8_SB(1, 0), b3, voffB);
            PG8_BAR; PG8_WAIT_L(0); PG8_MMA(0, 1, At, B1); PG8_BAR;
            PG8_LDA(At, 1, 1); PG8_STAGE(PG8_SA(1, 0), a3, voffA);
            PG8_BAR; PG8_WAIT_L(0); PG8_MMA(1, 0, At, B0); PG8_BAR; PG8_SCHED;
            PG8_STAGE(PG8_SB(1, 1), b3 + hstep, voffB);
            PG8_WAIT_V(6); PG8_BAR; PG8_MMA(1, 1, At, B1); PG8_BAR;
            }
        }
        if constexpr (ALIGN_EPI) { if (wr == 0) PG8_BAR; }
        if constexpr (!Epi::AFTER_DRAIN) { E(acc, cur, wr, wc, fr, fq); S.done(cur); }
        if (!has_next) break;
#pragma unroll
        for (int a = 0; a < 2; ++a)
#pragma unroll
            for (int b = 0; b < 2; ++b)
#pragma unroll
                for (int m = 0; m < 4; ++m)
#pragma unroll
                    for (int n = 0; n < 2; ++n) acc[a][b][m][n] = (f32x4){0.f, 0.f, 0.f, 0.f};
        cur = nxt; cA = nA; cB = nB; ++ui;
        if constexpr (ALIGN_EPI) { if (wr == 1) PG8_BAR; }
    }
    PG8_WAIT_V(0);
    if constexpr (!ALIGN_EPI) { if (wr == 0) PG8_BAR; }
    PG8_BAR;
    if constexpr (Epi::AFTER_DRAIN) { E.fused(acc, cur, wr, wc, fr, fq, lds, wid, lane); S.done(cur); }
#undef PG8_SA
#undef PG8_SB
#undef PG8_STAGE
#undef PG8_LDA
#undef PG8_LDB
#undef PG8_MMA
#undef PG8_WAIT_V
#undef PG8_WAIT_L
#undef PG8_BAR
#undef PG8_SCHED
}
}
namespace pg8 {
typedef unsigned u32x2 __attribute__((ext_vector_type(2)));
__device__ __forceinline__ float bf_lo(unsigned w) { return __builtin_bit_cast(float, w << 16); }
__device__ __forceinline__ float bf_hi(unsigned w) { return __builtin_bit_cast(float, w & 0xffff0000u); }
__device__ __forceinline__ float sigm(float x) { return 1.0f / (1.0f + __expf(-x)); }

struct EpiProj {
    static constexpr bool PERM = true, AFTER_DRAIN = false;
    bf16_t *U, *Q, *KV, *QKG, *VG, *RG; float* SMALL; const float* rope;
    __device__ __forceinline__ void operator()(const f32x4 (&acc)[2][2][4][2], const Unit& u, int wr, int wc, int fr, int fq) const {
        const int pn = u.pn, row0 = u.pm * BM + wr * 64 + fr;
        if (pn == 13) {
            if (wc < 2) {
#pragma unroll
                for (int ai = 0; ai < 2; ++ai)
#pragma unroll
                    for (int m = 0; m < 4; ++m) { float* rp = SMALL + (size_t)(row0 + ai * HALF + m * 16) * 64 + wc * 32 + 8 * fq;
                        *(f32x4*)rp = acc[ai][0][m][0]; *(f32x4*)(rp + 4) = acc[ai][0][m][1]; }
            }
            return;
        }
        bf16_t* base; int ld, colt; bool isq = false, iskv = false;
        if (pn < 2) { base = U; ld = 512; colt = pn * 256; }
        else if (pn < 4) { base = Q; ld = 512; colt = (pn - 2) * 256; isq = true; }
        else if (pn < 7) { base = KV; ld = 768; colt = (pn - 4) * 256; iskv = true; }
        else if (pn < 9) { base = QKG; ld = 512; colt = (pn - 7) * 256; }
        else if (pn < 11) { base = VG; ld = 512; colt = (pn - 9) * 256; }
        else { base = RG; ld = 512; colt = (pn - 11) * 256; }
        const int col0 = colt + wc * 32 + 8 * fq;
        const float sc = isq ? 0.125f : 1.0f;
        const bool ropew = (isq || iskv) && ((wc & 1) == 0);
#pragma unroll
        for (int ai = 0; ai < 2; ++ai)
#pragma unroll
            for (int m = 0; m < 4; ++m) {
                const int row = row0 + ai * HALF + m * 16;
                bf16_t* rowp = base + (size_t)row * ld + col0;
#pragma unroll
                for (int bj = 0; bj < 2; ++bj) {
                    f32x4 v0 = acc[ai][bj][m][0], v1 = acc[ai][bj][m][1];
                    if (ropew && (isq || bj == 0)) {
                        f32x4 o0, o1;
#pragma unroll
                        for (int e = 0; e < 4; ++e) { o0[e] = __shfl_xor(v0[e], 16); o1[e] = __shfl_xor(v1[e], 16); }
                        if (fq < 2) {
                            const f32x4 c0 = *(const f32x4*)(rope + (size_t)row * 16), c1 = *(const f32x4*)(rope + (size_t)row * 16 + 4);
                            const f32x4 s0 = *(const f32x4*)(rope + (size_t)row * 16 + 8), s1 = *(const f32x4*)(rope + (size_t)row * 16 + 12);
                            const float sg = (fq == 0) ? -1.0f : 1.0f;
                            v0 = v0 * c0 + (o0 * s0) * sg; v1 = v1 * c1 + (o1 * s1) * sg;
                        }
                    }
                    v0 = v0 * sc; v1 = v1 * sc;
                    u32x4 w; w.x = cvt_pk_bf16(v0[0], v0[1]); w.y = cvt_pk_bf16(v0[2], v0[3]); w.z = cvt_pk_bf16(v1[0], v1[1]); w.w = cvt_pk_bf16(v1[2], v1[3]);
                    *(u32x4*)(rowp + bj * HALF) = w;
                }
            }
    }
};

template <int FN> struct EpiAct {
    static constexpr bool PERM = true, AFTER_DRAIN = false;
    bf16_t* O; int ldc;
    __device__ __forceinline__ void operator()(const f32x4 (&acc)[2][2][4][2], const Unit& u, int wr, int wc, int fr, int fq) const {
        const int row0 = u.pm * BM + wr * 64 + fr, col0 = u.pn * BM + wc * 32 + 8 * fq;
#pragma unroll
        for (int ai = 0; ai < 2; ++ai)
#pragma unroll
            for (int m = 0; m < 4; ++m) { bf16_t* rowp = O + (size_t)(row0 + ai * HALF + m * 16) * ldc + col0;
#pragma unroll
                for (int bj = 0; bj < 2; ++bj) { f32x4 v0 = acc[ai][bj][m][0], v1 = acc[ai][bj][m][1];
                    if (FN == 1) {
#pragma unroll
                        for (int e = 0; e < 4; ++e) { v0[e] = sigm(v0[e]); v1[e] = sigm(v1[e]); } }
                    if (FN == 2) {
#pragma unroll
                        for (int e = 0; e < 4; ++e) { const float a = fmaxf(v0[e], 0.f), b = fmaxf(v1[e], 0.f); v0[e] = a * a; v1[e] = b * b; } }
                    u32x4 w; w.x = cvt_pk_bf16(v0[0], v0[1]); w.y = cvt_pk_bf16(v0[2], v0[3]); w.z = cvt_pk_bf16(v1[0], v1[1]); w.w = cvt_pk_bf16(v1[2], v1[3]);
                    *(u32x4*)(rowp + bj * HALF) = w; } }
    }
};

template <bool FIRST> struct EpiBranch {
    static constexpr bool PERM = true, AFTER_DRAIN = false;
    bf16_t* MG; const bf16_t* GM; int kofs;
    __device__ __forceinline__ void operator()(const f32x4 (&acc)[2][2][4][2], const Unit& u, int wr, int wc, int fr, int fq) const {
        const int row0 = u.pm * BM + wr * 64 + fr, col0 = u.pn * BM + wc * 32 + 8 * fq;
#pragma unroll
        for (int ai = 0; ai < 2; ++ai)
#pragma unroll
            for (int m = 0; m < 4; ++m) { const size_t row = (size_t)(row0 + ai * HALF + m * 16);
#pragma unroll
                for (int bj = 0; bj < 2; ++bj) {
                    const u32x4 gw = *(const u32x4*)(GM + row * 3072 + kofs + col0 + bj * HALF);
                    f32x4 v0 = acc[ai][bj][m][0], v1 = acc[ai][bj][m][1];
                    v0[0] *= bf_lo(gw.x); v0[1] *= bf_hi(gw.x); v0[2] *= bf_lo(gw.y); v0[3] *= bf_hi(gw.y);
                    v1[0] *= bf_lo(gw.z); v1[1] *= bf_hi(gw.z); v1[2] *= bf_lo(gw.w); v1[3] *= bf_hi(gw.w);
                    bf16_t* op = MG + row * 1024 + col0 + bj * HALF;
                    if (!FIRST) { const u32x4 ow = *(const u32x4*)op;
                        v0[0] += bf_lo(ow.x); v0[1] += bf_hi(ow.x); v0[2] += bf_lo(ow.y); v0[3] += bf_hi(ow.y);
                        v1[0] += bf_lo(ow.z); v1[1] += bf_hi(ow.z); v1[2] += bf_lo(ow.w); v1[3] += bf_hi(ow.w); }
                    u32x4 w; w.x = cvt_pk_bf16(v0[0], v0[1]); w.y = cvt_pk_bf16(v0[2], v0[3]); w.z = cvt_pk_bf16(v1[0], v1[1]); w.w = cvt_pk_bf16(v1[2], v1[3]);
                    *(u32x4*)op = w; } }
    }
};

struct EpiRes {
    static constexpr bool PERM = false, AFTER_DRAIN = false;
    const float* in; float* out;
    __device__ __forceinline__ void operator()(const f32x4 (&acc)[2][2][4][2], const Unit& u, int wr, int wc, int fr, int fq) const {
        const int row0 = u.pm * BM + wr * 64 + fr, col0 = u.pn * BM + wc * 32 + 4 * fq;
#pragma unroll
        for (int ai = 0; ai < 2; ++ai)
#pragma unroll
            for (int m = 0; m < 4; ++m) { const size_t off = (size_t)(row0 + ai * HALF + m * 16) * 1024 + col0;
#pragma unroll
                for (int bj = 0; bj < 2; ++bj)
#pragma unroll
                    for (int n = 0; n < 2; ++n) { const f32x4 b = *(const f32x4*)(in + off + bj * HALF + n * 16); *(f32x4*)(out + off + bj * HALF + n * 16) = b + acc[ai][bj][m][n]; } }
    }
};

struct EpiPle {
    static constexpr bool PERM = false, AFTER_DRAIN = false;
    float* h; const bf16_t* PP;
    __device__ __forceinline__ void operator()(const f32x4 (&acc)[2][2][4][2], const Unit& u, int wr, int wc, int fr, int fq) const {
        const int row0 = u.pm * BM + wr * 64 + fr, col0 = u.pn * BM + wc * 32 + 4 * fq;
#pragma unroll
        for (int ai = 0; ai < 2; ++ai)
#pragma unroll
            for (int m = 0; m < 4; ++m) { const size_t off = (size_t)(row0 + ai * HALF + m * 16) * 1024 + col0;
#pragma unroll
                for (int bj = 0; bj < 2; ++bj)
#pragma unroll
                    for (int n = 0; n < 2; ++n) { const size_t o = off + bj * HALF + n * 16; const u32x2 pw = *(const u32x2*)(PP + o); const f32x4 b = *(const f32x4*)(h + o); const f32x4 a = acc[ai][bj][m][n];
                        f32x4 r; r[0] = b[0] + sigm(a[0]) * bf_lo(pw.x); r[1] = b[1] + sigm(a[1]) * bf_hi(pw.x); r[2] = b[2] + sigm(a[2]) * bf_lo(pw.y); r[3] = b[3] + sigm(a[3]) * bf_hi(pw.y);
                        *(f32x4*)(h + o) = r; } }
    }
};
}
#define GAS __attribute__((address_space(1)))
#define LAS __attribute__((address_space(3)))
typedef unsigned short bf16;
typedef unsigned v4u __attribute__((ext_vector_type(4)));
typedef float f32x4 __attribute__((ext_vector_type(4)));
typedef short bf16x8 __attribute__((ext_vector_type(8)));
typedef GAS unsigned gu32;
typedef GAS unsigned long long gu64;
#define RLX_AGENT __ATOMIC_RELAXED, __HIP_MEMORY_SCOPE_AGENT
#define LDS_WAIT() asm volatile("s_waitcnt lgkmcnt(0)" ::: "memory")
#define VM_WAIT() asm volatile("s_waitcnt vmcnt(0)" ::: "memory")
__device__ __forceinline__ unsigned long long rt() { return __builtin_amdgcn_s_memrealtime(); }
__device__ __forceinline__ unsigned f2bf(float f) { unsigned u = __builtin_bit_cast(unsigned, f); return (u + 0x7fffu + ((u >> 16) & 1u)) >> 16; }
__device__ __forceinline__ unsigned pk2(float lo, float hi) { return f2bf(lo) | (f2bf(hi) << 16); }

#define XB_TMO      128
#define XB_XCNT(j)  (256  + 64 * (j))
#define XB_XSUB(j)  (1280 + 64 * (j))
#define XB_XGEN(j)  (2304 + 64 * (j))
#define XB_TOP      3328
#define XB_TOPGEN   3392
#define XCD_BAR_WORDS 3456
#define XB_SPIN_CAP (1u << 18)

__device__ __forceinline__ unsigned xb_ld(unsigned* p)              { return __hip_atomic_load(p, __ATOMIC_RELAXED, __HIP_MEMORY_SCOPE_AGENT); }
__device__ __forceinline__ unsigned xb_add(unsigned* p, unsigned v) { return __hip_atomic_fetch_add(p, v, __ATOMIC_RELAXED, __HIP_MEMORY_SCOPE_AGENT); }
__device__ __forceinline__ unsigned xb_xcc_id() { return (unsigned)__builtin_amdgcn_s_getreg((3 << 11) | 20) & 0xFu; }
#define XB_SPIN(cond, bar) do { unsigned _sp = 0; while (cond) { __builtin_amdgcn_s_sleep(1); \
    if ((++_sp & 255u) == 0u) { if (xb_ld(&(bar)[XB_TMO])) break; if (_sp > XB_SPIN_CAP) { atomicAdd(&(bar)[XB_TMO], 1u); break; } } } } while (0)

struct XcdBarrier {
    unsigned* bar; unsigned x;
    volatile LAS unsigned* st;
};

__device__ __forceinline__ XcdBarrier xcd_barrier_post(unsigned* bar, volatile LAS unsigned* st) {
    XcdBarrier b; b.bar = bar; b.x = xb_xcc_id(); b.st = st;
    if (threadIdx.x == 0) (void)xb_add(&bar[XB_XCNT(b.x)], 1u);
    return b;
}
__device__ __forceinline__ void xcd_barrier_complete(unsigned* bar, unsigned x, unsigned& nloc, unsigned& nx) {
    const unsigned G = gridDim.x * gridDim.y * gridDim.z;
    unsigned sum, cnt, mine, sp = 0u;
    for (;;) {
        sum = 0u; cnt = 0u; mine = 0u;
#pragma unroll 1
        for (unsigned j = 0; j < 16; ++j) { const unsigned c = xb_ld(&bar[XB_XCNT(j)]); sum += c; cnt += (c > 0u) ? 1u : 0u; mine = (j == x) ? c : mine; }
        if (sum == G) break;
        __builtin_amdgcn_s_sleep(1);
        if ((++sp & 255u) == 0u) { if (xb_ld(&bar[XB_TMO])) break; if (sp > XB_SPIN_CAP) { atomicAdd(&bar[XB_TMO], 1u); break; } }
    }
    nloc = mine > 0u ? mine : 1u; nx = cnt > 0u ? cnt : 1u;
}

__device__ __forceinline__ void xcd_barrier(const XcdBarrier& b) {
    asm volatile("s_waitcnt vmcnt(0)" ::: "memory");
    __syncthreads();
    if (threadIdx.x == 0) {
        unsigned* bar = b.bar;
        __builtin_amdgcn_s_waitcnt(0);
        unsigned nloc = b.st[0], nx = b.st[1];
        if (nloc == 0u) { xcd_barrier_complete(bar, b.x, nloc, nx); b.st[0] = nloc; b.st[1] = nx; }
        const unsigned old = xb_add(&bar[XB_XSUB(b.x)], 1u);
        const unsigned gen = old / nloc;
        if (old + 1u == (gen + 1u) * nloc) {
            __builtin_amdgcn_fence(__ATOMIC_RELEASE, "agent");
            asm volatile("s_waitcnt vmcnt(0)" ::: "memory");
            const unsigned og = xb_add(&bar[XB_TOP], 1u);
            const unsigned tg = og / nx;
            if (og + 1u == (tg + 1u) * nx) xb_add(&bar[XB_TOPGEN], 1u);
            else XB_SPIN(xb_ld(&bar[XB_TOPGEN]) == tg, bar);
            __builtin_amdgcn_fence(__ATOMIC_ACQUIRE, "agent");
            xb_add(&bar[XB_XGEN(b.x)], 1u);
            asm volatile("s_waitcnt vmcnt(0)" ::: "memory");
        } else {
            XB_SPIN(xb_ld(&bar[XB_XGEN(b.x)]) == gen, bar);
            __builtin_amdgcn_fence(__ATOMIC_ACQUIRE, "agent");
            asm volatile("s_waitcnt vmcnt(0)" ::: "memory");
        }
    }
    __syncthreads();
}
constexpr int NWAVES = 8;
constexpr int BATCH = 2, SEQ = 16384, M = BATCH * SEQ, D = 1024, DEPTH = 2;
constexpr int INW = 6440;
constexpr int NIN = 3584;
constexpr int NGM = 3072, FF = 4096, PLE = 256;
constexpr int NCMP = 1023;
constexpr float EPS = 1e-6f;
#define DI __device__ __forceinline__

constexpr size_t MiB = 1u << 20;
constexpr size_t WS_CTL = 0, CTL_ZERO_BYTES = 1 * MiB;
constexpr size_t WS_ROPE = 1 * MiB;
constexpr size_t WS_KCMP = 3 * MiB, WS_VCMP = 3 * MiB + 512 * 1024;
constexpr size_t WS_DECAY = 4 * MiB;
constexpr size_t WS_W = 8 * MiB;
constexpr size_t W_IN = 0, W_GM = 7 * MiB, W_BR = 13 * MiB, W_O = 16 * MiB, W_1 = 18 * MiB, W_2 = 26 * MiB, W_PG = 34 * MiB, W_PP = 36 * MiB, W_LAYER = 36 * MiB + 512 * 1024;
constexpr size_t WS_A16 = 88 * MiB;
constexpr size_t WS_SMALL = 152 * MiB;
constexpr size_t WS_POOLED = 160 * MiB;
constexpr size_t WS_Q = 192 * MiB;
constexpr size_t WS_RG = 224 * MiB;
constexpr size_t WS_U = 256 * MiB, WS_KV = 288 * MiB, WS_QKG = 336 * MiB, WS_VG = 368 * MiB, WS_GLA = 400 * MiB;
constexpr size_t WS_GM = 256 * MiB;
constexpr size_t WS_HID = 160 * MiB;
constexpr size_t WS_PP = 416 * MiB;
constexpr size_t WS_P16 = 480 * MiB;
constexpr size_t WS_END = 512 * MiB;
static_assert(WS_W + 2 * W_LAYER <= WS_A16 && WS_GLA + (size_t)2048 * 8192 * 4 <= WS_END && WS_GM + (size_t)M * NGM * 2 <= WS_P16 && WS_HID + (size_t)M * FF * 2 <= WS_PP && WS_PP + (size_t)M * D * 2 <= WS_P16 && WS_P16 + (size_t)M * PLE * 2 <= WS_END, "d_ws map");
constexpr int CW_BAR = 4096;

constexpr int RING_OFF = 0, RING_BYTES = 131072;
constexpr int LDSCTL_OFF = RING_BYTES, MISC_OFF = LDSCTL_OFF + 320;
constexpr int LDS_BYTES = 147456;
static_assert(MISC_OFF + 128 <= LDS_BYTES, "LDS map");

typedef const void* __attribute__((address_space(4))) kaptr_t;
DI const void* ka_in(int i) { const kaptr_t* ka = (const kaptr_t*)__builtin_amdgcn_kernarg_segment_ptr(); return (const void*)*(volatile const kaptr_t*)(ka + i); }
#define IN_x ((const float*)ka_in(0))
#define IN_p ((const float*)ka_in(1))
#define IN_positions ((const int*)ka_in(2))
#define IN_norm_mix ((const float*)ka_in(3))
#define IN_w_in ((const float*)ka_in(4))
#define IN_pool_w ((const float*)ka_in(5))
#define IN_pool_scale ((const float*)ka_in(6))
#define IN_cmp_pos_k ((const float*)ka_in(7))
#define IN_cmp_w_k ((const float*)ka_in(8))
#define IN_cmp_pos_v ((const float*)ka_in(9))
#define IN_cmp_w_v ((const float*)ka_in(10))
#define IN_gla_w_gate ((const float*)ka_in(11))
#define IN_gla_b_gate ((const float*)ka_in(12))
#define IN_gla_norm ((const float*)ka_in(13))
#define IN_w_branch ((const float*)ka_in(14))
#define IN_w_out ((const float*)ka_in(15))
#define IN_norm_ffn ((const float*)ka_in(16))
#define IN_w_ff1 ((const float*)ka_in(17))
#define IN_w_ff2 ((const float*)ka_in(18))
#define IN_norm_ple ((const float*)ka_in(19))
#define IN_w_ple_gate ((const float*)ka_in(20))
#define IN_w_ple_proj ((const float*)ka_in(21))
#define IN_norm_final ((const float*)ka_in(22))
DI unsigned char* ws_opaque() { return (unsigned char*)ka_in(24); }
#define OUTP ((float*)ka_in(23))
struct Frame {
    LAS unsigned char* lds;
    volatile LAS unsigned* MISC;
    gu32* ctl;
    int tid, lane, wave, G, bid;
};
DI bf16* wptr_(unsigned char* wsq, int l, size_t off) { return (bf16*)(wsq + WS_W + (size_t)l * W_LAYER + off); }
#define wptr(F, l, off) wptr_(wsq, l, off)
DI float bf2f(bf16 b) { return __builtin_bit_cast(float, (unsigned)b << 16); }
DI float wave_sum(float v) {
#pragma unroll
    for (int o = 1; o < 64; o <<= 1) v += __shfl_xor(v, o);
    return v;
}
DI float wave_max(float v) {
#pragma unroll
    for (int o = 1; o < 64; o <<= 1) v = fmaxf(v, __shfl_xor(v, o));
    return v;
}

template <class Map>
DI void transpose_mat(Frame& F, const float* W, int ld, int K, int Ndst, bf16* WT, Map map) {
    LAS float* scr = (LAS float*)(F.lds + RING_OFF + F.wave * 16384);
    const int gw = F.bid * NWAVES + F.wave, NGW = F.G * NWAVES, lane = F.lane;
    const int nblk = Ndst / 32, items = (K / 64) * nblk;
    for (int it = gw; it < items; it += NGW) {
        const int kb = it / nblk, nb = it % nblk, k0 = 64 * kb, n0 = 32 * nb;
        const int sc = map(n0 + (lane & 31));
#pragma unroll 8
        for (int i = 0; i < 32; ++i) { const int kk = 2 * i + (lane >> 5); scr[kk * 33 + (lane & 31)] = sc >= 0 ? W[(size_t)(k0 + kk) * ld + sc] : 0.f; }
        LDS_WAIT(); asm volatile("" ::: "memory");
        const int c = lane & 7;
#pragma unroll
        for (int j = 0; j < 4; ++j) { const int n = (lane >> 3) + 8 * j; const LAS float* s = scr + (8 * c) * 33 + n;
            v4u o; o.x = pk2(s[0 * 33], s[1 * 33]); o.y = pk2(s[2 * 33], s[3 * 33]); o.z = pk2(s[4 * 33], s[5 * 33]); o.w = pk2(s[6 * 33], s[7 * 33]);
            *(v4u*)(WT + (size_t)(n0 + n) * K + k0 + 8 * c) = o; }
        LDS_WAIT(); asm volatile("" ::: "memory");
    }
}
struct MapOff { int off; DI int operator()(int n) const { return n + off; } };
struct MapWin {
    DI int operator()(int n) const {
        if (n < 1792) return n;
        if (n < 2816) return n + 24;
        if (n < 3328) return n + 40;
        if (n < 3352) return n - 3328 + 1792;
        if (n < 3368) return n - 3352 + 2840;
        return -1;
    }
};
DI void p0_prologue(Frame& F) {
    unsigned char* const wsq = ws_opaque();
    for (int l = 0; l < DEPTH; ++l) {
        transpose_mat(F, IN_w_in + (size_t)l * D * INW, INW, D, NIN, wptr(F, l, W_IN), MapWin{});
        transpose_mat(F, IN_w_in + (size_t)l * D * INW, INW, D, NGM, wptr(F, l, W_GM), MapOff{3368});
        transpose_mat(F, IN_w_branch + ((size_t)l * 3 + 1) * 512 * D, D, 512, D, wptr(F, l, W_BR) + (size_t)1 * D * 512, MapOff{0});
        transpose_mat(F, IN_w_branch + ((size_t)l * 3 + 2) * 512 * D, D, 512, D, wptr(F, l, W_BR) + (size_t)2 * D * 512, MapOff{0});
        transpose_mat(F, IN_w_out + (size_t)l * D * D, D, D, D, wptr(F, l, W_O), MapOff{0});
        transpose_mat(F, IN_w_ff1 + (size_t)l * D * FF, FF, D, FF, wptr(F, l, W_1), MapOff{0});
        transpose_mat(F, IN_w_ff2 + (size_t)l * FF * D, D, FF, D, wptr(F, l, W_2), MapOff{0});
        transpose_mat(F, IN_w_ple_gate + (size_t)l * D * D, D, D, D, wptr(F, l, W_PG), MapOff{0});
        transpose_mat(F, IN_w_ple_proj + (size_t)l * PLE * D, D, PLE, D, wptr(F, l, W_PP), MapOff{0});
        bf16* WT0 = wptr(F, l, W_BR);
        const float* pw = IN_pool_w + (size_t)l * 4 * 128 * 128; const float* psc = IN_pool_scale + (size_t)l * 512; const float* wb = IN_w_branch + (size_t)l * 3 * 512 * D;
        for (int it = F.bid * 512 + F.tid; it < 512 * D; it += F.G * 512) {
            const int n = it & (D - 1), kk = it >> 10, g = kk >> 7, c = kk & 127;
            float a = 0.f;
            for (int d = 0; d < 128; ++d) a += pw[(g * 128 + c) * 128 + d] * psc[g * 128 + d] * wb[(size_t)(g * 128 + d) * D + n];
            WT0[(size_t)n * 512 + kk] = (bf16)f2bf(a);
        }
    }
    for (int m = F.bid * 512 + F.tid; m < M; m += F.G * 512) {
        const float pos = (float)IN_positions[m];
#pragma unroll
        for (int i = 0; i < 8; ++i) {
            const float inv = (float)exp(-(double)i * 0.125 * 13.122363377404328);
            const float ang = pos * inv; double sn, cs; sincos((double)ang, &sn, &cs);
            ((float*)(wsq + WS_ROPE))[(size_t)m * 16 + i] = (float)cs; ((float*)(wsq + WS_ROPE))[(size_t)m * 16 + 8 + i] = (float)sn;
        }
    }
}

DI void norm_rows_bf16(Frame& F, const float* h, const float* gain, bf16* o16) {
    const int gw = F.bid * NWAVES + F.wave, NGW = F.G * NWAVES;
    f32x4 gv[4];
#pragma unroll
    for (int j = 0; j < 4; ++j) gv[j] = *((const f32x4*)gain + F.lane + 64 * j);
    for (int m = gw; m < M; m += NGW) {
        const f32x4* xr = (const f32x4*)(h + (size_t)m * D) + F.lane;
        f32x4 v[4]; float s = 0.f;
#pragma unroll
        for (int j = 0; j < 4; ++j) { v[j] = xr[64 * j]; s += (v[j].x * v[j].x + v[j].y * v[j].y) + (v[j].z * v[j].z + v[j].w * v[j].w); }
        const float rstd = 1.0f / sqrtf(wave_sum(s) * (1.f / D) + EPS);
        unsigned long long* o8 = (unsigned long long*)(o16 + (size_t)m * D) + F.lane;
#pragma unroll
        for (int j = 0; j < 4; ++j) { const f32x4 y = v[j] * rstd * gv[j]; o8[64 * j] = (unsigned long long)pk2(y.x, y.y) | ((unsigned long long)pk2(y.z, y.w) << 32); }
    }
}
DI void norm_rows_f32(Frame& F, float* h, const float* gain) {
    const int gw = F.bid * NWAVES + F.wave, NGW = F.G * NWAVES;
    f32x4 gv[4];
#pragma unroll
    for (int j = 0; j < 4; ++j) gv[j] = *((const f32x4*)gain + F.lane + 64 * j);
    for (int m = gw; m < M; m += NGW) {
        f32x4* xr = (f32x4*)(h + (size_t)m * D) + F.lane;
        f32x4 v[4]; float s = 0.f;
#pragma unroll
        for (int j = 0; j < 4; ++j) { v[j] = xr[64 * j]; s += (v[j].x * v[j].x + v[j].y * v[j].y) + (v[j].z * v[j].z + v[j].w * v[j].w); }
        const float rstd = 1.0f / sqrtf(wave_sum(s) * (1.f / D) + EPS);
#pragma unroll
        for (int j = 0; j < 4; ++j) xr[64 * j] = v[j] * rstd * gv[j];
    }
}
DI void cvt_p16(Frame& F, int l) {
    unsigned char* const wsq = ws_opaque();
    const f32x4* src = (const f32x4*)(IN_p + (size_t)l * M * PLE); unsigned long long* dst = (unsigned long long*)((bf16*)(wsq + WS_P16));
    for (size_t i = (size_t)F.bid * 512 + F.tid; i < (size_t)M * PLE / 4; i += (size_t)F.G * 512) { const f32x4 v = src[i]; dst[i] = (unsigned long long)pk2(v.x, v.y) | ((unsigned long long)pk2(v.z, v.w) << 32); }
}

DI void pool_phase(Frame& F) {
    unsigned char* const wsq = ws_opaque();
    for (int it = F.bid * 512 + F.tid; it < M * 64; it += F.G * 512) {
        const int m = it >> 6, cv = it & 63, g = cv >> 4, w = 2 << g, tl = m & (SEQ - 1);
        const int cnt = (tl + 1 < w) ? tl + 1 : w;
        float s[8];
#pragma unroll
        for (int e = 0; e < 8; ++e) s[e] = 0.f;
        v4u cur = {0u, 0u, 0u, 0u};
        for (int k = 0; k < cnt; ++k) {
            const v4u r = *(const v4u*)(((bf16*)(wsq + WS_U)) + (size_t)(m - k) * 512 + cv * 8);
            if (k == 0) cur = r;
            s[0] += pg8::bf_lo(r.x); s[1] += pg8::bf_hi(r.x); s[2] += pg8::bf_lo(r.y); s[3] += pg8::bf_hi(r.y);
            s[4] += pg8::bf_lo(r.z); s[5] += pg8::bf_hi(r.z); s[6] += pg8::bf_lo(r.w); s[7] += pg8::bf_hi(r.w);
        }
        const float ic = 1.0f / (float)cnt;
        v4u o;
        o.x = pk2(s[0] * ic - pg8::bf_lo(cur.x), s[1] * ic - pg8::bf_hi(cur.x)); o.y = pk2(s[2] * ic - pg8::bf_lo(cur.y), s[3] * ic - pg8::bf_hi(cur.y));
        o.z = pk2(s[4] * ic - pg8::bf_lo(cur.z), s[5] * ic - pg8::bf_hi(cur.z)); o.w = pk2(s[6] * ic - pg8::bf_lo(cur.w), s[7] * ic - pg8::bf_hi(cur.w));
        *(v4u*)(((bf16*)(wsq + WS_POOLED)) + (size_t)m * 512 + cv * 8) = o;
    }
}

DI void compress_phase(Frame& F, int l) {
    unsigned char* const wsq = ws_opaque();
    const int gw = F.bid * NWAVES + F.wave, NGW = F.G * NWAVES, lane = F.lane;
    for (int u = gw; u < 1024; u += NGW) {
        const int which = u & 1, rest = u >> 1, nb = rest & 127, g = (rest >> 7) & 1, b = rest >> 8, n0 = nb * 8;
        const float* Wc = (which ? IN_cmp_w_v : IN_cmp_w_k) + (size_t)l * 2048 * 64;
        const float* Pc = (which ? IN_cmp_pos_v : IN_cmp_pos_k) + (size_t)l * 2048;
        const bf16* src = ((bf16*)(wsq + WS_KV)) + (size_t)b * SEQ * 768 + which * 128 + g * 64;
        float acc[8];
#pragma unroll
        for (int i = 0; i < 8; ++i) acc[i] = 0.f;
        for (int li = 0; li < 32; ++li) {
            int tok[8];
#pragma unroll
            for (int i = 0; i < 8; ++i) { const int t = 16 * (n0 + i) + li; tok[i] = t < SEQ ? t : SEQ - 1; }
            for (int d = 0; d < 64; ++d) {
                const float w = Wc[(size_t)(li * 64 + d) * 64 + lane], ps = Pc[li * 64 + d];
#pragma unroll
                for (int i = 0; i < 8; ++i) acc[i] += (bf2f(src[(size_t)tok[i] * 768 + d]) + ps) * w;
            }
        }
        bf16* dst = which ? ((bf16*)(wsq + WS_VCMP)) : ((bf16*)(wsq + WS_KCMP));
#pragma unroll
        for (int i = 0; i < 8; ++i) { const int n = n0 + i; if (n < NCMP) dst[((size_t)(b * 1024 + n) * 2 + g) * 64 + lane] = (bf16)f2bf(acc[i]); }
    }
}

DI void dot4(const LAS float* qf, const bf16* kp, float (&s)[4]) {
#pragma unroll
    for (int hh = 0; hh < 4; ++hh) s[hh] = 0.f;
    v4u kv[8];
#pragma unroll
    for (int v = 0; v < 8; ++v) kv[v] = *(const v4u*)(kp + 8 * v);
#pragma unroll
    for (int v = 0; v < 8; ++v) {
        asm volatile("" : "+v"(s[0]), "+v"(s[1]), "+v"(s[2]), "+v"(s[3]) :: "memory");
        const v4u kw = kv[v];
        const float k0 = pg8::bf_lo(kw.x), k1 = pg8::bf_hi(kw.x), k2 = pg8::bf_lo(kw.y), k3 = pg8::bf_hi(kw.y), k4 = pg8::bf_lo(kw.z), k5 = pg8::bf_hi(kw.z), k6 = pg8::bf_lo(kw.w), k7 = pg8::bf_hi(kw.w);
#pragma unroll
        for (int hh = 0; hh < 4; ++hh) {
            const f32x4 qa = *(const LAS f32x4*)(qf + hh * 64 + 8 * v), qb = *(const LAS f32x4*)(qf + hh * 64 + 8 * v + 4);
            s[hh] += (k0 * qa.x + k1 * qa.y) + (k2 * qa.z + k3 * qa.w) + (k4 * qb.x + k5 * qb.y) + (k6 * qb.z + k7 * qb.w);
        }
    }
}
template <bool IMP, class Prov>
DI void attn_branch(const Prov& P, int nch, const LAS float* qf, LAS float* pc, LAS float* ps, int lane, float (&o)[4]) {
    float mx[4], l[4];
#pragma unroll
    for (int hh = 0; hh < 4; ++hh) { mx[hh] = -INFINITY; l[hh] = 0.f; o[hh] = 0.f; }
    for (int c = 0; c < nch; ++c) {
        asm volatile("" ::: "memory");
        const bf16* kp; bool valid;
        if (!P.chunk(c, lane, kp, valid)) continue;
        float s[4]; dot4(qf, kp, s);
#pragma unroll
        for (int hh = 0; hh < 4; ++hh) {
            const float sv = valid ? s[hh] : -INFINITY;
            const float cm = wave_max(sv);
            if (cm > -INFINITY) {
                const float mn = fmaxf(mx[hh], cm);
                const float e = valid ? __expf(sv - mn) : 0.f;
                const float cs = wave_sum(e);
                l[hh] = l[hh] * __expf(mx[hh] - mn) + cs; mx[hh] = mn;
            }
        }
    }
    float inv[4];
#pragma unroll
    for (int hh = 0; hh < 4; ++hh) inv[hh] = l[hh] > 0.f ? 1.0f / l[hh] : 0.f;
    for (int c = 0; c < nch; ++c) {
        asm volatile("" ::: "memory");
        const bf16* kp; bool valid;
        if (!P.chunk(c, lane, kp, valid)) { if (IMP) ps[c * 64 + lane] = 0.f; continue; }
        float s[4]; dot4(qf, kp, s);
        f32x4 p;
#pragma unroll
        for (int hh = 0; hh < 4; ++hh) p[hh] = valid ? __expf(s[hh] - mx[hh]) * inv[hh] : 0.f;
        *(LAS f32x4*)(pc + lane * 4) = p;
        if (IMP) ps[c * 64 + lane] = (p[0] + p[1]) + (p[2] + p[3]);
        LDS_WAIT(); asm volatile("" ::: "memory");
#pragma unroll 8
        for (int kk = 0; kk < 64; ++kk) {
            const f32x4 p4 = *(const LAS f32x4*)(pc + kk * 4);
            const float v = bf2f(P.vrow(c, kk)[lane]);
            o[0] += p4.x * v; o[1] += p4.y * v; o[2] += p4.z * v; o[3] += p4.w * v;
        }
        LDS_WAIT(); asm volatile("" ::: "memory");
    }
}
struct ProvCmp {
    const bf16 *K, *V; int cnt;
    DI bool chunk(int c, int lane, const bf16*& kp, bool& valid) const { const int n = c * 64 + lane; valid = n < cnt; kp = K + (size_t)(valid ? n : 0) * 128; return true; }
    DI const bf16* vrow(int c, int kk) const { const int n = c * 64 + kk; return V + (size_t)(n < cnt ? n : 0) * 128; }
};
struct ProvSel {
    const bf16 *K, *V; const LAS int* sel; int t;
    DI bool chunk(int c, int lane, const bf16*& kp, bool& valid) const { const int blk = sel[c]; if (blk < 0) return false; const int tok = blk * 64 + lane; valid = tok <= t; kp = K + (size_t)tok * 768; return true; }
    DI const bf16* vrow(int c, int kk) const { return V + (size_t)(sel[c] * 64 + kk) * 768; }
};
struct ProvWin {
    const bf16 *K, *V; int t;
    DI bool chunk(int c, int lane, const bf16*& kp, bool& valid) const { const int t0 = t - 511 + 64 * c; if (t0 + 63 < 0) return false; const int tok = t0 + lane; valid = tok >= 0; kp = K + (size_t)(valid ? tok : 0) * 768; return true; }
    DI const bf16* vrow(int c, int kk) const { const int tok = t - 511 + 64 * c + kk; return V + (size_t)(tok >= 0 ? tok : 0) * 768; }
};
constexpr int NSA_WAVE_LDS = 8192;
DI void nsa_phase(Frame& F) {
    unsigned char* const wsq = ws_opaque();
    const int gw = F.bid * NWAVES + F.wave, NGW = F.G * NWAVES, lane = F.lane;
    LAS float* qf = (LAS float*)(F.lds + RING_OFF + F.wave * NSA_WAVE_LDS);
    LAS float* pc = qf + 256; LAS float* ps = qf + 512; LAS int* seli = (LAS int*)(qf + 512 + 1024);
    for (int task = gw; task < BATCH * 2 * SEQ; task += NGW) {
        const int t = task >> 2, g = (task >> 1) & 1, b = task & 1;
        const size_t m = (size_t)b * SEQ + t;
        {
            const unsigned long long qw = *(const unsigned long long*)(((bf16*)(wsq + WS_Q)) + m * 512 + g * 256 + lane * 4);
            f32x4 qv; qv.x = pg8::bf_lo((unsigned)qw); qv.y = pg8::bf_hi((unsigned)qw); qv.z = pg8::bf_lo((unsigned)(qw >> 32)); qv.w = pg8::bf_hi((unsigned)(qw >> 32));
            *(LAS f32x4*)(qf + lane * 4) = qv;
            LDS_WAIT(); asm volatile("" ::: "memory");
        }
        const int cnt = t >= 31 ? ((t - 31) >> 4) + 1 : 0, nch = (cnt + 63) >> 6;
        float oc[4];
        { ProvCmp P{((bf16*)(wsq + WS_KCMP)) + ((size_t)b * 1024 * 2 + g) * 64, ((bf16*)(wsq + WS_VCMP)) + ((size_t)b * 1024 * 2 + g) * 64, cnt};
#ifndef NSA_NO_CMP
          attn_branch<true>(P, nch, qf, pc, ps, lane, oc);
#else
          oc[0]=oc[1]=oc[2]=oc[3]=(float)P.cnt;
#endif
        }
        const int cur = t >> 6;
        unsigned long long key[4];
#pragma unroll
        for (int jj = 0; jj < 4; ++jj) {
            const int j = lane + 64 * jj;
            float imp = 0.f;
#pragma unroll
            for (int k = -1; k < 4; ++k) { const int n = 4 * j + k; if (n >= 0 && n < cnt) imp += ps[n]; }
            const bool forced = (j == 0) || (j == cur) || (j == cur - 1);
            const float sc = forced ? INFINITY : imp;
            key[jj] = (j <= cur) ? (((unsigned long long)__float_as_uint(sc) << 32) | (unsigned long long)(0xFFFFu - (unsigned)j)) : 0ull;
        }
        for (int r = 0; r < 16; ++r) {
            unsigned long long best = key[0] > key[1] ? key[0] : key[1]; { const unsigned long long b2 = key[2] > key[3] ? key[2] : key[3]; best = best > b2 ? best : b2; }
#pragma unroll
            for (int o = 1; o < 64; o <<= 1) {
                const unsigned lo = __shfl_xor((unsigned)best, o), hi = __shfl_xor((unsigned)(best >> 32), o);
                const unsigned long long ot = ((unsigned long long)hi << 32) | lo; best = ot > best ? ot : best;
            }
            const int js = best ? (int)(0xFFFFu - (unsigned)(best & 0xFFFFull)) : -1;
            if (lane == 0) seli[r] = js;
#pragma unroll
            for (int jj = 0; jj < 4; ++jj) if (key[jj] == best) key[jj] = 0ull;
        }
        LDS_WAIT(); asm volatile("" ::: "memory");
        float os[4];
        { ProvSel P{((bf16*)(wsq + WS_KV)) + (size_t)b * SEQ * 768 + 2 * 128 + g * 64, ((bf16*)(wsq + WS_KV)) + (size_t)b * SEQ * 768 + 3 * 128 + g * 64, seli, t};
#ifndef NSA_NO_SEL
          attn_branch<false>(P, 16, qf, pc, ps, lane, os);
#else
          os[0]=os[1]=os[2]=os[3]=(float)P.t;
#endif
        }
        float ow[4];
        { ProvWin P{((bf16*)(wsq + WS_KV)) + (size_t)b * SEQ * 768 + 4 * 128 + g * 64, ((bf16*)(wsq + WS_KV)) + (size_t)b * SEQ * 768 + 5 * 128 + g * 64, t};
#ifndef NSA_NO_WIN
          attn_branch<false>(P, 8, qf, pc, ps, lane, ow);
#else
          ow[0]=ow[1]=ow[2]=ow[3]=(float)P.t;
#endif
        }
        const float* gl = ((float*)(wsq + WS_SMALL)) + m * 64 + g * 12;
#pragma unroll
        for (int hh = 0; hh < 4; ++hh) {
            const float y = pg8::sigm(gl[hh * 3 + 0]) * oc[hh] + pg8::sigm(gl[hh * 3 + 1]) * os[hh] + pg8::sigm(gl[hh * 3 + 2]) * ow[hh];
            ((bf16*)(wsq + WS_Q))[m * 512 + (g * 4 + hh) * 64 + lane] = (bf16)f2bf(y);
        }
    }
}

DI float logsig(float z) { return fminf(z, 0.f) - log1pf(expf(-fabsf(z))); }
DI void gla_gates(Frame& F, int l, size_t m0, int h, LAS float* bc) {
    unsigned char* const wsq = ws_opaque();
    const int i = F.tid >> 3, dsub = F.tid & 7;
    const float* wg = IN_gla_w_gate + (size_t)l * 16 * 256; const float* bg = IN_gla_b_gate + (size_t)l * 256;
    float glr[16];
#pragma unroll
    for (int r4 = 0; r4 < 4; ++r4) { const f32x4 v = *(const f32x4*)(((float*)(wsq + WS_SMALL)) + (m0 + i) * 64 + 24 + 4 * r4); glr[4 * r4] = v.x; glr[4 * r4 + 1] = v.y; glr[4 * r4 + 2] = v.z; glr[4 * r4 + 3] = v.w; }
#pragma unroll
    for (int e = 0; e < 8; ++e) { const int d = dsub * 8 + e, col = h * 64 + d; float z = bg[col];
#pragma unroll
        for (int r = 0; r < 16; ++r) z += glr[r] * wg[r * 256 + col];
        bc[i * 65 + d] = logsig(z) * (1.0f / 16.0f); }
    __syncthreads();
    if (F.tid < 64) { float run = 0.f; for (int k = 0; k < 64; ++k) { run += bc[k * 65 + F.tid]; bc[k * 65 + F.tid] = run; } }
    __syncthreads();
}
DI void gla_g1(Frame& F, int l) {
    unsigned char* const wsq = ws_opaque();
    LAS float* bc = (LAS float*)(F.lds + RING_OFF); LAS float* kt = bc + 64 * 65;
    for (int u = F.bid; u < 2048; u += F.G) {
        const int h = u & 3, n = (u >> 2) & 255, b = u >> 10; const size_t m0 = (size_t)b * SEQ + n * 64;
        gla_gates(F, l, m0, h, bc);
        { const int i = F.tid >> 3, dsub = F.tid & 7;
          const v4u kw = *(const v4u*)(((bf16*)(wsq + WS_QKG)) + (m0 + i) * 512 + 256 + h * 64 + dsub * 8);
          const float kf[8] = {pg8::bf_lo(kw.x), pg8::bf_hi(kw.x), pg8::bf_lo(kw.y), pg8::bf_hi(kw.y), pg8::bf_lo(kw.z), pg8::bf_hi(kw.z), pg8::bf_lo(kw.w), pg8::bf_hi(kw.w)};
#pragma unroll
          for (int e = 0; e < 8; ++e) { const int d = dsub * 8 + e; kt[i * 65 + d] = kf[e] * expf(bc[63 * 65 + d] - bc[i * 65 + d]); } }
        __syncthreads();
        const int e = F.tid & 127, dg = F.tid >> 7;
        float acc[16];
#pragma unroll
        for (int dd = 0; dd < 16; ++dd) acc[dd] = 0.f;
        for (int j = 0; j < 64; ++j) { const float v = bf2f(((bf16*)(wsq + WS_VG))[(m0 + j) * 512 + h * 128 + e]);
#pragma unroll
            for (int dd = 0; dd < 16; ++dd) acc[dd] += kt[j * 65 + dg * 16 + dd] * v; }
#pragma unroll
        for (int dd = 0; dd < 16; ++dd) ((float*)(wsq + WS_GLA))[(size_t)u * 8192 + (dg * 16 + dd) * 128 + e] = acc[dd];
        if (F.tid < 64) ((float*)(wsq + WS_DECAY))[u * 64 + F.tid] = expf(bc[63 * 65 + F.tid]);
        __syncthreads();
    }
}
DI void gla_g2(Frame& F) {
    unsigned char* const wsq = ws_opaque();
    for (int ch = F.bid * 512 + F.tid; ch < 65536; ch += F.G * 512) {
        const int e = ch & 127, d = (ch >> 7) & 63, h = (ch >> 13) & 3, b = ch >> 15;
        float st = 0.f;
        for (int n0 = 0; n0 < 256; n0 += 8) {
            float dl[8], dc[8];
#pragma unroll
            for (int k = 0; k < 8; ++k) { const int u = (b * 256 + n0 + k) * 4 + h; dl[k] = ((float*)(wsq + WS_GLA))[(size_t)u * 8192 + d * 128 + e]; dc[k] = ((float*)(wsq + WS_DECAY))[u * 64 + d]; }
#pragma unroll
            for (int k = 0; k < 8; ++k) { const int u = (b * 256 + n0 + k) * 4 + h; ((float*)(wsq + WS_GLA))[(size_t)u * 8192 + d * 128 + e] = st; st = st * dc[k] + dl[k]; }
        }
    }
}
DI void gla_g3(Frame& F, int l) {
    unsigned char* const wsq = ws_opaque();
    LAS float* bc = (LAS float*)(F.lds + RING_OFF); LAS float* qs = bc + 64 * 65; LAS float* ks = qs + 64 * 65; LAS float* red = ks + 64 * 65;
    const float* gn = IN_gla_norm + (size_t)l * 128;
    for (int u = F.bid; u < 2048; u += F.G) {
        const int h = u & 3, n = (u >> 2) & 255, b = u >> 10; const size_t m0 = (size_t)b * SEQ + n * 64;
        gla_gates(F, l, m0, h, bc);
        { const int i = F.tid >> 3, dsub = F.tid & 7;
          const v4u qw = *(const v4u*)(((bf16*)(wsq + WS_QKG)) + (m0 + i) * 512 + h * 64 + dsub * 8);
          const v4u kw = *(const v4u*)(((bf16*)(wsq + WS_QKG)) + (m0 + i) * 512 + 256 + h * 64 + dsub * 8);
          const float qv[8] = {pg8::bf_lo(qw.x), pg8::bf_hi(qw.x), pg8::bf_lo(qw.y), pg8::bf_hi(qw.y), pg8::bf_lo(qw.z), pg8::bf_hi(qw.z), pg8::bf_lo(qw.w), pg8::bf_hi(qw.w)};
          const float kf[8] = {pg8::bf_lo(kw.x), pg8::bf_hi(kw.x), pg8::bf_lo(kw.y), pg8::bf_hi(kw.y), pg8::bf_lo(kw.z), pg8::bf_hi(kw.z), pg8::bf_lo(kw.w), pg8::bf_hi(kw.w)};
#pragma unroll
          for (int e = 0; e < 8; ++e) { const int d = dsub * 8 + e; const float bb = bc[i * 65 + d]; qs[i * 65 + d] = qv[e] * 0.125f * expf(bb); ks[i * 65 + d] = kf[e] * expf(-bb); } }
        __syncthreads();
        { const int i = F.tid >> 3, jg = F.tid & 7;
          float a[8];
#pragma unroll
          for (int jj = 0; jj < 8; ++jj) a[jj] = 0.f;
          for (int d = 0; d < 64; ++d) { const float qv = qs[i * 65 + d];
#pragma unroll
              for (int jj = 0; jj < 8; ++jj) a[jj] += qv * ks[(jg * 8 + jj) * 65 + d]; }
#pragma unroll
          for (int jj = 0; jj < 8; ++jj) { const int j = jg * 8 + jj; bc[i * 65 + j] = (j <= i) ? a[jj] : 0.f; } }
        __syncthreads();
        const int e = F.tid & 127, ig = F.tid >> 7;
        float acc[16];
#pragma unroll
        for (int r = 0; r < 16; ++r) acc[r] = 0.f;
        for (int j = 0; j < 64; ++j) { const float v = bf2f(((bf16*)(wsq + WS_VG))[(m0 + j) * 512 + h * 128 + e]);
#pragma unroll
            for (int r = 0; r < 16; ++r) acc[r] += bc[(ig * 16 + r) * 65 + j] * v; }
        for (int d = 0; d < 64; ++d) { const float st = ((float*)(wsq + WS_GLA))[(size_t)u * 8192 + d * 128 + e];
#pragma unroll
            for (int r = 0; r < 16; ++r) acc[r] += qs[(ig * 16 + r) * 65 + d] * st; }
#pragma unroll
        for (int r = 0; r < 16; ++r) { const float ss = wave_sum(acc[r] * acc[r]); if (F.lane == 0) red[F.wave * 16 + r] = ss; }
        __syncthreads();
        const float gne = gn[e];
#pragma unroll
        for (int r = 0; r < 16; ++r) {
            const float tot = red[F.wave * 16 + r] + red[(F.wave ^ 1) * 16 + r];
            const float rs = 1.0f / sqrtf(tot * (1.0f / 128.0f) + EPS);
            const size_t idx = (m0 + ig * 16 + r) * 512 + h * 128 + e;
            const float rr = bf2f(((bf16*)(wsq + WS_RG))[idx]);
            ((bf16*)(wsq + WS_RG))[idx] = (bf16)f2bf(acc[r] * rs * gne * (rr / (1.0f + expf(-rr))));
        }
        __syncthreads();
    }
}

#ifndef EN_P0
#define EN_P0 1
#endif
#ifndef EN_P2
#define EN_P2 1
#endif
#ifndef EN_P3
#define EN_P3 1
#endif
#ifndef EN_P4
#define EN_P4 1
#endif
#ifndef EN_NSA
#define EN_NSA 1
#endif
#ifndef EN_P5
#define EN_P5 1
#endif
#ifndef EN_P6
#define EN_P6 1
#endif
#ifndef EN_P7
#define EN_P7 1
#endif
#ifndef EN_P8
#define EN_P8 1
#endif
#ifndef EN_P10
#define EN_P10 1
#endif
#ifndef EN_P10B
#define EN_P10B 1
#endif
#ifndef EN_P11
#define EN_P11 1
#endif
#ifndef EN_P13
#define EN_P13 1
#endif
struct Args { const void* in[23]; float* out; unsigned char* ws; };
#define PG8_SP2 true
#define PG8_ALIGN true
__global__ void __launch_bounds__(NWAVES * 64, 2) mk_fwd(Args args) {
    extern __shared__ __attribute__((aligned(16))) unsigned char lds[];
    Frame F;
    F.lds = (LAS unsigned char*)lds;
    F.MISC = (volatile LAS unsigned*)(F.lds + MISC_OFF);
    F.tid = threadIdx.x; F.lane = F.tid & 63; F.wave = __builtin_amdgcn_readfirstlane(F.tid >> 6);
    F.G = gridDim.x; F.bid = blockIdx.x;
    unsigned char* wsq = ws_opaque();
    F.ctl = (gu32*)(wsq + WS_CTL);
    for (int u = F.tid; u < (LDS_BYTES - LDSCTL_OFF) / 4; u += NWAVES * 64) ((LAS unsigned*)(F.lds + LDSCTL_OFF))[u] = 0u;
    __syncthreads();
    XcdBarrier bar = xcd_barrier_post((unsigned*)(F.ctl + CW_BAR), F.MISC + 8);
#define GRID_BAR() do { xcd_barrier(bar); wsq = ws_opaque(); asm volatile("" : "+v"(F.tid)); F.lane = F.tid & 63; F.wave = __builtin_amdgcn_readfirstlane(F.tid >> 6); } while (0)
    using pg8::Gemm; using pg8::StaticOrder; using pg8::gemm_phase;
    const int bid = (int)blockIdx.x;

#if EN_P0
    p0_prologue(F);
#endif
    GRID_BAR();
    for (int l = 0; l < DEPTH; ++l) {
        const float* hin = (l == 0) ? IN_x : (const float*)OUTP;
        norm_rows_bf16(F, hin, IN_norm_mix + (size_t)l * D, ((bf16*)(wsq + WS_A16)));
        GRID_BAR();
#if EN_P2
        { Gemm g{((bf16*)(wsq + WS_A16)), wptr(F, l, W_IN), M, NIN, D}; StaticOrder S; S.init(M, NIN, F.G, bid);
          pg8::EpiProj E{((bf16*)(wsq + WS_U)), ((bf16*)(wsq + WS_Q)), ((bf16*)(wsq + WS_KV)), ((bf16*)(wsq + WS_QKG)), ((bf16*)(wsq + WS_VG)), ((bf16*)(wsq + WS_RG)), ((float*)(wsq + WS_SMALL)), ((float*)(wsq + WS_ROPE))};
          gemm_phase<pg8::EpiProj, StaticOrder, PG8_ALIGN, PG8_SP2>(F.lds + RING_OFF, g, S, E); }
#endif
        GRID_BAR();
#if EN_P3
        pool_phase(F); compress_phase(F, l); gla_g1(F, l);
#endif
        GRID_BAR();
#if EN_P4
        gla_g2(F);
#endif
#if EN_NSA
        nsa_phase(F);
#endif
        GRID_BAR();
#if EN_P5
        gla_g3(F, l);
#endif
        GRID_BAR();
#if EN_P6
        { Gemm g{((bf16*)(wsq + WS_A16)), wptr(F, l, W_GM), M, NGM, D}; StaticOrder S; S.init(M, NGM, F.G, bid);
          pg8::EpiAct<1> E{((bf16*)(wsq + WS_GM)), NGM};
          gemm_phase<pg8::EpiAct<1>, StaticOrder, PG8_ALIGN, PG8_SP2>(F.lds + RING_OFF, g, S, E); }
#endif
        GRID_BAR();
#if EN_P7
        { StaticOrder S; S.init(M, D, F.G, bid);
          { Gemm g{((bf16*)(wsq + WS_POOLED)), wptr(F, l, W_BR), M, D, 512}; pg8::EpiBranch<true> E{((bf16*)(wsq + WS_A16)), ((bf16*)(wsq + WS_GM)), 0};
            gemm_phase<pg8::EpiBranch<true>, StaticOrder, PG8_ALIGN, PG8_SP2>(F.lds + RING_OFF, g, S, E); }
          { Gemm g{((bf16*)(wsq + WS_Q)), wptr(F, l, W_BR) + (size_t)1 * D * 512, M, D, 512}; pg8::EpiBranch<false> E{((bf16*)(wsq + WS_A16)), ((bf16*)(wsq + WS_GM)), 1024};
            gemm_phase<pg8::EpiBranch<false>, StaticOrder, PG8_ALIGN, PG8_SP2>(F.lds + RING_OFF, g, S, E); }
          { Gemm g{((bf16*)(wsq + WS_RG)), wptr(F, l, W_BR) + (size_t)2 * D * 512, M, D, 512}; pg8::EpiBranch<false> E{((bf16*)(wsq + WS_A16)), ((bf16*)(wsq + WS_GM)), 2048};
            gemm_phase<pg8::EpiBranch<false>, StaticOrder, PG8_ALIGN, PG8_SP2>(F.lds + RING_OFF, g, S, E); } }
#endif
        GRID_BAR();
#if EN_P8
        { Gemm g{((bf16*)(wsq + WS_A16)), wptr(F, l, W_O), M, D, D}; StaticOrder S; S.init(M, D, F.G, bid);
          pg8::EpiRes E{hin, OUTP};
          gemm_phase<pg8::EpiRes, StaticOrder, PG8_ALIGN, PG8_SP2>(F.lds + RING_OFF, g, S, E); }
#endif
        GRID_BAR();
        norm_rows_bf16(F, OUTP, IN_norm_ffn + (size_t)l * D, ((bf16*)(wsq + WS_A16))); cvt_p16(F, l);
        GRID_BAR();
#if EN_P10
        { Gemm g{((bf16*)(wsq + WS_A16)), wptr(F, l, W_1), M, FF, D}; StaticOrder S; S.init(M, FF, F.G, bid);
          pg8::EpiAct<2> E{((bf16*)(wsq + WS_HID)), FF};
          gemm_phase<pg8::EpiAct<2>, StaticOrder, PG8_ALIGN, PG8_SP2>(F.lds + RING_OFF, g, S, E); }
#endif
#if EN_P10B
        { int kp = PLE; asm volatile("" : "+s"(kp));
          Gemm g{((bf16*)(wsq + WS_P16)), wptr(F, l, W_PP), M, D, kp}; StaticOrder S; S.init(M, D, F.G, bid);
          pg8::EpiAct<0> E{((bf16*)(wsq + WS_PP)), D};
          gemm_phase<pg8::EpiAct<0>, StaticOrder, PG8_ALIGN, PG8_SP2>(F.lds + RING_OFF, g, S, E); }
#endif
        GRID_BAR();
#if EN_P11
        { Gemm g{((bf16*)(wsq + WS_HID)), wptr(F, l, W_2), M, D, FF}; StaticOrder S; S.init(M, D, F.G, bid);
          pg8::EpiRes E{OUTP, OUTP};
          gemm_phase<pg8::EpiRes, StaticOrder, PG8_ALIGN, PG8_SP2>(F.lds + RING_OFF, g, S, E); }
#endif
        GRID_BAR();
        norm_rows_bf16(F, OUTP, IN_norm_ple + (size_t)l * D, ((bf16*)(wsq + WS_A16)));
        GRID_BAR();
#if EN_P13
        { Gemm g{((bf16*)(wsq + WS_A16)), wptr(F, l, W_PG), M, D, D}; StaticOrder S; S.init(M, D, F.G, bid);
          pg8::EpiPle E{OUTP, ((bf16*)(wsq + WS_PP))};
          gemm_phase<pg8::EpiPle, StaticOrder, PG8_ALIGN, PG8_SP2>(F.lds + RING_OFF, g, S, E); }
#endif
        GRID_BAR();
    }
    norm_rows_f32(F, OUTP, IN_norm_final);
}

extern "C" void kernel_launch(void* const* d_in, const int* in_sizes, int n_in, void* d_out, int out_size, void* d_ws, size_t ws_size, hipStream_t stream) {
    static int grid = 0;
    if (grid == 0) {
        if (n_in != 23 || out_size != M * D || ws_size < WS_END) { fprintf(stderr, "kernel_launch: unexpected problem (n_in %d, out %d, ws %zu)\n", n_in, out_size, ws_size); grid = -1; return; }
        int dev = 0, cus = 0, per_cu = 0;
        if (hipGetDevice(&dev) != hipSuccess || hipDeviceGetAttribute(&cus, hipDeviceAttributeMultiprocessorCount, dev) != hipSuccess) { grid = -1; return; }
        if (hipFuncSetAttribute((const void*)mk_fwd, hipFuncAttributeMaxDynamicSharedMemorySize, LDS_BYTES) != hipSuccess) { fprintf(stderr, "kernel_launch: hipFuncSetAttribute failed\n"); grid = -1; return; }
        if (hipOccupancyMaxActiveBlocksPerMultiprocessor(&per_cu, (const void*)mk_fwd, NWAVES * 64, LDS_BYTES) != hipSuccess || per_cu < 1) fprintf(stderr, "kernel_launch: occupancy query reports %d\n", per_cu);
        (void)hipGetLastError();
        grid = cus;
    }
    if (grid < 0) return;
    if (hipMemsetAsync((char*)d_ws + WS_CTL, 0, CTL_ZERO_BYTES, stream) != hipSuccess) return;
    Args a{};
    for (int i = 0; i < 23; ++i) a.in[i] = d_in[i];
    a.out = (float*)d_out; a.ws = (unsigned char*)d_ws;
    hipLaunchKernelGGL(mk_fwd, dim3(grid), dim3(NWAVES * 64), LDS_BYTES, stream, a);
}
```

```cpp
#include <hip/hip_runtime.h>
#include <cstdio>
#include <cstdint>
#include <cmath>
namespace pg8 {
#define PG8_LAS __attribute__((address_space(3)))
typedef unsigned short bf16_t;
typedef short bf16x8 __attribute__((ext_vector_type(8)));
typedef float f32x4 __attribute__((ext_vector_type(4)));
typedef unsigned u32x4 __attribute__((ext_vector_type(4)));
constexpr int BM = 256, BK = 64, HALF = 128, HTB = HALF * BK * 2  , STAGE_BYTES = 8 * HTB, NXCD = 8, WGM = 8;

__host__ __device__ __forceinline__ int lds_byte(int r, int c) { const int st = (r >> 4) * 2 + (c >> 5), rr = r & 15, cc = c & 31, ob = rr * 64 + cc * 2; return st * 1024 + (ob ^ (((ob >> 9) & 1) << 5)); }
__host__ __device__ __forceinline__ void stage_rc(int b, int& R, int& C) { const int st = b / 1024, sb = b % 1024, swz = sb ^ (((sb >> 9) & 1) << 5); R = (st >> 1) * 16 + swz / 64; C = (st & 1) * 32 + (swz % 64) / 2; }
__host__ __device__ __forceinline__ int perm32(int rho) { const int n = rho >> 4, i = rho & 15; return 8 * (i >> 2) + 4 * n + (i & 3); }

template <class E> struct ABlocked { static constexpr bool v = false; };
struct Unit { int pm, pn, idx, g; };
struct Gemm { const bf16_t* A; const bf16_t* Bt; int M, N, K; };
struct Gemm2 { const bf16_t* A[2]; const bf16_t* Bt[2]; int K[2]; };

struct StaticOrder {
    int nM, nN, nwg, G, c, i0, cnt;
    __host__ __device__ void init(int M, int N, int G_, int c_) { nM = M / BM; nN = N / BM; nwg = nM * nN; G = G_; c = c_; i0 = 0; cnt = 1 << 30; }
    __host__ __device__ __forceinline__ bool next(int i, Unit& u) const {
        if (i >= cnt) return false;
        const int L = (i + i0) * G + c; if (L >= nwg) return false;
        int wgid = L; { const int q = nwg / NXCD, r = nwg % NXCD, xcd = wgid % NXCD, off = wgid / NXCD; wgid = (xcd < r ? xcd * (q + 1) : r * (q + 1) + (xcd - r) * q) + off; }
        const int nig = WGM * nN, gid = wgid / nig, fm = gid * WGM, gsz = (nM - fm) < WGM ? (nM - fm) : WGM;
        u.pm = fm + ((wgid % nig) % gsz); u.pn = (wgid % nig) / gsz; u.idx = i; u.g = 0; return true;
    }
    __device__ __forceinline__ void a_ready(const Unit&) const {}
    __device__ __forceinline__ void done(const Unit&) const {}
};

typedef float f32x2 __attribute__((ext_vector_type(2)));
typedef __bf16 bf16x2_pk __attribute__((ext_vector_type(2)));
__device__ __forceinline__ unsigned cvt_pk_bf16(float lo, float hi) { const f32x2 v = {lo, hi}; return __builtin_bit_cast(unsigned, __builtin_convertvector(v, bf16x2_pk)); }
__device__ __forceinline__ f32x2 gelu_pk(f32x2 v) {
    const f32x2 av = __builtin_elementwise_abs(v), d = av * 0.2316418882f + 1.0f;
    f32x2 t; t.x = __builtin_amdgcn_rcpf(d.x); t.y = __builtin_amdgcn_rcpf(d.y);
    f32x2 q = t * 0.5307027145f + (-0.7265760135f); q = q * t + 0.7107068705f; q = q * t + (-0.142248368f); q = q * t + 0.127414796f; q = q * t;
    const f32x2 s = (v * v) * (-0.72134752044f);
    f32x2 e; e.x = __builtin_amdgcn_exp2f(s.x); e.y = __builtin_amdgcn_exp2f(s.y);
    const f32x2 m = v * (q * e), r = v - m;
    f32x2 o; o.x = v.x < 0.f ? m.x : r.x; o.y = v.y < 0.f ? m.y : r.y; return o;
}

template <int ACT  > struct EpiBf16 {
    static constexpr bool PERM = true, AFTER_DRAIN = false; static_assert(ACT == 0 || ACT == 1, "EpiBf16: ACT is 0 (none) or 1 (gelu_pk)");
    bf16_t* O; int ldc; const float* bias; int split_cols; size_t split_stride; float scale0;
    __device__ __forceinline__ void operator()(const f32x4 (&acc)[2][2][4][2], const Unit& u, int wr, int wc, int fr, int fq) const {
        const int row0 = u.pm * BM + wr * 64 + fr; int colt = u.pn * BM; bf16_t* base = O;
        float sc = 1.f; if (split_cols) { const int t = colt / split_cols; base += (size_t)t * split_stride; colt -= t * split_cols; if (t == 0) sc = scale0; }
        const int col0 = colt + wc * 32 + 8 * fq, bcol0 = u.pn * BM + wc * 32 + 8 * fq;
        f32x4 bv[2][2];
#pragma unroll
        for (int bj = 0; bj < 2; ++bj)
#pragma unroll
            for (int n = 0; n < 2; ++n) bv[bj][n] = bias ? *(const f32x4*)(bias + bcol0 + bj * HALF + 4 * n) : (f32x4){0.f, 0.f, 0.f, 0.f};
#pragma unroll
        for (int ai = 0; ai < 2; ++ai)
#pragma unroll
            for (int m = 0; m < 4; ++m) { bf16_t* rowp = base + (size_t)(row0 + ai * HALF + m * 16) * ldc + col0;
#pragma unroll
                for (int bj = 0; bj < 2; ++bj) { f32x4 v0 = acc[ai][bj][m][0] + bv[bj][0], v1 = acc[ai][bj][m][1] + bv[bj][1];
                    if (ACT == 1) { f32x2 a = gelu_pk((f32x2){v0[0], v0[1]}), b = gelu_pk((f32x2){v0[2], v0[3]}), c = gelu_pk((f32x2){v1[0], v1[1]}), d = gelu_pk((f32x2){v1[2], v1[3]});
                        v0 = (f32x4){a.x, a.y, b.x, b.y}; v1 = (f32x4){c.x, c.y, d.x, d.y}; }
                    v0 = v0 * sc; v1 = v1 * sc; u32x4 w; w.x = cvt_pk_bf16(v0[0], v0[1]); w.y = cvt_pk_bf16(v0[2], v0[3]); w.z = cvt_pk_bf16(v1[0], v1[1]); w.w = cvt_pk_bf16(v1[2], v1[3]);
                    *(u32x4*)(rowp + bj * HALF) = w; } }
    }
};
template <class Epi, class Sched, bool ALIGN_EPI = false, bool SP2 = false>
__device__ __forceinline__ void gemm_phase(PG8_LAS unsigned char* lds, const Gemm g, const Sched& S, const Epi& E, int tid_in) {
    int tid_ = tid_in; asm volatile("" : "+v"(tid_));
    const int tid = tid_, wid = __builtin_amdgcn_readfirstlane(tid >> 6), lane = tid & 63, wr = wid >> 2, wc = wid & 3, fr = lane & 15, fq = lane >> 4;
    const int K = g.K, nt = K / BK;
    unsigned voffA[2], voffB[2];
#pragma unroll
    for (int i = 0; i < 2; ++i) { int R, C; stage_rc(tid * 16 + i * 8192, R, C); const int Rb = Epi::PERM ? ((R & ~31) + perm32(R & 31)) : R;
        voffA[i] = (unsigned)(R * (ABlocked<Epi>::v ? BK : K) + C) * 2u; voffB[i] = (unsigned)(Rb * K + C) * 2u; }
    const size_t kstep = (size_t)(BK * 2);
    const size_t hstep = (size_t)HALF * K * 2;
    const size_t kstepA = ABlocked<Epi>::v ? (size_t)(BM * BK * 2) : kstep, hstepA = ABlocked<Epi>::v ? (size_t)(HALF * BK * 2) : hstep;
    const size_t tstep = 2 * hstep;
    const unsigned ldsw = (unsigned)wid * 1024u;
    const int aoff = lds_byte(wr * 64 + fr, fq * 8), boff = lds_byte(wc * 32 + fr, fq * 8);
#define PG8_SA(b, h) (((b) * 2 + (h)) * HTB)
#define PG8_SB(b, h) ((4 + (b) * 2 + (h)) * HTB)
#define PG8_STAGE(bufoff, gbase, voff) do { _Pragma("unroll") for (int _i = 0; _i < 2; ++_i) \
        __builtin_amdgcn_global_load_lds((const unsigned*)((const char*)(gbase) + (voff)[_i]), (PG8_LAS unsigned*)(lds + (bufoff) + ldsw + _i * 8192), 16, 0, 0); } while (0)
#define PG8_LDA(dst, b, h) do { _Pragma("unroll") for (int m = 0; m < 4; ++m) _Pragma("unroll") for (int k = 0; k < 2; ++k) dst[m][k] = *(const PG8_LAS bf16x8*)(lds + PG8_SA(b, h) + aoff + m * 2048 + k * 1024); } while (0)
#define PG8_LDB(dst, b, h) do { _Pragma("unroll") for (int n = 0; n < 2; ++n) _Pragma("unroll") for (int k = 0; k < 2; ++k) dst[n][k] = *(const PG8_LAS bf16x8*)(lds + PG8_SB(b, h) + boff + n * 2048 + k * 1024); } while (0)
#define PG8_MMA(ai, bj, At, Bt) do { __builtin_amdgcn_s_setprio(1); _Pragma("unroll") for (int m = 0; m < 4; ++m) _Pragma("unroll") for (int n = 0; n < 2; ++n) _Pragma("unroll") for (int k = 0; k < 2; ++k) \
        acc[ai][bj][m][n] = __builtin_amdgcn_mfma_f32_16x16x32_bf16(Bt[n][k], At[m][k], acc[ai][bj][m][n], 0, 0, 0); __builtin_amdgcn_s_setprio(0); } while (0)
#define PG8_WAIT_V(n) asm volatile("s_waitcnt vmcnt(" #n ")" ::: "memory")
#define PG8_WAIT_L(n) asm volatile("s_waitcnt lgkmcnt(" #n ")" ::: "memory")
#define PG8_BAR __builtin_amdgcn_s_barrier()
#define PG8_SCHED __builtin_amdgcn_sched_barrier(0)
    Unit cur, nxt; int ui = 0;
    if (!S.next(0, cur)) return;
    f32x4 acc[2][2][4][2];
#pragma unroll
    for (int a = 0; a < 2; ++a)
#pragma unroll
        for (int b = 0; b < 2; ++b)
#pragma unroll
            for (int m = 0; m < 4; ++m)
#pragma unroll
                for (int n = 0; n < 2; ++n) acc[a][b][m][n] = (f32x4){0.f, 0.f, 0.f, 0.f};
    bf16x8 At[4][2], B0[2][2], B1[2][2];
    const char* cA = (const char*)g.A + (size_t)cur.pm * tstep; const char* cB = (const char*)g.Bt + (size_t)cur.pn * tstep;
    S.a_ready(cur);
    if constexpr (SP2) {
        PG8_STAGE(PG8_SB(0, 0), cB, voffB); PG8_STAGE(PG8_SB(0, 1), cB + hstep, voffB); PG8_STAGE(PG8_SA(0, 0), cA, voffA); PG8_STAGE(PG8_SA(0, 1), cA + hstepA, voffA);
        if (wr == 1) PG8_BAR;
        PG8_WAIT_V(2); PG8_BAR;
        PG8_STAGE(PG8_SB(1, 0), cB + kstep, voffB); PG8_STAGE(PG8_SA(1, 0), cA + kstepA, voffA); PG8_STAGE(PG8_SB(1, 1), cB + hstep + kstep, voffB);
        PG8_WAIT_V(6); PG8_BAR;
    } else {
        PG8_STAGE(PG8_SB(0, 0), cB, voffB); PG8_STAGE(PG8_SA(0, 0), cA, voffA); PG8_STAGE(PG8_SB(0, 1), cB + hstep, voffB); PG8_STAGE(PG8_SA(0, 1), cA + hstepA, voffA);
        if (wr == 1) PG8_BAR;
        PG8_WAIT_V(4); PG8_BAR;
        PG8_STAGE(PG8_SB(1, 0), cB + kstep, voffB); PG8_STAGE(PG8_SA(1, 0), cA + kstepA, voffA); PG8_STAGE(PG8_SB(1, 1), cB + hstep + kstep, voffB);
        PG8_WAIT_V(6); PG8_BAR;
    }
    for (;;) {
        const bool has_next = S.next(ui + 1, nxt);
        const char* nA = has_next ? (const char*)g.A + (size_t)nxt.pm * tstep : cA; const char* nB = has_next ? (const char*)g.Bt + (size_t)nxt.pn * tstep : cB;
        for (int t = 0; t < nt; t += 2) {
            const bool last = (t == nt - 2);
            const char* a1 = cA + (size_t)(t + 1) * kstepA;
            const char* a2 = last ? nA : cA + (size_t)(t + 2) * kstepA; const char* b2 = last ? nB : cB + (size_t)(t + 2) * kstep;
            const char* a3 = a2 + kstepA; const char* b3 = b2 + kstep;
            if (last && has_next) S.a_ready(nxt);
            if constexpr (SP2) {
            PG8_LDB(B0, 0, 0); PG8_LDB(B1, 0, 1); PG8_SCHED; PG8_LDA(At, 0, 0); PG8_STAGE(PG8_SA(1, 1), a1 + hstepA, voffA);
            PG8_WAIT_V(8); PG8_WAIT_L(0); PG8_BAR; PG8_MMA(0, 0, At, B0); PG8_MMA(0, 1, At, B1); PG8_BAR; PG8_SCHED;
            PG8_LDA(At, 0, 1); PG8_STAGE(PG8_SB(0, 0), b2, voffB); PG8_STAGE(PG8_SB(0, 1), b2 + hstep, voffB); PG8_STAGE(PG8_SA(0, 0), a2, voffA);
            PG8_WAIT_V(8); PG8_WAIT_L(0); PG8_BAR; PG8_MMA(1, 0, At, B0); PG8_MMA(1, 1, At, B1); PG8_BAR; PG8_SCHED;
            PG8_LDB(B0, 1, 0); PG8_LDB(B1, 1, 1); PG8_SCHED; PG8_LDA(At, 1, 0); PG8_STAGE(PG8_SA(0, 1), a2 + hstepA, voffA);
            PG8_WAIT_V(8); PG8_WAIT_L(0); PG8_BAR; PG8_MMA(0, 0, At, B0); PG8_MMA(0, 1, At, B1); PG8_BAR; PG8_SCHED;
            PG8_LDA(At, 1, 1); PG8_STAGE(PG8_SB(1, 0), b3, voffB); PG8_STAGE(PG8_SB(1, 1), b3 + hstep, voffB); PG8_STAGE(PG8_SA(1, 0), a3, voffA);
            PG8_WAIT_V(8); PG8_WAIT_L(0); PG8_BAR; PG8_MMA(1, 0, At, B0); PG8_MMA(1, 1, At, B1); PG8_BAR; PG8_SCHED;
            } else {
            PG8_LDB(B0, 0, 0); PG8_SCHED; PG8_LDA(At, 0, 0); PG8_STAGE(PG8_SA(1, 1), a1 + hstepA, voffA);
            PG8_WAIT_L(8); PG8_BAR; PG8_WAIT_L(0); PG8_MMA(0, 0, At, B0); PG8_BAR; PG8_SCHED;
            PG8_LDB(B1, 0, 1); PG8_STAGE(PG8_SB(0, 0), b2, voffB);
            PG8_BAR; PG8_WAIT_L(0); PG8_MMA(0, 1, At, B1); PG8_BAR;
            PG8_LDA(At, 0, 1); PG8_STAGE(PG8_SA(0, 0), a2, voffA);
            PG8_BAR; PG8_WAIT_L(0); PG8_MMA(1, 0, At, B0); PG8_BAR; PG8_SCHED;
            PG8_STAGE(PG8_SB(0, 1), b2 + hstep, voffB);
            PG8_WAIT_V(6); PG8_BAR; PG8_MMA(1, 1, At, B1); PG8_BAR;
            PG8_LDB(B0, 1, 0); PG8_SCHED; PG8_LDA(At, 1, 0); PG8_STAGE(PG8_SA(0, 1), a2 + hstepA, voffA);
            PG8_WAIT_L(8); PG8_BAR; PG8_WAIT_L(0); PG8_MMA(0, 0, At, B0); PG8_BAR; PG8_SCHED;
            PG8_LDB(B1, 1, 1); PG8_STAGE(PG8_SB(1, 0), b3, voffB);
            PG8_BAR; PG8_WAIT_L(0); PG8_MMA(0, 1, At, B1); PG8_BAR;
            PG8_LDA(At, 1, 1); PG8_STAGE(PG8_SA(1, 0), a3, voffA);
            PG8_BAR; PG8_WAIT_L(0); PG8_MMA(1, 0, At, B0); PG8_BAR; PG8_SCHED;
            PG8_STAGE(PG8_SB(1, 1), b3 + hstep, voffB);
            PG8_WAIT_V(6); PG8_BAR; PG8_MMA(1, 1, At, B1); PG8_BAR;
            }
        }
        if constexpr (ALIGN_EPI) { if (wr == 0) PG8_BAR; }
        if constexpr (!Epi::AFTER_DRAIN) { E(acc, cur, wr, wc, fr, fq); S.done(cur); }
        if (!has_next) break;
#pragma unroll
        for (int a = 0; a < 2; ++a)
#pragma unroll
            for (int b = 0; b < 2; ++b)
#pragma unroll
                for (int m = 0; m < 4; ++m)
#pragma unroll
                    for (int n = 0; n < 2; ++n) acc[a][b][m][n] = (f32x4){0.f, 0.f, 0.f, 0.f};
        cur = nxt; cA = nA; cB = nB; ++ui;
        if constexpr (ALIGN_EPI) { if (wr == 1) PG8_BAR; }
    }
    PG8_WAIT_V(0);
    if constexpr (!ALIGN_EPI) { if (wr == 0) PG8_BAR; }
    PG8_BAR;
    if constexpr (Epi::AFTER_DRAIN) { E.fused(acc, cur, wr, wc, fr, fq, lds, wid, lane); S.done(cur); }
#undef PG8_SA
#undef PG8_SB
#undef PG8_STAGE
#undef PG8_LDA
#undef PG8_LDB
#undef PG8_MMA
#undef PG8_WAIT_V
#undef PG8_WAIT_L
#undef PG8_BAR
#undef PG8_SCHED
}

template <class Epi0, class Epi1, class Sched>
__device__ __forceinline__ void gemm_stream2(PG8_LAS unsigned char* lds, const Gemm2 g, const Sched& S, const Epi0& E0, const Epi1& E1, int tid_in) {
    static_assert(Epi0::PERM == Epi1::PERM && !Epi0::AFTER_DRAIN && !Epi1::AFTER_DRAIN, "gemm_stream2: same accumulator layout, in-loop epilogues");
    int tid_ = tid_in; asm volatile("" : "+v"(tid_));
    const int tid = tid_, wid = __builtin_amdgcn_readfirstlane(tid >> 6), lane = tid & 63, wr = wid >> 2, wc = wid & 3, fr = lane & 15, fq = lane >> 4;
    int rA[2], rB[2], cC[2];
#pragma unroll
    for (int i = 0; i < 2; ++i) { int R, C; stage_rc(tid * 16 + i * 8192, R, C); rA[i] = R; rB[i] = Epi0::PERM ? ((R & ~31) + perm32(R & 31)) : R; cC[i] = C; }
    const size_t kstep = (size_t)(BK * 2);
    const unsigned ldsw = (unsigned)wid * 1024u;
    const int aoff = lds_byte(wr * 64 + fr, fq * 8), boff = lds_byte(wc * 32 + fr, fq * 8);
#define PG8_SA(b, h) (((b) * 2 + (h)) * HTB)
#define PG8_SB(b, h) ((4 + (b) * 2 + (h)) * HTB)
#define PG8_STAGE(bufoff, gbase, voff) do { _Pragma("unroll") for (int _i = 0; _i < 2; ++_i) \
        __builtin_amdgcn_global_load_lds((const unsigned*)((const char*)(gbase) + (voff)[_i]), (PG8_LAS unsigned*)(lds + (bufoff) + ldsw + _i * 8192), 16, 0, 0); } while (0)
#define PG8_LDA(dst, b, h) do { _Pragma("unroll") for (int m = 0; m < 4; ++m) _Pragma("unroll") for (int k = 0; k < 2; ++k) dst[m][k] = *(const PG8_LAS bf16x8*)(lds + PG8_SA(b, h) + aoff + m * 2048 + k * 1024); } while (0)
#define PG8_LDB(dst, b, h) do { _Pragma("unroll") for (int n = 0; n < 2; ++n) _Pragma("unroll") for (int k = 0; k < 2; ++k) dst[n][k] = *(const PG8_LAS bf16x8*)(lds + PG8_SB(b, h) + boff + n * 2048 + k * 1024); } while (0)
#define PG8_MMA(ai, bj, At, Bt) do { __builtin_amdgcn_s_setprio(1); _Pragma("unroll") for (int m = 0; m < 4; ++m) _Pragma("unroll") for (int n = 0; n < 2; ++n) _Pragma("unroll") for (int k = 0; k < 2; ++k) \
        acc[ai][bj][m][n] = __builtin_amdgcn_mfma_f32_16x16x32_bf16(Bt[n][k], At[m][k], acc[ai][bj][m][n], 0, 0, 0); __builtin_amdgcn_s_setprio(0); } while (0)
#define PG8_WAIT_V(n) asm volatile("s_waitcnt vmcnt(" #n ")" ::: "memory")
#define PG8_WAIT_L(n) asm volatile("s_waitcnt lgkmcnt(" #n ")" ::: "memory")
#define PG8_BAR __builtin_amdgcn_s_barrier()
#define PG8_SCHED __builtin_amdgcn_sched_barrier(0)
    Unit cur, nxt; int ui = 0;
    if (!S.next(0, cur)) return;
    f32x4 acc[2][2][4][2];
#pragma unroll
    for (int a = 0; a < 2; ++a)
#pragma unroll
        for (int b = 0; b < 2; ++b)
#pragma unroll
            for (int m = 0; m < 4; ++m)
#pragma unroll
                for (int n = 0; n < 2; ++n) acc[a][b][m][n] = (f32x4){0.f, 0.f, 0.f, 0.f};
    bf16x8 At[4][2], B0[2][2], B1[2][2];
    int Kc = cur.g ? g.K[1] : g.K[0];
    size_t hsc = (size_t)HALF * Kc * 2;
    const char* cA = (const char*)(cur.g ? g.A[1] : g.A[0]) + (size_t)cur.pm * 2 * hsc; const char* cB = (const char*)(cur.g ? g.Bt[1] : g.Bt[0]) + (size_t)cur.pn * 2 * hsc;
    unsigned vAc[2], vBc[2];
#pragma unroll
    for (int i = 0; i < 2; ++i) { vAc[i] = (unsigned)(rA[i] * Kc + cC[i]) * 2u; vBc[i] = (unsigned)(rB[i] * Kc + cC[i]) * 2u; }
    PG8_STAGE(PG8_SB(0, 0), cB, vBc); PG8_STAGE(PG8_SB(0, 1), cB + hsc, vBc); PG8_STAGE(PG8_SA(0, 0), cA, vAc); PG8_STAGE(PG8_SA(0, 1), cA + hsc, vAc);
    if (wr == 1) PG8_BAR;
    PG8_WAIT_V(2); PG8_BAR;
    PG8_STAGE(PG8_SB(1, 0), cB + kstep, vBc); PG8_STAGE(PG8_SA(1, 0), cA + kstep, vAc); PG8_STAGE(PG8_SB(1, 1), cB + hsc + kstep, vBc);
    PG8_WAIT_V(6); PG8_BAR;
    for (;;) {
        const bool has_next = S.next(ui + 1, nxt);
        const int Kn = has_next ? (nxt.g ? g.K[1] : g.K[0]) : Kc;
        const size_t hsn = (size_t)HALF * Kn * 2;
        const char* nA = has_next ? (const char*)(nxt.g ? g.A[1] : g.A[0]) + (size_t)nxt.pm * 2 * hsn : cA; const char* nB = has_next ? (const char*)(nxt.g ? g.Bt[1] : g.Bt[0]) + (size_t)nxt.pn * 2 * hsn : cB;
        unsigned vAn[2], vBn[2];
#pragma unroll
        for (int i = 0; i < 2; ++i) { vAn[i] = (unsigned)(rA[i] * Kn + cC[i]) * 2u; vBn[i] = (unsigned)(rB[i] * Kn + cC[i]) * 2u; }
        const int nt = Kc / BK;
        for (int t = 0; t < nt; t += 2) {
            const bool last = (t == nt - 2);
            const char* a1 = cA + (size_t)(t + 1) * kstep;
            const char* a2 = last ? nA : cA + (size_t)(t + 2) * kstep; const char* b2 = last ? nB : cB + (size_t)(t + 2) * kstep;
            const char* a3 = a2 + kstep; const char* b3 = b2 + kstep;
            const size_t hs2 = last ? hsn : hsc;
            unsigned vA2[2], vB2[2];
#pragma unroll
            for (int i = 0; i < 2; ++i) { vA2[i] = last ? vAn[i] : vAc[i]; vB2[i] = last ? vBn[i] : vBc[i]; }
            PG8_LDB(B0, 0, 0); PG8_LDB(B1, 0, 1); PG8_SCHED; PG8_LDA(At, 0, 0); PG8_STAGE(PG8_SA(1, 1), a1 + hsc, vAc);
            PG8_WAIT_V(8); PG8_WAIT_L(0); PG8_BAR; PG8_MMA(0, 0, At, B0); PG8_MMA(0, 1, At, B1); PG8_BAR; PG8_SCHED;
            PG8_LDA(At, 0, 1); PG8_STAGE(PG8_SB(0, 0), b2, vB2); PG8_STAGE(PG8_SB(0, 1), b2 + hs2, vB2); PG8_STAGE(PG8_SA(0, 0), a2, vA2);
            PG8_WAIT_V(8); PG8_WAIT_L(0); PG8_BAR; PG8_MMA(1, 0, At, B0); PG8_MMA(1, 1, At, B1); PG8_BAR; PG8_SCHED;
            PG8_LDB(B0, 1, 0); PG8_LDB(B1, 1, 1); PG8_SCHED; PG8_LDA(At, 1, 0); PG8_STAGE(PG8_SA(0, 1), a2 + hs2, vA2);
            PG8_WAIT_V(8); PG8_WAIT_L(0); PG8_BAR; PG8_MMA(0, 0, At, B0); PG8_MMA(0, 1, At, B1); PG8_BAR; PG8_SCHED;
            PG8_LDA(At, 1, 1); PG8_STAGE(PG8_SB(1, 0), b3, vB2); PG8_STAGE(PG8_SB(1, 1), b3 + hs2, vB2); PG8_STAGE(PG8_SA(1, 0), a3, vA2);
            PG8_WAIT_V(8); PG8_WAIT_L(0); PG8_BAR; PG8_MMA(1, 0, At, B0); PG8_MMA(1, 1, At, B1); PG8_BAR; PG8_SCHED;
        }
        if (wr == 0) PG8_BAR;
        if (cur.g == 0) E0(acc, cur, wr, wc, fr, fq); else E1(acc, cur, wr, wc, fr, fq);
        if (!has_next) break;
#pragma unroll
        for (int a = 0; a < 2; ++a)
#pragma unroll
            for (int b = 0; b < 2; ++b)
#pragma unroll
                for (int m = 0; m < 4; ++m)
#pragma unroll
                    for (int n = 0; n < 2; ++n) acc[a][b][m][n] = (f32x4){0.f, 0.f, 0.f, 0.f};
        cur = nxt; cA = nA; cB = nB; Kc = Kn; hsc = hsn; ++ui;
#pragma unroll
        for (int i = 0; i < 2; ++i) { vAc[i] = vAn[i]; vBc[i] = vBn[i]; }
        if (wr == 1) PG8_BAR;
    }
    PG8_WAIT_V(0);
    PG8_BAR;
#undef PG8_SA
#undef PG8_SB
#undef PG8_STAGE
#undef PG8_LDA
#undef PG8_LDB
#undef PG8_MMA
#undef PG8_WAIT_V
#undef PG8_WAIT_L
#undef PG8_BAR
#undef PG8_SCHED
}
}
namespace pg8 {
typedef unsigned u32x2 __attribute__((ext_vector_type(2)));
__device__ __forceinline__ float bf_lo(unsigned w) { return __builtin_bit_cast(float, w << 16); }
__device__ __forceinline__ float bf_hi(unsigned w) { return __builtin_bit_cast(float, w & 0xffff0000u); }
__device__ __forceinline__ float sigm_l2(float y) { return __builtin_amdgcn_rcpf(1.0f + __builtin_amdgcn_exp2f(y)); }
__device__ __forceinline__ float sigm(float x) { return __builtin_amdgcn_rcpf(1.0f + __expf(-x)); }

__device__ __forceinline__ float row_rstd(const float* ssq, size_t row) {
    const f32x4 a = *(const f32x4*)(ssq + row * 16), b = *(const f32x4*)(ssq + row * 16 + 4), c = *(const f32x4*)(ssq + row * 16 + 8), d = *(const f32x4*)(ssq + row * 16 + 12);
    const float s = ((a.x + a.y) + (a.z + a.w)) + ((b.x + b.y) + (b.z + b.w)) + ((c.x + c.y) + (c.z + c.w)) + ((d.x + d.y) + (d.z + d.w));
    return 1.0f / sqrtf(s * (1.0f / 1024.0f) + 1e-6f);
}
constexpr int RSTD_CAP = 12;
struct RstdTab { const PG8_LAS float* tab;
    __device__ __forceinline__ float get(const Unit& u, int lrow) const { return tab[u.idx * 256 + lrow]; } };
struct EpiProj {
    static constexpr bool PERM = true, AFTER_DRAIN = false;
    bf16_t *U, *Q, *KV, *QKG, *VG, *RG; float* SMALL; const float* rope; RstdTab RS; int Mrows; bf16_t *VST, *VWT; int seq;
    __device__ __forceinline__ void operator()(const f32x4 (&acc)[2][2][4][2], const Unit& u, int wr, int wc, int fr, int fq) const {
        const int pn = u.pn, row0 = u.pm * BM + wr * 64 + fr;
        if (pn == 13) {
            if (wc < 2) {
#pragma unroll
                for (int ai = 0; ai < 2; ++ai)
#pragma unroll
                    for (int m = 0; m < 4; ++m) { const size_t row = (size_t)(row0 + ai * HALF + m * 16); const float rs = RS.get(u, wr * 64 + fr + ai * HALF + m * 16); float* rp = SMALL + row * 64 + wc * 32 + 8 * fq;
                        *(f32x4*)rp = acc[ai][0][m][0] * rs; *(f32x4*)(rp + 4) = acc[ai][0][m][1] * rs; }
            }
            return;
        }
        bf16_t* base; int ld, colt; bool isq = false, iskv = false;
        if (pn < 2) { base = U; ld = 512; colt = pn * 256; }
        else if (pn < 4) { base = Q; ld = 512; colt = (pn - 2) * 256; isq = true; }
        else if (pn < 7) { base = KV; ld = 768; colt = (pn - 4) * 256; iskv = true; }
        else if (pn < 9) { base = QKG; ld = 512; colt = (pn - 7) * 256; }
        else if (pn < 11) { base = VG; ld = 512; colt = (pn - 9) * 256; }
        else { base = RG; ld = 512; colt = (pn - 11) * 256; }
        const int col0 = colt + wc * 32 + 8 * fq;
        const float sc = isq ? 0.125f * 1.4426950408889634f : 1.0f;
        const bool ropew = (isq || iskv) && ((wc & 1) == 0);
#pragma unroll
        for (int ap = 0; ap < 4; ++ap) {
            const int ai = ap >> 1;
            f32x4 rc[2][4];
#pragma unroll
            for (int mm = 0; mm < 2; ++mm)
#pragma unroll
                for (int q = 0; q < 4; ++q) rc[mm][q] = (ropew && fq < 2) ? *(const f32x4*)(rope + (size_t)(row0 + ai * HALF + (2 * (ap & 1) + mm) * 16) * 16 + 4 * q) : (f32x4){0.f, 0.f, 0.f, 0.f};
            float rsr[2];
#pragma unroll
            for (int mm = 0; mm < 2; ++mm) rsr[mm] = RS.get(u, wr * 64 + fr + ai * HALF + (2 * (ap & 1) + mm) * 16) * sc;
#pragma unroll
            for (int mm = 0; mm < 2; ++mm) {
                const int m = 2 * (ap & 1) + mm;
                const int row = row0 + ai * HALF + m * 16;
                bf16_t* rowp = base + (size_t)row * ld + col0;
#pragma unroll
                for (int bj = 0; bj < 2; ++bj) {
                    f32x4 v0 = acc[ai][bj][m][0] * rsr[mm], v1 = acc[ai][bj][m][1] * rsr[mm];
                    if (ropew && (isq || bj == 0)) {
                        f32x4 o0, o1;
#pragma unroll
                        for (int e = 0; e < 4; ++e) { o0[e] = __shfl_xor(v0[e], 16); o1[e] = __shfl_xor(v1[e], 16); }
                        if (fq < 2) {
                            const float sg = (fq == 0) ? -1.0f : 1.0f;
                            v0 = v0 * rc[mm][0] + (o0 * rc[mm][2]) * sg; v1 = v1 * rc[mm][1] + (o1 * rc[mm][3]) * sg;
                        }
                    }
                    u32x4 w; w.x = cvt_pk_bf16(v0[0], v0[1]); w.y = cvt_pk_bf16(v0[2], v0[3]); w.z = cvt_pk_bf16(v1[0], v1[1]); w.w = cvt_pk_bf16(v1[2], v1[3]);
                    if (iskv && bj == 1 && pn >= 5) {
                        const int bb = row / seq, tl = row - bb * seq;
                        bf16_t* vt = (pn == 5 ? VST : VWT) + ((size_t)((bb * 2 + (wc >> 1)) * (seq >> 6) + (tl >> 6)) * 64 + 32 * (wc & 1) + 8 * fq) * 64 + (tl & 63);
                        vt[0 * 64] = (bf16_t)(w.x & 0xffffu); vt[1 * 64] = (bf16_t)(w.x >> 16); vt[2 * 64] = (bf16_t)(w.y & 0xffffu); vt[3 * 64] = (bf16_t)(w.y >> 16);
                        vt[4 * 64] = (bf16_t)(w.z & 0xffffu); vt[5 * 64] = (bf16_t)(w.z >> 16); vt[6 * 64] = (bf16_t)(w.w & 0xffffu); vt[7 * 64] = (bf16_t)(w.w >> 16); }
                    else if (iskv) *(u32x4*)(KV + ((size_t)((2 * (pn - 4) + bj) * 2 + (wc >> 1)) * Mrows + row) * 64 + 32 * (wc & 1) + 8 * fq) = w;
                    else *(u32x4*)(rowp + bj * HALF) = w;
                }
            }
        }
    }
};

template <int FN> struct EpiAct {
    static constexpr bool PERM = true, AFTER_DRAIN = false;
    bf16_t* O; int ldc;
    __device__ __forceinline__ void operator()(const f32x4 (&acc)[2][2][4][2], const Unit& u, int wr, int wc, int fr, int fq) const {
        const int row0 = u.pm * BM + wr * 64 + fr, col0 = u.pn * BM + wc * 32 + 8 * fq;
#pragma unroll
        for (int ai = 0; ai < 2; ++ai)
#pragma unroll
            for (int m = 0; m < 4; ++m) { bf16_t* rowp = O + (size_t)(row0 + ai * HALF + m * 16) * ldc + col0;
#pragma unroll
                for (int bj = 0; bj < 2; ++bj) { f32x4 v0 = acc[ai][bj][m][0], v1 = acc[ai][bj][m][1];
                    if (FN == 1) {
#pragma unroll
                        for (int e = 0; e < 4; ++e) { v0[e] = sigm(v0[e]); v1[e] = sigm(v1[e]); } }
                    if (FN == 2) {
#pragma unroll
                        for (int e = 0; e < 4; ++e) { const float a = fmaxf(v0[e], 0.f), b = fmaxf(v1[e], 0.f); v0[e] = a * a; v1[e] = b * b; } }
                    u32x4 w; w.x = cvt_pk_bf16(v0[0], v0[1]); w.y = cvt_pk_bf16(v0[2], v0[3]); w.z = cvt_pk_bf16(v1[0], v1[1]); w.w = cvt_pk_bf16(v1[2], v1[3]);
                    *(u32x4*)(rowp + bj * HALF) = w; } }
    }
};

template <bool FIRST> struct EpiBranch {
    static constexpr bool PERM = true, AFTER_DRAIN = false;
    bf16_t* MG; const bf16_t* GM; int kofs;
    __device__ __forceinline__ void operator()(const f32x4 (&acc)[2][2][4][2], const Unit& u, int wr, int wc, int fr, int fq) const {
        const int row0 = u.pm * BM + wr * 64 + fr, col0 = u.pn * BM + wc * 32 + 8 * fq;
#pragma unroll
        for (int ai = 0; ai < 2; ++ai) {
            u32x4 gw[4][2], ow[4][2];
#pragma unroll
            for (int m = 0; m < 4; ++m)
#pragma unroll
                for (int bj = 0; bj < 2; ++bj) { const size_t row = (size_t)(row0 + ai * HALF + m * 16);
                    gw[m][bj] = *(const u32x4*)(GM + row * 3072 + kofs + col0 + bj * HALF);
                    if (!FIRST) ow[m][bj] = *(const u32x4*)(MG + row * 1024 + col0 + bj * HALF); }
#pragma unroll
            for (int m = 0; m < 4; ++m)
#pragma unroll
                for (int bj = 0; bj < 2; ++bj) { const size_t row = (size_t)(row0 + ai * HALF + m * 16);
                    f32x4 v0 = acc[ai][bj][m][0], v1 = acc[ai][bj][m][1]; const u32x4 g = gw[m][bj];
                    v0[0] *= bf_lo(g.x); v0[1] *= bf_hi(g.x); v0[2] *= bf_lo(g.y); v0[3] *= bf_hi(g.y);
                    v1[0] *= bf_lo(g.z); v1[1] *= bf_hi(g.z); v1[2] *= bf_lo(g.w); v1[3] *= bf_hi(g.w);
                    if (!FIRST) { const u32x4 o = ow[m][bj];
                        v0[0] += bf_lo(o.x); v0[1] += bf_hi(o.x); v0[2] += bf_lo(o.y); v0[3] += bf_hi(o.y);
                        v1[0] += bf_lo(o.z); v1[1] += bf_hi(o.z); v1[2] += bf_lo(o.w); v1[3] += bf_hi(o.w); }
                    u32x4 w; w.x = cvt_pk_bf16(v0[0], v0[1]); w.y = cvt_pk_bf16(v0[2], v0[3]); w.z = cvt_pk_bf16(v1[0], v1[1]); w.w = cvt_pk_bf16(v1[2], v1[3]);
                    *(u32x4*)(MG + row * 1024 + col0 + bj * HALF) = w; }
        }
    }
};

struct BranchOrder {
    StaticOrder S0; int per, nM;
    __device__ __forceinline__ void init(int M, int N, int G, int c) { S0.init(M, N, G, c); nM = M / BM; per = 0; Unit u; while (S0.next(per, u)) ++per; }
    __device__ __forceinline__ bool next(int i, Unit& u) const {
        if (i >= 3 * per) return false;
        const int k = (i >= 2 * per) ? 2 : ((i >= per) ? 1 : 0);
        if (!S0.next(i - k * per, u)) return false;
        u.pm += k * nM; u.pn += 4 * k; u.idx = i; return true;
    }
    __device__ __forceinline__ void a_ready(const Unit&) const {}
    __device__ __forceinline__ void done(const Unit&) const {}
};
struct GateBranchOrder {
    StaticOrder S0; int per, nM;
    __device__ __forceinline__ void init(int M, int N, int G, int c) { S0.init(M, N, G, c); nM = M / BM; per = 0; Unit u; while (S0.next(per, u)) ++per; }
    __device__ __forceinline__ bool next(int i, Unit& u) const {
        if (i >= 6 * per) return false;
        const int j = i / 6, r = i - 6 * j, k = r >> 1;
        if (!S0.next(j, u)) return false;
        if (r & 1) { u.g = 1; u.pm += k * nM; u.pn += 4 * k; u.idx = i; }
        else { u.g = 0; u.pn += 4 * k; u.idx = j; }
        return true;
    }
};
struct PlePairOrder {
    StaticOrder S0; int per;
    __device__ __forceinline__ void init(int M, int N, int G, int c) { S0.init(M, N, G, c); per = 0; Unit u; while (S0.next(per, u)) ++per; }
    __device__ __forceinline__ bool next(int i, Unit& u) const {
        if (i >= 2 * per) return false;
        const int j = i >> 1;
        if (!S0.next(j, u)) return false;
        u.g = i & 1; u.idx = j; return true;
    }
};
struct EpiTile {
    static constexpr bool PERM = true, AFTER_DRAIN = false;
    bf16_t* T;
    __device__ __forceinline__ void operator()(const f32x4 (&acc)[2][2][4][2], const Unit& u, int wr, int wc, int fr, int fq) const {
        int lofs = (wr * 64 + fr) * 256 + wc * 32 + 8 * fq; asm volatile("" : "+v"(lofs));
#pragma unroll
        for (int ai = 0; ai < 2; ++ai)
#pragma unroll
            for (int m = 0; m < 4; ++m)
#pragma unroll
                for (int bj = 0; bj < 2; ++bj) { const f32x4 v0 = acc[ai][bj][m][0], v1 = acc[ai][bj][m][1];
                    u32x4 w; w.x = cvt_pk_bf16(v0[0], v0[1]); w.y = cvt_pk_bf16(v0[2], v0[3]); w.z = cvt_pk_bf16(v1[0], v1[1]); w.w = cvt_pk_bf16(v1[2], v1[3]);
                    *(u32x4*)(T + lofs + (ai * HALF + m * 16) * 256 + bj * HALF) = w; }
    }
};
struct EpiBranchR {
    static constexpr bool PERM = true, AFTER_DRAIN = false;
    bf16_t* MG; const bf16_t* GM; bf16_t* PS; int nM;
    __device__ __forceinline__ void operator()(const f32x4 (&acc)[2][2][4][2], const Unit& u, int wr, int wc, int fr, int fq) const {
        const int k = (u.pm >= 2 * nM) ? 2 : ((u.pm >= nM) ? 1 : 0), pm = u.pm - k * nM, pn = u.pn - 4 * k;
        const int row0 = pm * BM + wr * 64 + fr, col0 = pn * BM + wc * 32 + 8 * fq;
        int lofs = (wr * 64 + fr) * 256 + wc * 32 + 8 * fq; asm volatile("" : "+v"(lofs));
#pragma unroll
        for (int ai = 0; ai < 2; ++ai) {
            u32x4 gw[4][2], ow[4][2];
#pragma unroll
            for (int m = 0; m < 4; ++m)
#pragma unroll
                for (int bj = 0; bj < 2; ++bj) { const size_t row = (size_t)(row0 + ai * HALF + m * 16);
                    gw[m][bj] = *(const u32x4*)(GM + lofs + (ai * HALF + m * 16) * 256 + bj * HALF);
                    ow[m][bj] = (k != 0) ? *(const u32x4*)(PS + lofs + (ai * HALF + m * 16) * 256 + bj * HALF) : (u32x4){0u, 0u, 0u, 0u}; }
#pragma unroll
            for (int m = 0; m < 4; ++m)
#pragma unroll
                for (int bj = 0; bj < 2; ++bj) { const size_t row = (size_t)(row0 + ai * HALF + m * 16);
                    f32x4 v0 = acc[ai][bj][m][0], v1 = acc[ai][bj][m][1]; const u32x4 g = gw[m][bj], o = ow[m][bj];
                    v0[0] = v0[0] * bf_lo(g.x) + bf_lo(o.x); v0[1] = v0[1] * bf_hi(g.x) + bf_hi(o.x); v0[2] = v0[2] * bf_lo(g.y) + bf_lo(o.y); v0[3] = v0[3] * bf_hi(g.y) + bf_hi(o.y);
                    v1[0] = v1[0] * bf_lo(g.z) + bf_lo(o.z); v1[1] = v1[1] * bf_hi(g.z) + bf_hi(o.z); v1[2] = v1[2] * bf_lo(g.w) + bf_lo(o.w); v1[3] = v1[3] * bf_hi(g.w) + bf_hi(o.w);
                    u32x4 w; w.x = cvt_pk_bf16(v0[0], v0[1]); w.y = cvt_pk_bf16(v0[2], v0[3]); w.z = cvt_pk_bf16(v1[0], v1[1]); w.w = cvt_pk_bf16(v1[2], v1[3]);
                    if (k == 2) *(u32x4*)(MG + row * 1024 + col0 + bj * HALF) = w; else *(u32x4*)(PS + lofs + (ai * HALF + m * 16) * 256 + bj * HALF) = w; }
        }
    }
};

struct EpiRes {
    static constexpr bool PERM = false, AFTER_DRAIN = false;
    const float* in; float* out;
    __device__ __forceinline__ void operator()(const f32x4 (&acc)[2][2][4][2], const Unit& u, int wr, int wc, int fr, int fq) const {
        const int row0 = u.pm * BM + wr * 64 + fr, col0 = u.pn * BM + wc * 32 + 4 * fq;
#pragma unroll
        for (int ai = 0; ai < 2; ++ai)
#pragma unroll
            for (int m = 0; m < 4; ++m) { const size_t off = (size_t)(row0 + ai * HALF + m * 16) * 1024 + col0;
#pragma unroll
                for (int bj = 0; bj < 2; ++bj)
#pragma unroll
                    for (int n = 0; n < 2; ++n) { const f32x4 b = *(const f32x4*)(in + off + bj * HALF + n * 16); *(f32x4*)(out + off + bj * HALF + n * 16) = b + acc[ai][bj][m][n]; } }
    }
};

struct EpiPle {
    static constexpr bool PERM = false, AFTER_DRAIN = false;
    float* h; const bf16_t* PP;
    __device__ __forceinline__ void operator()(const f32x4 (&acc)[2][2][4][2], const Unit& u, int wr, int wc, int fr, int fq) const {
        const int row0 = u.pm * BM + wr * 64 + fr, col0 = u.pn * BM + wc * 32 + 4 * fq;
#pragma unroll
        for (int ai = 0; ai < 2; ++ai)
#pragma unroll
            for (int m = 0; m < 4; ++m) { const size_t off = (size_t)(row0 + ai * HALF + m * 16) * 1024 + col0;
#pragma unroll
                for (int bj = 0; bj < 2; ++bj)
#pragma unroll
                    for (int n = 0; n < 2; ++n) { const size_t o = off + bj * HALF + n * 16; const u32x2 pw = *(const u32x2*)(PP + o); const f32x4 b = *(const f32x4*)(h + o); const f32x4 a = acc[ai][bj][m][n];
                        f32x4 r; r[0] = b[0] + sigm(a[0]) * bf_lo(pw.x); r[1] = b[1] + sigm(a[1]) * bf_hi(pw.x); r[2] = b[2] + sigm(a[2]) * bf_lo(pw.y); r[3] = b[3] + sigm(a[3]) * bf_hi(pw.y);
                        *(f32x4*)(h + o) = r; } }
    }
};
struct EpiResN {
    static constexpr bool PERM = false, AFTER_DRAIN = false;
    const float* in; float* out; bf16_t* HB; float* SSQ;
    __device__ __forceinline__ void operator()(const f32x4 (&acc)[2][2][4][2], const Unit& u, int wr, int wc, int fr, int fq) const {
        const int row0 = u.pm * BM + wr * 64 + fr, col0 = u.pn * BM + wc * 32 + 4 * fq;
#pragma unroll
        for (int ai = 0; ai < 2; ++ai) {
            f32x4 iv[4][2][2];
#pragma unroll
            for (int m = 0; m < 4; ++m)
#pragma unroll
                for (int bj = 0; bj < 2; ++bj)
#pragma unroll
                    for (int n = 0; n < 2; ++n) iv[m][bj][n] = *(const f32x4*)(in + (size_t)(row0 + ai * HALF + m * 16) * 1024 + col0 + bj * HALF + n * 16);
#pragma unroll
            for (int m = 0; m < 4; ++m) { const size_t row = (size_t)(row0 + ai * HALF + m * 16); const size_t off = row * 1024 + col0; float ss = 0.f;
#pragma unroll
                for (int bj = 0; bj < 2; ++bj)
#pragma unroll
                    for (int n = 0; n < 2; ++n) { const size_t o = off + bj * HALF + n * 16; const f32x4 v = iv[m][bj][n] + acc[ai][bj][m][n]; *(f32x4*)(out + o) = v;
                        u32x2 w; w.x = cvt_pk_bf16(v[0], v[1]); w.y = cvt_pk_bf16(v[2], v[3]); *(u32x2*)(HB + o) = w;
                        ss += (v[0] * v[0] + v[1] * v[1]) + (v[2] * v[2] + v[3] * v[3]); }
                ss += __shfl_xor(ss, 16); ss += __shfl_xor(ss, 32);
                if (fq == 0) SSQ[row * 16 + u.pn * 4 + wc] = ss; }
        }
    }
};
template <bool NORS> struct EpiRelu2NT {
    static constexpr bool PERM = true, AFTER_DRAIN = false;
    bf16_t* O; int ldc; RstdTab RS;
    __device__ __forceinline__ void operator()(const f32x4 (&acc)[2][2][4][2], const Unit& u, int wr, int wc, int fr, int fq) const {
        const int row0 = u.pm * BM + wr * 64 + fr, col0 = u.pn * BM + wc * 32 + 8 * fq;
#pragma unroll
        for (int ai = 0; ai < 2; ++ai) {
            float rs[4];
#pragma unroll
            for (int m = 0; m < 4; ++m) rs[m] = NORS ? 1.0f : RS.get(u, wr * 64 + fr + ai * HALF + m * 16);
#pragma unroll
            for (int m = 0; m < 4; ++m) { bf16_t* rowp = O + (size_t)u.pm * ((size_t)ldc * BM) + (size_t)(u.pn * 4 + (wc >> 1)) * (BM * BK) + (wr * 64 + fr + ai * HALF + m * 16) * BK + (wc & 1) * 32 + 8 * fq;
#pragma unroll
                for (int bj = 0; bj < 2; ++bj) { f32x4 v0 = acc[ai][bj][m][0] * rs[m], v1 = acc[ai][bj][m][1] * rs[m];
#pragma unroll
                    for (int e = 0; e < 4; ++e) { v0[e] = fmaxf(v0[e], 0.f); v1[e] = fmaxf(v1[e], 0.f); }
                    v0 = v0 * v0; v1 = v1 * v1;
                    u32x4 w; w.x = cvt_pk_bf16(v0[0], v0[1]); w.y = cvt_pk_bf16(v0[2], v0[3]); w.z = cvt_pk_bf16(v1[0], v1[1]); w.w = cvt_pk_bf16(v1[2], v1[3]);
                    *(u32x4*)(rowp + bj * (2 * BM * BK)) = w; } }
        }
    }
};
typedef EpiRelu2NT<false> EpiRelu2N;
struct EpiPleN {
    static constexpr bool PERM = false, AFTER_DRAIN = false;
    float* h; const bf16_t* PP; const float* SSQ;
    __device__ __forceinline__ void operator()(const f32x4 (&acc)[2][2][4][2], const Unit& u, int wr, int wc, int fr, int fq) const {
        const int row0 = u.pm * BM + wr * 64 + fr, col0 = u.pn * BM + wc * 32 + 4 * fq;
#pragma unroll
        for (int ai = 0; ai < 2; ++ai)
#pragma unroll
            for (int mp = 0; mp < 2; ++mp) {
                float rs[2]; f32x4 hv[2][2][2]; u32x2 pw[2][2][2];
#pragma unroll
                for (int mm = 0; mm < 2; ++mm) { const size_t row = (size_t)(row0 + ai * HALF + (2 * mp + mm) * 16); rs[mm] = row_rstd(SSQ, row);
#pragma unroll
                    for (int bj = 0; bj < 2; ++bj)
#pragma unroll
                        for (int n = 0; n < 2; ++n) { const size_t o = row * 1024 + col0 + bj * HALF + n * 16; hv[mm][bj][n] = *(const f32x4*)(h + o); pw[mm][bj][n] = *(const u32x2*)(PP + o); } }
#pragma unroll
                for (int mm = 0; mm < 2; ++mm) { const int m = 2 * mp + mm; const size_t row = (size_t)(row0 + ai * HALF + m * 16);
#pragma unroll
                    for (int bj = 0; bj < 2; ++bj)
#pragma unroll
                        for (int n = 0; n < 2; ++n) { const size_t o = row * 1024 + col0 + bj * HALF + n * 16; const f32x4 a = acc[ai][bj][m][n] * rs[mm], b = hv[mm][bj][n]; const u32x2 p = pw[mm][bj][n];
                            f32x4 r; r[0] = b[0] + sigm(a[0]) * bf_lo(p.x); r[1] = b[1] + sigm(a[1]) * bf_hi(p.x); r[2] = b[2] + sigm(a[2]) * bf_lo(p.y); r[3] = b[3] + sigm(a[3]) * bf_hi(p.y);
                            *(f32x4*)(h + o) = r; } }
            }
    }
};
struct EpiSigN {
    static constexpr bool PERM = true, AFTER_DRAIN = false;
    bf16_t* O; int ldc; RstdTab RS;
    __device__ __forceinline__ void operator()(const f32x4 (&acc)[2][2][4][2], const Unit& u, int wr, int wc, int fr, int fq) const {
        int lofs = (wr * 64 + fr) * 256 + wc * 32 + 8 * fq; asm volatile("" : "+v"(lofs));
#pragma unroll
        for (int ai = 0; ai < 2; ++ai) {
            float rs[4];
#pragma unroll
            for (int m = 0; m < 4; ++m) rs[m] = RS.get(u, wr * 64 + fr + ai * HALF + m * 16) * -1.4426950408889634f;
#pragma unroll
            for (int m = 0; m < 4; ++m) { bf16_t* rowp = O + lofs + (ai * HALF + m * 16) * 256;
#pragma unroll
                for (int bj = 0; bj < 2; ++bj) { f32x4 v0 = acc[ai][bj][m][0] * rs[m], v1 = acc[ai][bj][m][1] * rs[m];
#pragma unroll
                    for (int e = 0; e < 4; ++e) { v0[e] = sigm_l2(v0[e]); v1[e] = sigm_l2(v1[e]); }
                    u32x4 w; w.x = cvt_pk_bf16(v0[0], v0[1]); w.y = cvt_pk_bf16(v0[2], v0[3]); w.z = cvt_pk_bf16(v1[0], v1[1]); w.w = cvt_pk_bf16(v1[2], v1[3]);
                    *(u32x4*)(rowp + bj * HALF) = w; } }
        }
    }
};
template <int MODE, bool MIRROR> struct EpiStream {
    static constexpr bool PERM = true, AFTER_DRAIN = false;
    bf16_t* H; bf16_t* H2; float* SSQo; RstdTab RSi; const bf16_t* PP;
    __device__ __forceinline__ void operator()(const f32x4 (&acc)[2][2][4][2], const Unit& u, int wr, int wc, int fr, int fq) const {
        const int row0 = u.pm * BM + wr * 64 + fr, col0 = u.pn * BM + wc * 32 + 8 * fq;
        int lofs = (wr * 64 + fr) * 256 + wc * 32 + 8 * fq; if (MODE == 1) asm volatile("" : "+v"(lofs));
        constexpr int NB = (MODE == 1) ? 2 : 4;
#pragma unroll
        for (int bt = 0; bt < 8 / NB; ++bt) {
            u32x4 hw[NB][2], pw[NB][2]; float rs[NB];
#pragma unroll
            for (int mm = 0; mm < NB; ++mm) { const int rg = bt * NB + mm, ai = rg >> 2, m = rg & 3; const size_t row = (size_t)(row0 + ai * HALF + m * 16);
                rs[mm] = (MODE == 1) ? RSi.get(u, wr * 64 + fr + ai * HALF + m * 16) * -1.4426950408889634f : 1.0f;
#pragma unroll
                for (int bj = 0; bj < 2; ++bj) { hw[mm][bj] = *(const u32x4*)(H + row * 1024 + col0 + bj * HALF); if (MODE == 1) pw[mm][bj] = *(const u32x4*)(PP + lofs + (ai * HALF + m * 16) * 256 + bj * HALF); } }
#pragma unroll
            for (int mm = 0; mm < NB; ++mm) { const int rg = bt * NB + mm, ai = rg >> 2, m = rg & 3; const size_t row = (size_t)(row0 + ai * HALF + m * 16); float ss = 0.f;
#pragma unroll
                for (int bj = 0; bj < 2; ++bj) { f32x4 v0 = acc[ai][bj][m][0], v1 = acc[ai][bj][m][1]; const u32x4 hh = hw[mm][bj];
                    if (MODE == 1) { const u32x4 p = pw[mm][bj]; v0 = v0 * rs[mm]; v1 = v1 * rs[mm];
                        v0[0] = sigm_l2(v0[0]) * bf_lo(p.x); v0[1] = sigm_l2(v0[1]) * bf_hi(p.x); v0[2] = sigm_l2(v0[2]) * bf_lo(p.y); v0[3] = sigm_l2(v0[3]) * bf_hi(p.y);
                        v1[0] = sigm_l2(v1[0]) * bf_lo(p.z); v1[1] = sigm_l2(v1[1]) * bf_hi(p.z); v1[2] = sigm_l2(v1[2]) * bf_lo(p.w); v1[3] = sigm_l2(v1[3]) * bf_hi(p.w); }
                    v0[0] += bf_lo(hh.x); v0[1] += bf_hi(hh.x); v0[2] += bf_lo(hh.y); v0[3] += bf_hi(hh.y); v1[0] += bf_lo(hh.z); v1[1] += bf_hi(hh.z); v1[2] += bf_lo(hh.w); v1[3] += bf_hi(hh.w);
                    u32x4 w; w.x = cvt_pk_bf16(v0[0], v0[1]); w.y = cvt_pk_bf16(v0[2], v0[3]); w.z = cvt_pk_bf16(v1[0], v1[1]); w.w = cvt_pk_bf16(v1[2], v1[3]);
                    *(u32x4*)((MIRROR ? H2 : H) + row * 1024 + col0 + bj * HALF) = w;
                    const float r0 = bf_lo(w.x), r1 = bf_hi(w.x), r2 = bf_lo(w.y), r3 = bf_hi(w.y), r4 = bf_lo(w.z), r5 = bf_hi(w.z), r6 = bf_lo(w.w), r7 = bf_hi(w.w);
                    ss += ((r0 * r0 + r1 * r1) + (r2 * r2 + r3 * r3)) + ((r4 * r4 + r5 * r5) + (r6 * r6 + r7 * r7)); }
                ss += __shfl_xor(ss, 16); ss += __shfl_xor(ss, 32);
                if (fq == 0) SSQo[row * 16 + u.pn * 4 + wc] = ss; }
        }
    }
};
template <> struct ABlocked<EpiStream<0, true>> { static constexpr bool v = true; };
}
#define GAS __attribute__((address_space(1)))
#define LAS __attribute__((address_space(3)))
typedef unsigned short bf16;
typedef unsigned v4u __attribute__((ext_vector_type(4)));
typedef float f32x4 __attribute__((ext_vector_type(4)));
typedef short bf16x8 __attribute__((ext_vector_type(8)));
typedef GAS unsigned gu32;
typedef GAS unsigned long long gu64;
#define RLX_AGENT __ATOMIC_RELAXED, __HIP_MEMORY_SCOPE_AGENT
#define LDS_WAIT() asm volatile("s_waitcnt lgkmcnt(0)" ::: "memory")
#define VM_WAIT() asm volatile("s_waitcnt vmcnt(0)" ::: "memory")
__device__ __forceinline__ unsigned long long rt() { return __builtin_amdgcn_s_memrealtime(); }
__device__ __forceinline__ unsigned f2bf(float f) { unsigned u = __builtin_bit_cast(unsigned, f); return (u + 0x7fffu + ((u >> 16) & 1u)) >> 16; }
__device__ __forceinline__ unsigned pk2(float lo, float hi) { return f2bf(lo) | (f2bf(hi) << 16); }

#define XB_TMO      128
#define XB_XCNT(j)  (256  + 64 * (j))
#define XB_XSUB(j)  (1280 + 64 * (j))
#define XB_XGEN(j)  (2304 + 64 * (j))
#define XB_TOP      3328
#define XB_TOPGEN   3392
#define XCD_BAR_WORDS 3456
#define XB_SPIN_CAP (1u << 18)

__device__ __forceinline__ unsigned xb_ld(unsigned* p)              { return __hip_atomic_load(p, __ATOMIC_RELAXED, __HIP_MEMORY_SCOPE_AGENT); }
__device__ __forceinline__ unsigned xb_add(unsigned* p, unsigned v) { return __hip_atomic_fetch_add(p, v, __ATOMIC_RELAXED, __HIP_MEMORY_SCOPE_AGENT); }
__device__ __forceinline__ unsigned xb_xcc_id() { return (unsigned)__builtin_amdgcn_s_getreg((3 << 11) | 20) & 0xFu; }
#define XB_SPIN(cond, bar) do { unsigned _sp = 0; while (cond) { __builtin_amdgcn_s_sleep(1); \
    if ((++_sp & 255u) == 0u) { if (xb_ld(&(bar)[XB_TMO])) break; if (_sp > XB_SPIN_CAP) { atomicAdd(&(bar)[XB_TMO], 1u); break; } } } } while (0)

struct XcdBarrier {
    unsigned* bar; unsigned x;
    volatile LAS unsigned* st;
};

__device__ __forceinline__ XcdBarrier xcd_barrier_post(unsigned* bar, volatile LAS unsigned* st) {
    XcdBarrier b; b.bar = bar; b.x = xb_xcc_id(); b.st = st;
    if (threadIdx.x == 0) (void)xb_add(&bar[XB_XCNT(b.x)], 1u);
    return b;
}
__device__ __forceinline__ void xcd_barrier_complete(unsigned* bar, unsigned x, unsigned& nloc, unsigned& nx) {
    const unsigned G = gridDim.x * gridDim.y * gridDim.z;
    unsigned sum, cnt, mine, sp = 0u;
    for (;;) {
        sum = 0u; cnt = 0u; mine = 0u;
#pragma unroll 1
        for (unsigned j = 0; j < 16; ++j) { const unsigned c = xb_ld(&bar[XB_XCNT(j)]); sum += c; cnt += (c > 0u) ? 1u : 0u; mine = (j == x) ? c : mine; }
        if (sum == G) break;
        __builtin_amdgcn_s_sleep(1);
        if ((++sp & 255u) == 0u) { if (xb_ld(&bar[XB_TMO])) break; if (sp > XB_SPIN_CAP) { atomicAdd(&bar[XB_TMO], 1u); break; } }
    }
    nloc = mine > 0u ? mine : 1u; nx = cnt > 0u ? cnt : 1u;
}

__device__ __forceinline__ void xcd_barrier(const XcdBarrier& b) {
    asm volatile("s_waitcnt vmcnt(0)" ::: "memory");
    __syncthreads();
    if (threadIdx.x == 0) {
        unsigned* bar = b.bar;
        __builtin_amdgcn_s_waitcnt(0);
        unsigned nloc = b.st[0], nx = b.st[1];
        if (nloc == 0u) { xcd_barrier_complete(bar, b.x, nloc, nx); b.st[0] = nloc; b.st[1] = nx; }
        const unsigned old = xb_add(&bar[XB_XSUB(b.x)], 1u);
        const unsigned gen = old / nloc;
        if (old + 1u == (gen + 1u) * nloc) {
            __builtin_amdgcn_fence(__ATOMIC_RELEASE, "agent");
            asm volatile("s_waitcnt vmcnt(0)" ::: "memory");
            const unsigned og = xb_add(&bar[XB_TOP], 1u);
            const unsigned tg = og / nx, want = (tg + 1u) * nx;
            if (og + 1u != want) XB_SPIN(xb_ld(&bar[XB_TOP]) < want, bar);
            __builtin_amdgcn_fence(__ATOMIC_ACQUIRE, "agent");
            xb_add(&bar[XB_XGEN(b.x)], 1u);
            asm volatile("s_waitcnt vmcnt(0)" ::: "memory");
        } else {
            XB_SPIN(xb_ld(&bar[XB_XGEN(b.x)]) == gen, bar);
            __builtin_amdgcn_fence(__ATOMIC_ACQUIRE, "agent");
            asm volatile("s_waitcnt vmcnt(0)" ::: "memory");
        }
    }
    __syncthreads();
}
constexpr int NWAVES = 8;
constexpr int BATCH = 2, SEQ = 16384, M = BATCH * SEQ, D = 1024, DEPTH = 2;
constexpr int INW = 6440;
constexpr int NIN = 3584;
constexpr int NGM = 3072, FF = 4096, PLE = 256;
constexpr int NCMP = 1023;
constexpr float EPS = 1e-6f;
#define DI __device__ __forceinline__

constexpr size_t MiB = 1u << 20;
constexpr size_t WS_CTL = 0, CTL_ZERO_BYTES = 1 * MiB;
constexpr size_t WS_ROPE = 1 * MiB;
constexpr size_t WS_KCMP = 3 * MiB, WS_VCMP = 3 * MiB + 512 * 1024;
constexpr size_t WS_DECAY = 4 * MiB;
constexpr size_t WS_W = 8 * MiB;
constexpr size_t W_IN = 0, W_GM = 7 * MiB, W_BR = 13 * MiB, W_O = 16 * MiB, W_1 = 18 * MiB, W_2 = 26 * MiB, W_PG = 34 * MiB, W_PP = 36 * MiB, W_LAYER = 36 * MiB + 512 * 1024;
constexpr size_t WS_A16 = 88 * MiB;
constexpr size_t WS_SMALL = 152 * MiB;
constexpr size_t WS_POOLED = 160 * MiB;
constexpr size_t WS_Q = 192 * MiB;
constexpr size_t WS_RG = 224 * MiB;
constexpr size_t WS_U = 256 * MiB, WS_KV = 288 * MiB, WS_QKG = 336 * MiB, WS_VG = 368 * MiB, WS_GLA = 400 * MiB;
constexpr size_t WS_GM = 256 * MiB;
constexpr size_t WS_HID = 160 * MiB;
constexpr size_t WS_VST = 496 * MiB, WS_VWT = 504 * MiB, WS_VCT = 5 * MiB;
constexpr size_t WS_YP = 464 * MiB;
constexpr size_t WS_WCT = 81 * MiB;
constexpr size_t WS_CPOS = 82 * MiB;
constexpr size_t WS_SSQ0 = 6 * MiB, WS_SSQ1 = 83 * MiB, WS_SSQ2 = 85 * MiB;
constexpr size_t WS_MG = 448 * MiB;
constexpr size_t WS_HB2 = WS_MG;
constexpr size_t WS_PP = 160 * MiB;
constexpr size_t WS_P16 = 416 * MiB;
constexpr size_t WS_END = 512 * MiB;
static_assert(WS_W + 2 * W_LAYER <= WS_A16 && WS_GLA + (size_t)2048 * 8192 * 4 <= WS_END && WS_GM + (size_t)M * NGM * 2 <= WS_HB2 && WS_HID + (size_t)M * FF * 2 <= WS_HB2 && WS_PP + (size_t)M * D * 2 <= WS_END && WS_HB2 + (size_t)M * D * 2 <= WS_END, "d_ws map");
constexpr int CW_BAR = 4096;

constexpr int LDS_BYTES = 147456;
constexpr int LDSCTL_OFF = 0, MISC_OFF = LDSCTL_OFF + 320;
constexpr int RING_OFF = 1024, RING_BYTES = LDS_BYTES - RING_OFF;
static_assert(MISC_OFF + 128 <= RING_OFF && RING_BYTES >= 131072, "LDS map");

typedef const void* __attribute__((address_space(4))) kaptr_t;
DI const void* ka_in(int i) { const kaptr_t* ka = (const kaptr_t*)__builtin_amdgcn_kernarg_segment_ptr(); return (const void*)*(volatile const kaptr_t*)(ka + i); }
#define IN_x ((const float*)ka_in(0))
#define IN_p ((const float*)ka_in(1))
#define IN_positions ((const int*)ka_in(2))
#define IN_norm_mix ((const float*)ka_in(3))
#define IN_w_in ((const float*)ka_in(4))
#define IN_pool_w ((const float*)ka_in(5))
#define IN_pool_scale ((const float*)ka_in(6))
#define IN_cmp_pos_k ((const float*)ka_in(7))
#define IN_cmp_w_k ((const float*)ka_in(8))
#define IN_cmp_pos_v ((const float*)ka_in(9))
#define IN_cmp_w_v ((const float*)ka_in(10))
#define IN_gla_w_gate ((const float*)ka_in(11))
#define IN_gla_b_gate ((const float*)ka_in(12))
#define IN_gla_norm ((const float*)ka_in(13))
#define IN_w_branch ((const float*)ka_in(14))
#define IN_w_out ((const float*)ka_in(15))
#define IN_norm_ffn ((const float*)ka_in(16))
#define IN_w_ff1 ((const float*)ka_in(17))
#define IN_w_ff2 ((const float*)ka_in(18))
#define IN_norm_ple ((const float*)ka_in(19))
#define IN_w_ple_gate ((const float*)ka_in(20))
#define IN_w_ple_proj ((const float*)ka_in(21))
#define IN_norm_final ((const float*)ka_in(22))
DI unsigned char* ws_opaque() { return (unsigned char*)ka_in(24); }
#define OUTP ((float*)ka_in(23))
struct Frame {
    LAS unsigned char* lds;
    volatile LAS unsigned* MISC;
    gu32* ctl;
    int tid, lane, wave, G, bid;
};
DI bf16* wptr_(unsigned char* wsq, int l, size_t off) { return (bf16*)(wsq + WS_W + (size_t)l * W_LAYER + off); }
#define wptr(F, l, off) wptr_(wsq, l, off)
DI float bf2f(bf16 b) { return __builtin_bit_cast(float, (unsigned)b << 16); }
DI void unpack8(const v4u w, float (&f)[8]) { f[0] = pg8::bf_lo(w.x); f[1] = pg8::bf_hi(w.x); f[2] = pg8::bf_lo(w.y); f[3] = pg8::bf_hi(w.y); f[4] = pg8::bf_lo(w.z); f[5] = pg8::bf_hi(w.z); f[6] = pg8::bf_lo(w.w); f[7] = pg8::bf_hi(w.w); }
DI float wave_sum(float v) {
#pragma unroll
    for (int o = 1; o < 64; o <<= 1) v += __shfl_xor(v, o);
    return v;
}
DI float wave_max(float v) {
#pragma unroll
    for (int o = 1; o < 64; o <<= 1) v = fmaxf(v, __shfl_xor(v, o));
    return v;
}

struct TrDesc { const float* W; const float* gain; bf16* WT; int ld, K, Ndst, mapoff; };
DI int map_win(int n) {
    if (n < 1792) return n;
    if (n < 2816) return n + 24;
    if (n < 3328) return n + 40;
    if (n < 3352) return n - 3328 + 1792;
    if (n < 3368) return n - 3352 + 2840;
    return -1;
}
DI void tr_load(const TrDesc& d, int it, int lane, float (&wv)[32]) {
    const int nblk = d.Ndst / 32, kb = it / nblk, nb = it % nblk, k0 = 64 * kb, n0 = 32 * nb;
    const int n = n0 + (lane & 31), sc = d.mapoff < 0 ? map_win(n) : n + d.mapoff;
#pragma unroll
    for (int i = 0; i < 32; ++i) { const int kk = 2 * i + (lane >> 5); wv[i] = sc >= 0 ? d.W[(size_t)(k0 + kk) * d.ld + sc] : 0.f; }
}
DI void tr_store(const TrDesc& d, int it, LAS float* scr, int lane, const float (&wv)[32]) {
    const int nblk = d.Ndst / 32, kb = it / nblk, nb = it % nblk, k0 = 64 * kb, n0 = 32 * nb;
#pragma unroll
    for (int i = 0; i < 32; ++i) { const int kk = 2 * i + (lane >> 5); const float gk = d.gain ? d.gain[k0 + kk] : 1.0f; scr[kk * 33 + (lane & 31)] = wv[i] * gk; }
    LDS_WAIT(); asm volatile("" ::: "memory");
    const int c = lane & 7;
#pragma unroll
    for (int j = 0; j < 4; ++j) { const int nn = (lane >> 3) + 8 * j; const LAS float* s = scr + (8 * c) * 33 + nn;
        v4u o; o.x = pk2(s[0 * 33], s[1 * 33]); o.y = pk2(s[2 * 33], s[3 * 33]); o.z = pk2(s[4 * 33], s[5 * 33]); o.w = pk2(s[6 * 33], s[7 * 33]);
        *(v4u*)(d.WT + (size_t)(n0 + nn) * d.K + k0 + 8 * c) = o; }
    LDS_WAIT(); asm volatile("" ::: "memory");
}
DI void p0_prologue(Frame& F) {
    unsigned char* const wsq = ws_opaque();
    { constexpr int I_IN = 16 * 112, I_GM = 16 * 96, I_BR = 8 * 32, I_O = 16 * 32, I_1 = 16 * 128, I_2 = 64 * 32, I_PG = 16 * 32, I_PP = 4 * 32, I_CT = 32 * 2;
      constexpr int PER_LAYER = I_IN + I_GM + 2 * I_BR + I_O + I_1 + I_2 + I_PG + I_PP + 2 * I_CT;
      LAS float* scr = (LAS float*)(F.lds + RING_OFF + F.wave * 16384);
      const int gw = F.bid * NWAVES + F.wave, NGW = F.G * NWAVES, lane = F.lane;
      auto desc = [&](int gi, TrDesc& dout, int& rout) {
          const int l = gi / PER_LAYER; int r = gi % PER_LAYER; TrDesc d;
          if (r < I_IN) d = TrDesc{IN_w_in + (size_t)l * D * INW, IN_norm_mix + (size_t)l * D, wptr(F, l, W_IN), INW, D, NIN, -1};
          else if ((r -= I_IN) < I_GM) d = TrDesc{IN_w_in + (size_t)l * D * INW, IN_norm_mix + (size_t)l * D, wptr(F, l, W_GM), INW, D, NGM, 3368};
          else if ((r -= I_GM) < I_BR) d = TrDesc{IN_w_branch + ((size_t)l * 3 + 1) * 512 * D, nullptr, wptr(F, l, W_BR) + (size_t)1 * D * 512, D, 512, D, 0};
          else if ((r -= I_BR) < I_BR) d = TrDesc{IN_w_branch + ((size_t)l * 3 + 2) * 512 * D, nullptr, wptr(F, l, W_BR) + (size_t)2 * D * 512, D, 512, D, 0};
          else if ((r -= I_BR) < I_O) d = TrDesc{IN_w_out + (size_t)l * D * D, nullptr, wptr(F, l, W_O), D, D, D, 0};
          else if ((r -= I_O) < I_1) d = TrDesc{IN_w_ff1 + (size_t)l * D * FF, IN_norm_ffn + (size_t)l * D, wptr(F, l, W_1), FF, D, FF, 0};
          else if ((r -= I_1) < I_2) d = TrDesc{IN_w_ff2 + (size_t)l * FF * D, nullptr, wptr(F, l, W_2), D, FF, D, 0};
          else if ((r -= I_2) < I_PG) d = TrDesc{IN_w_ple_gate + (size_t)l * D * D, IN_norm_ple + (size_t)l * D, wptr(F, l, W_PG), D, D, D, 0};
          else if ((r -= I_PG) < I_PP) d = TrDesc{IN_w_ple_proj + (size_t)l * PLE * D, nullptr, wptr(F, l, W_PP), D, PLE, D, 0};
          else if ((r -= I_PP) < I_CT) d = TrDesc{IN_cmp_w_k + (size_t)l * 2048 * 64, nullptr, ((bf16*)(wsq + WS_WCT)) + (size_t)(l * 2 + 0) * 64 * 2048, 64, 2048, 64, 0};
          else { r -= I_CT; d = TrDesc{IN_cmp_w_v + (size_t)l * 2048 * 64, nullptr, ((bf16*)(wsq + WS_WCT)) + (size_t)(l * 2 + 1) * 64 * 2048, 64, 2048, 64, 0}; }
          dout = d; rout = r;
      };
      float wvA[32], wvB[32]; TrDesc dA, dB; int rA = 0, rB = 0;
      int gi = gw;
      if (gi < DEPTH * PER_LAYER) { desc(gi, dA, rA); tr_load(dA, rA, lane, wvA); }
      for (; gi < DEPTH * PER_LAYER; gi += 2 * NGW) {
          const bool hasB = gi + NGW < DEPTH * PER_LAYER, hasA2 = gi + 2 * NGW < DEPTH * PER_LAYER;
          if (hasB) { desc(gi + NGW, dB, rB); tr_load(dB, rB, lane, wvB); }
          tr_store(dA, rA, scr, lane, wvA);
          if (hasA2) { desc(gi + 2 * NGW, dA, rA); tr_load(dA, rA, lane, wvA); }
          if (hasB) tr_store(dB, rB, scr, lane, wvB);
      } }
    for (int it = F.bid; it < DEPTH * 4 * 16 * 2; it += F.G) {
        const int l = it >> 7, g = (it >> 5) & 3, nb = (it >> 1) & 15, c0 = ((it & 1) * 8 + F.wave) * 8, n = nb * 64 + F.lane;
        const float* pw = IN_pool_w + (((size_t)l * 4 + g) * 128 + c0) * 128; const float* psc = IN_pool_scale + (size_t)l * 512 + g * 128;
        const float* wb = IN_w_branch + (size_t)l * 3 * 512 * D + (size_t)(g * 128) * D + n;
        LAS float* sp = (LAS float*)(F.lds + RING_OFF + F.wave * 16384);
#pragma unroll
        for (int j = 0; j < 4; ++j) ((LAS pg8::f32x4*)sp)[F.lane + 64 * j] = ((const pg8::f32x4*)pw)[F.lane + 64 * j];
        float a[8];
#pragma unroll
        for (int c = 0; c < 8; ++c) a[c] = 0.f;
#pragma unroll 1
        for (int dh = 0; dh < 128; dh += 32) {
            float wv[32];
#pragma unroll
            for (int d = 0; d < 32; ++d) wv[d] = wb[(size_t)(dh + d) * D];
#pragma unroll
            for (int d = 0; d < 32; ++d) wv[d] *= psc[dh + d];
            LDS_WAIT(); asm volatile("" ::: "memory");
#pragma unroll
            for (int d = 0; d < 32; d += 4)
#pragma unroll
                for (int c = 0; c < 8; ++c) { const pg8::f32x4 pv = *(const LAS pg8::f32x4*)(sp + c * 128 + dh + d); a[c] += (pv[0] * wv[d] + pv[1] * wv[d + 1]) + (pv[2] * wv[d + 2] + pv[3] * wv[d + 3]); }
        }
        v4u o; o.x = pk2(a[0], a[1]); o.y = pk2(a[2], a[3]); o.z = pk2(a[4], a[5]); o.w = pk2(a[6], a[7]);
        *(v4u*)(wptr(F, l, W_BR) + (size_t)n * 512 + g * 128 + c0) = o;
        LDS_WAIT(); asm volatile("" ::: "memory");
    }
    for (int o = F.bid; o < 2 * DEPTH * 64; o += F.G) {
        const int l = o >> 7, which = (o >> 6) & 1, e = o & 63;
        const float* Wc = (which ? IN_cmp_w_v : IN_cmp_w_k) + (size_t)l * 2048 * 64; const float* Pc = (which ? IN_cmp_pos_v : IN_cmp_pos_k) + (size_t)l * 2048;
        float a = 0.f;
#pragma unroll
        for (int j = 0; j < 4; ++j) { const int f = F.tid + 512 * j; a += Pc[f] * Wc[(size_t)f * 64 + e]; }
        a = wave_sum(a);
        LAS float* red = (LAS float*)(F.lds + RING_OFF + 131072);
        if (F.lane == 0) red[F.wave] = a;
        __syncthreads();
        if (F.tid == 0) { float t = 0.f;
#pragma unroll
            for (int p = 0; p < 8; ++p) t += red[p];
            ((float*)(wsq + WS_CPOS))[o] = t; }
        __syncthreads();
    }
    for (int it = F.bid * 512 + F.tid; it < M * 8; it += F.G * 512) {
        const int m = it >> 3, i = it & 7;
        const float pos = (float)IN_positions[m];
        const float inv = (float)exp(-(double)i * 0.125 * 13.122363377404328);
        const float ang = pos * inv; double sn, cs; sincos((double)ang, &sn, &cs);
        ((float*)(wsq + WS_ROPE))[(size_t)m * 16 + i] = (float)cs; ((float*)(wsq + WS_ROPE))[(size_t)m * 16 + 8 + i] = (float)sn;
    }
}

DI void cast_rows_bf16(Frame& F, const float* x, bf16* h16, float* ssq) {
    const int gw = F.bid * NWAVES + F.wave, NGW = F.G * NWAVES;
    for (int m0 = gw; m0 < M; m0 += 2 * NGW) {
        f32x4 v[2][4];
#pragma unroll
        for (int rr = 0; rr < 2; ++rr) { const int m = m0 + rr * NGW < M ? m0 + rr * NGW : m0;
#pragma unroll
            for (int j = 0; j < 4; ++j) v[rr][j] = *((const f32x4*)(x + (size_t)m * D) + F.lane + 64 * j); }
#pragma unroll
        for (int rr = 0; rr < 2; ++rr) { const int m = m0 + rr * NGW; if (m >= M) break;
            unsigned long long* o8 = (unsigned long long*)(h16 + (size_t)m * D) + F.lane; float s = 0.f;
#pragma unroll
            for (int j = 0; j < 4; ++j) { const unsigned lo = pk2(v[rr][j].x, v[rr][j].y), hi = pk2(v[rr][j].z, v[rr][j].w); o8[64 * j] = (unsigned long long)lo | ((unsigned long long)hi << 32);
                const float a = pg8::bf_lo(lo), b = pg8::bf_hi(lo), c = pg8::bf_lo(hi), d = pg8::bf_hi(hi); s += (a * a + b * b) + (c * c + d * d); }
            s = wave_sum(s);
            if (F.lane < 16) ssq[(size_t)m * 16 + F.lane] = (F.lane == 0) ? s : 0.f; }
    }
}
DI void final_norm(Frame& F, const bf16* h16, const float* ssq, const float* gain, float* out) {
    const int gw = F.bid * NWAVES + F.wave, NGW = F.G * NWAVES;
    f32x4 gv[4];
#pragma unroll
    for (int j = 0; j < 4; ++j) gv[j] = *((const f32x4*)gain + F.lane + 64 * j);
    for (int m0 = gw; m0 < M; m0 += 2 * NGW) {
        unsigned long long hw[2][4]; float rs[2];
#pragma unroll
        for (int rr = 0; rr < 2; ++rr) { const int m = m0 + rr * NGW < M ? m0 + rr * NGW : m0; rs[rr] = pg8::row_rstd(ssq, (size_t)m);
#pragma unroll
            for (int j = 0; j < 4; ++j) hw[rr][j] = *((const unsigned long long*)(h16 + (size_t)m * D) + F.lane + 64 * j); }
#pragma unroll
        for (int rr = 0; rr < 2; ++rr) { const int m = m0 + rr * NGW; if (m >= M) break;
            f32x4* o = (f32x4*)(out + (size_t)m * D) + F.lane;
#pragma unroll
            for (int j = 0; j < 4; ++j) { const unsigned lo = (unsigned)hw[rr][j], hi = (unsigned)(hw[rr][j] >> 32);
                f32x4 v; v.x = pg8::bf_lo(lo); v.y = pg8::bf_hi(lo); v.z = pg8::bf_lo(hi); v.w = pg8::bf_hi(hi); o[64 * j] = v * rs[rr] * gv[j]; } }
    }
}
DI void cvt_p16(Frame& F, int l) {
    unsigned char* const wsq = ws_opaque();
    const f32x4* src = (const f32x4*)(IN_p + (size_t)l * M * PLE); unsigned long long* dst = (unsigned long long*)((bf16*)(wsq + WS_P16));
    constexpr int n = M * PLE / 4; const int st = F.G * 512;
    for (int i = F.bid * 512 + F.tid; i < n; i += 4 * st) {
        f32x4 v[4];
#pragma unroll
        for (int k = 0; k < 4; ++k) { const int ii = i + k * st; v[k] = ii < n ? src[ii] : (f32x4){0.f, 0.f, 0.f, 0.f}; }
#pragma unroll
        for (int k = 0; k < 4; ++k) { const int ii = i + k * st; if (ii < n) dst[ii] = (unsigned long long)pk2(v[k].x, v[k].y) | ((unsigned long long)pk2(v[k].z, v[k].w) << 32); }
    }
}

template <int W, int T> DI void pool_item(const bf16* U, bf16* P, int m0, int col8) {
    const int tl0 = m0 & (SEQ - 1);
    v4u pre[W - 1], cur[T];
#pragma unroll
    for (int k = 1; k < W; ++k) pre[k - 1] = (tl0 - k >= 0) ? *(const v4u*)(U + (size_t)(m0 - k) * 512 + col8) : (v4u){0u, 0u, 0u, 0u};
#pragma unroll
    for (int t = 0; t < T; ++t) cur[t] = *(const v4u*)(U + (size_t)(m0 + t) * 512 + col8);
    float s[8];
#pragma unroll
    for (int e = 0; e < 8; ++e) s[e] = 0.f;
#pragma unroll
    for (int k = 1; k < W; ++k) { float f[8]; unpack8(pre[k - 1], f);
#pragma unroll
        for (int e = 0; e < 8; ++e) s[e] += f[e]; }
#pragma unroll
    for (int t = 0; t < T; ++t) {
        const int tl = tl0 + t; float c[8]; unpack8(cur[t], c);
#pragma unroll
        for (int e = 0; e < 8; ++e) s[e] += c[e];
        const float ic = 1.0f / (float)((tl + 1 < W) ? tl + 1 : W);
        v4u o; o.x = pk2(s[0] * ic - c[0], s[1] * ic - c[1]); o.y = pk2(s[2] * ic - c[2], s[3] * ic - c[3]); o.z = pk2(s[4] * ic - c[4], s[5] * ic - c[5]); o.w = pk2(s[6] * ic - c[6], s[7] * ic - c[7]);
        *(v4u*)(P + (size_t)(m0 + t) * 512 + col8) = o;
        float d[8]; unpack8((t - W + 1 >= 0) ? cur[(t - W + 1 >= 0) ? t - W + 1 : 0] : pre[(t - W + 1 >= 0) ? 0 : W - 2 - t], d);
#pragma unroll
        for (int e = 0; e < 8; ++e) s[e] -= d[e];
    }
}
DI void pool_phase(Frame& F) {
    unsigned char* const wsq = ws_opaque();
    const bf16* U = (const bf16*)(wsq + WS_U); bf16* P = (bf16*)(wsq + WS_POOLED);
    const int g = F.wave & 3, cvl = F.lane & 15, tq = F.lane >> 4;
    for (int cg = F.bid * 2 + (F.wave >> 2); cg < M / 64; cg += F.G * 2) {
        const int m0 = (cg * 4 + tq) * 16, col8 = (g * 16 + cvl) * 8;
#pragma unroll 1
        for (int hf = 0; hf < 2; ++hf) {
            if (g == 0) pool_item<2, 8>(U, P, m0 + 8 * hf, col8); else if (g == 1) pool_item<4, 8>(U, P, m0 + 8 * hf, col8); else if (g == 2) pool_item<8, 8>(U, P, m0 + 8 * hf, col8); else pool_item<16, 8>(U, P, m0 + 8 * hf, col8); }
    }
}

typedef float f32x16 __attribute__((ext_vector_type(16)));
typedef float f32x2_t __attribute__((ext_vector_type(2)));
typedef __bf16 bf16x2_t __attribute__((ext_vector_type(2)));
typedef unsigned u32x2_t __attribute__((ext_vector_type(2)));
#define MFMA32(a, b, c) __builtin_amdgcn_mfma_f32_32x32x16_bf16((a), (b), (c), 0, 0, 0)
DI unsigned cvtpk(float lo, float hi) { const f32x2_t v = {lo, hi}; const bf16x2_t b = __builtin_convertvector(v, bf16x2_t); return __builtin_bit_cast(unsigned, b); }
DI int crow(int i, int h) { return (i & 3) + 8 * (i >> 2) + 4 * h; }
DI float ex2(float x) { return __builtin_amdgcn_exp2f(x); }
#define MAX_TAIL "\n\tv_max3_f32 %0, %0, %4, %5\n\tv_max3_f32 %0, %0, %6, %7\n\tv_max3_f32 %0, %0, %8, %9\n\tv_max3_f32 %0, %0, %10, %11\n\tv_max3_f32 %0, %0, %12, %13\n\tv_max3_f32 %0, %0, %14, %15"
DI float max16_x4(const f32x4 (&S)[4]) {
    float m;
    asm("s_nop 7\n\tv_max3_f32 %0, %1, %2, %3" MAX_TAIL "\n\tv_max_f32 %0, %0, %16" : "=&v"(m)
        : "v"(S[0][0]), "v"(S[0][1]), "v"(S[0][2]), "v"(S[0][3]), "v"(S[1][0]), "v"(S[1][1]), "v"(S[1][2]), "v"(S[1][3]), "v"(S[2][0]), "v"(S[2][1]), "v"(S[2][2]), "v"(S[2][3]), "v"(S[3][0]), "v"(S[3][1]), "v"(S[3][2]), "v"(S[3][3]));
    return m;
}
DI float max16_x16(const f32x16& S) {
    float m;
    asm("s_nop 11\n\tv_max3_f32 %0, %1, %2, %3" MAX_TAIL "\n\tv_max_f32 %0, %0, %16" : "=&v"(m)
        : "v"(S[0]), "v"(S[1]), "v"(S[2]), "v"(S[3]), "v"(S[4]), "v"(S[5]), "v"(S[6]), "v"(S[7]), "v"(S[8]), "v"(S[9]), "v"(S[10]), "v"(S[11]), "v"(S[12]), "v"(S[13]), "v"(S[14]), "v"(S[15]));
    return m;
}
DI float max17_x16(float seed, const f32x16& S) {
    float m;
    asm("s_nop 11\n\tv_max3_f32 %0, %17, %1, %2\n\tv_max3_f32 %0, %0, %3, %4" "\n\tv_max3_f32 %0, %0, %5, %6\n\tv_max3_f32 %0, %0, %7, %8\n\tv_max3_f32 %0, %0, %9, %10\n\tv_max3_f32 %0, %0, %11, %12\n\tv_max3_f32 %0, %0, %13, %14\n\tv_max3_f32 %0, %0, %15, %16" : "=&v"(m)
        : "v"(S[0]), "v"(S[1]), "v"(S[2]), "v"(S[3]), "v"(S[4]), "v"(S[5]), "v"(S[6]), "v"(S[7]), "v"(S[8]), "v"(S[9]), "v"(S[10]), "v"(S[11]), "v"(S[12]), "v"(S[13]), "v"(S[14]), "v"(S[15]), "v"(seed));
    return m;
}
constexpr int NSA_KB = 8192, NSA_BLK = 16384, NSA_STAGE = 2 * NSA_BLK;
constexpr int NSA_OFF_IMP = 2 * NSA_STAGE, NSA_OFF_SELB = 4 * NSA_STAGE, NSA_LDS_END = NSA_OFF_SELB + 2 * 2048;
static_assert(NSA_LDS_END <= RING_BYTES && NSA_OFF_IMP + 65536 <= NSA_OFF_SELB, "NSA LDS map");
DI int swz(int row, int g) { return row * 128 + ((g ^ ((row >> 1) & 7)) << 4); }
enum { MODE_CMP1 = 0, MODE_CMP2 = 1, MODE_SEL = 2, MODE_WIN = 3 };
#define LDS_BARRIER() asm volatile("s_waitcnt lgkmcnt(0)\n\ts_barrier" ::: "memory")

struct NsaCol {
    int tcol, cnt;
    float m, l;
};
DI void qk_tile(const LAS unsigned char* kb, const bf16x8 (&qf)[4], int lane, float cinit, f32x16& S0, f32x16& S1) {
    const int r = lane & 31, h = lane >> 5;
#pragma unroll
    for (int i = 0; i < 16; ++i) { S0[i] = cinit; S1[i] = cinit; }
#pragma unroll
    for (int ks = 0; ks < 4; ++ks) {
        const bf16x8 a0 = *(const LAS bf16x8*)(kb + swz(r, 2 * ks + h));
        const bf16x8 a1 = *(const LAS bf16x8*)(kb + swz(32 + r, 2 * ks + h));
        S0 = MFMA32(a0, qf[ks], S0); S1 = MFMA32(a1, qf[ks], S1);
    }
}
template <int S> DI bf16x8 pack8(const f32x16& x) {
    v4u p; p.x = cvtpk(x[8 * S + 0], x[8 * S + 1]); p.y = cvtpk(x[8 * S + 2], x[8 * S + 3]); p.z = cvtpk(x[8 * S + 4], x[8 * S + 5]); p.w = cvtpk(x[8 * S + 6], x[8 * S + 7]);
    return __builtin_bit_cast(bf16x8, p);
}
template <int KS> DI void pv_step(const LAS unsigned char* vb, const bf16x8 pf, int r, int h, f32x16& O0, f32x16& O1) {
#pragma unroll
    for (int dh = 0; dh < 2; ++dh) {
        const u32x2_t lo = *(const LAS u32x2_t*)(vb + swz(32 * dh + r, 2 * KS) + 8 * h), hi = *(const LAS u32x2_t*)(vb + swz(32 * dh + r, 2 * KS + 1) + 8 * h);
        const v4u av = {lo.x, lo.y, hi.x, hi.y};
        const bf16x8 a = __builtin_bit_cast(bf16x8, av);
        if (dh == 0) O0 = MFMA32(a, pf, O0); else O1 = MFMA32(a, pf, O1);
    }
}
DI void pv_tile(const LAS unsigned char* vb, const f32x16& P0, const f32x16& P1, int lane, f32x16& O0, f32x16& O1) {
    const int r = lane & 31, h = lane >> 5;
    pv_step<0>(vb, pack8<0>(P0), r, h, O0, O1); pv_step<1>(vb, pack8<1>(P0), r, h, O0, O1);
    pv_step<2>(vb, pack8<0>(P1), r, h, O0, O1); pv_step<3>(vb, pack8<1>(P1), r, h, O0, O1);
}

template <int MODE>
DI void nsa_block(const LAS unsigned char* kb, int lane, int i, int c, int rowbase, bool mybit, const bf16x8 (&qf)[4], NsaCol& col, float inv_l, float& carry, f32x16& O0, f32x16& O1, LAS float* impw) {
    const int h = lane >> 5, hh = lane & 3;
    const LAS unsigned char* vb = kb + NSA_KB;
    const float ms0 = (MODE == MODE_SEL && !mybit) ? INFINITY : ((col.m == -INFINITY) ? 0.f : col.m);
    f32x16 S0, S1; qk_tile(kb, qf, lane, -ms0, S0, S1);
    const int kbase = (MODE == MODE_WIN) ? (rowbase + 64 * i) : 64 * i;
    bool masked;
    if (MODE == MODE_CMP1 || MODE == MODE_CMP2) masked = (kbase + 63 >= 4 * c - 1);
    else if (MODE == MODE_SEL) masked = (i == c);
    else masked = !((kbase + 63 <= 64 * c) && (kbase > 64 * c + 63 - 512));
    if (masked) {
#pragma unroll
        for (int r = 0; r < 16; ++r) {
            const int k0 = kbase + crow(r, h), k1 = k0 + 32;
            bool v0, v1;
            if (MODE == MODE_CMP1 || MODE == MODE_CMP2) { v0 = k0 < col.cnt; v1 = k1 < col.cnt; }
            else if (MODE == MODE_SEL) { v0 = k0 <= col.tcol; v1 = k1 <= col.tcol; }
            else { v0 = (k0 <= col.tcol) && (k0 > col.tcol - 512); v1 = (k1 <= col.tcol) && (k1 > col.tcol - 512); }
            S0[r] = v0 ? S0[r] : -INFINITY; S1[r] = v1 ? S1[r] : -INFINITY;
        }
    }
    if (MODE == MODE_CMP2) {
#pragma unroll
        for (int r = 0; r < 16; ++r) { S0[r] = ex2(S0[r]) * inv_l; S1[r] = ex2(S1[r]) * inv_l; }
#pragma unroll
        for (int u = 0; u < 8; ++u) {
            float G, L;
            if (u < 4) { G = (S0[4 * u] + S0[4 * u + 1]) + (S0[4 * u + 2] + S0[4 * u + 3]); L = S0[4 * u + 3]; }
            else { G = (S1[4 * (u - 4)] + S1[4 * (u - 4) + 1]) + (S1[4 * (u - 4) + 2] + S1[4 * (u - 4) + 3]); L = S1[4 * (u - 4) + 3]; }
            G += __shfl_xor(G, 1); G += __shfl_xor(G, 2); L += __shfl_xor(L, 1); L += __shfl_xor(L, 2);
            const float Lx = __shfl_xor(L, 32);
            const float prev = (h == 1) ? Lx : carry;
            if (hh == 0) impw[((lane & 31) >> 2) * 256 + 16 * i + 2 * u + h] = G + prev;
            carry = Lx;
        }
        pv_tile(vb, S0, S1, lane, O0, O1);
    } else {
        float mx = max17_x16(max16_x16(S0), S1);
        f32x16 P0, P1;
#pragma unroll
        for (int r = 0; r < 16; ++r) { P0[r] = ex2(S0[r]); P1[r] = ex2(S1[r]); }
        const bool fresh = (col.m == -INFINITY);
        const float thr = fresh ? -INFINITY : 8.0f;
        if (__any(mx > thr)) {
            mx = fmaxf(mx, __shfl_xor(mx, 32));
            const bool need = mx > thr;
            const float dm = need ? mx : 0.f;
            const float alpha = need ? (fresh ? 0.f : ex2(-mx)) : 1.0f;
            col.l *= alpha; if (need) col.m = ms0 + mx;
#pragma unroll
            for (int r = 0; r < 16; ++r) { P0[r] = ex2(S0[r] - dm); P1[r] = ex2(S1[r] - dm); }
            if (MODE != MODE_CMP1) {
#pragma unroll
                for (int r = 0; r < 16; ++r) { O0[r] *= alpha; O1[r] *= alpha; }
            }
        }
        float ls = 0.f;
#pragma unroll
        for (int r = 0; r < 16; ++r) { S0[r] = P0[r]; S1[r] = P1[r]; ls += P0[r] + P1[r]; }
        col.l += ls;
        if (MODE != MODE_CMP1) pv_tile(vb, S0, S1, lane, O0, O1);
    }
}

struct NsaSrc { const bf16* Kth; const bf16* Vth; size_t kstep, vstep; int nt; };
DI void nsa_src_init(NsaSrc& S, const bf16* Krow0, size_t kpitch, const bf16* Vblk0, int nt, int tid) {
    const int row = tid >> 3, k = (tid & 7) ^ ((row >> 1) & 7);
    S.Kth = Krow0 + (size_t)row * kpitch + k * 8; S.kstep = 64 * kpitch; S.Vth = Vblk0 + row * 64 + k * 8; S.vstep = 4096; S.nt = nt;
}
template <bool NEEDV> DI void nsa_dma(const NsaSrc& S, int i, LAS unsigned char* blk, int w) {
    const int ic = i < S.nt ? i : S.nt - 1;
    __builtin_amdgcn_global_load_lds((const unsigned*)(S.Kth + (size_t)ic * S.kstep), (LAS unsigned*)(blk + w * 1024), 16, 0, 0);
    if (NEEDV) __builtin_amdgcn_global_load_lds((const unsigned*)(S.Vth + (size_t)ic * S.vstep), (LAS unsigned*)(blk + NSA_KB + w * 1024), 16, 0, 0);
}
template <int MODE, bool CHAIN_OUT = false, bool CHAIN_IN = false>
DI void nsa_tiles(Frame& F, unsigned char* wsq, int b, int g, int c, int nt, int i0, const bf16x8 (&qf)[4], NsaCol& col, float inv_l, f32x16& O0, f32x16& O1, LAS float* impw) {
    const int tid = F.tid, lane = F.lane, w = F.wave;
    constexpr bool NEEDV = (MODE != MODE_CMP1);
    NsaSrc S; int rowbase = 0;
    if (MODE == MODE_CMP1 || MODE == MODE_CMP2)
        nsa_src_init(S, ((const bf16*)(wsq + WS_KCMP)) + ((size_t)b * 1024 * 2 + g) * 64, 128, ((const bf16*)(wsq + WS_VCT)) + (size_t)((b * 2 + g) * 16) * 4096, nt, tid);
    else { rowbase = 64 * (c - 8 + i0);
        nsa_src_init(S, ((const bf16*)(wsq + WS_KV)) + ((size_t)(4 * 2 + g) * M + (size_t)b * SEQ + rowbase) * 64, 64, ((const bf16*)(wsq + WS_VWT)) + (size_t)((b * 2 + g) * 256 + (c - 8 + i0)) * 4096, nt, tid); }
    LAS unsigned char* ring = F.lds + RING_OFF;
    const int nst = (nt + 1) >> 1;
    const int par = CHAIN_IN ? (nst & 1) : 0;
    if (!CHAIN_IN) { nsa_dma<NEEDV>(S, 0, ring, w); nsa_dma<NEEDV>(S, 1, ring + NSA_BLK, w);
        asm volatile("s_waitcnt vmcnt(0)\n\ts_barrier" ::: "memory"); }
    float carry = 0.f;
    for (int s = 0; s < nst; ++s) {
        const int pb = (s + par) & 1;
        if (s + 1 < nst) { nsa_dma<NEEDV>(S, 2 * s + 2, ring + (pb ^ 1) * NSA_STAGE, w); nsa_dma<NEEDV>(S, 2 * s + 3, ring + (pb ^ 1) * NSA_STAGE + NSA_BLK, w); }
        else if (CHAIN_OUT) { nsa_dma<true>(S, 0, ring + (pb ^ 1) * NSA_STAGE, w); nsa_dma<true>(S, 1, ring + (pb ^ 1) * NSA_STAGE + NSA_BLK, w); }
#pragma unroll
        for (int bb = 0; bb < 2; ++bb) {
            const int i = 2 * s + bb;
            if (i < nt) nsa_block<MODE>(ring + pb * NSA_STAGE + bb * NSA_BLK, lane, i, c, rowbase, true, qf, col, inv_l, carry, O0, O1, impw);
        }
        asm volatile("s_waitcnt vmcnt(0) lgkmcnt(0)\n\ts_barrier" ::: "memory");
    }
}

#define MFMA16(a, b, c) __builtin_amdgcn_mfma_f32_16x16x32_bf16((a), (b), (c), 0, 0, 0)
struct Sel16 { float m, l; int tcol; f32x4 O0, O1, O2, O3; bf16x8 q0, q1; };
DI void sel16_qk(Sel16& G, bool bit, const bf16x8 (&kf)[4][2], int q4, int i, int c, f32x4 (&S)[4]) {
    const float ms0 = !bit ? INFINITY : ((G.m == -INFINITY) ? 0.f : G.m);
    const bf16x8 q0 = G.q0, q1 = G.q1;
#pragma unroll
    for (int t = 0; t < 4; ++t) { S[t] = (f32x4){-ms0, -ms0, -ms0, -ms0}; S[t] = MFMA16(kf[t][0], q0, S[t]); S[t] = MFMA16(kf[t][1], q1, S[t]); }
    if (i == c) {
#pragma unroll
        for (int t = 0; t < 4; ++t)
#pragma unroll
            for (int e = 0; e < 4; ++e) S[t][e] = (64 * c + 16 * t + 4 * q4 + e <= G.tcol) ? S[t][e] : -INFINITY;
    }
    float mx = max16_x4(S);
    f32x4 P[4];
#pragma unroll
    for (int t = 0; t < 4; ++t) { P[t][0] = ex2(S[t][0]); P[t][1] = ex2(S[t][1]); P[t][2] = ex2(S[t][2]); P[t][3] = ex2(S[t][3]); }
    const bool fresh = (G.m == -INFINITY);
    const float thr = fresh ? -INFINITY : 8.0f;
    if (__any(mx > thr)) {
        mx = fmaxf(mx, __shfl_xor(mx, 16)); mx = fmaxf(mx, __shfl_xor(mx, 32));
        const bool need = mx > thr;
        const float dm = need ? mx : 0.f, alpha = need ? (fresh ? 0.f : ex2(-mx)) : 1.0f;
        G.l *= alpha; if (need) G.m = ms0 + mx;
#pragma unroll
        for (int t = 0; t < 4; ++t) { P[t][0] = ex2(S[t][0] - dm); P[t][1] = ex2(S[t][1] - dm); P[t][2] = ex2(S[t][2] - dm); P[t][3] = ex2(S[t][3] - dm); }
        G.O0 *= alpha; G.O1 *= alpha; G.O2 *= alpha; G.O3 *= alpha;
    }
    float ls = 0.f;
#pragma unroll
    for (int t = 0; t < 4; ++t) { S[t] = P[t]; ls += (P[t][0] + P[t][1]) + (P[t][2] + P[t][3]); }
    G.l += ls;
}
DI void sel16_pv(Sel16& G, const bf16x8 (&vf)[4][2], const f32x4 (&S)[4]) {
#pragma unroll
    for (int ks2 = 0; ks2 < 2; ++ks2) {
        v4u pw; pw.x = cvtpk(S[2 * ks2][0], S[2 * ks2][1]); pw.y = cvtpk(S[2 * ks2][2], S[2 * ks2][3]); pw.z = cvtpk(S[2 * ks2 + 1][0], S[2 * ks2 + 1][1]); pw.w = cvtpk(S[2 * ks2 + 1][2], S[2 * ks2 + 1][3]);
        const bf16x8 pf = __builtin_bit_cast(bf16x8, pw);
        G.O0 = MFMA16(vf[0][ks2], pf, G.O0); G.O1 = MFMA16(vf[1][ks2], pf, G.O1); G.O2 = MFMA16(vf[2][ks2], pf, G.O2); G.O3 = MFMA16(vf[3][ks2], pf, G.O3);
    }
}
struct SelBits { bool bit, act; };
DI SelBits sel_bits(Sel16& G, const LAS unsigned* selw, int i) { const unsigned wd = selw[i >> 5]; SelBits r; r.bit = (wd >> (i & 31)) & 1u;
    r.act = __ballot(r.bit) != 0ull; return r; }
DI void sel16_block(const LAS unsigned char* kb, int c16, int q4, int i, int c0, Sel16& GA, const SelBits sA, Sel16& GB, const SelBits sB, Sel16& GC, const SelBits sC, Sel16& GD, const SelBits sD) {
    if (!(sA.act || sB.act || sC.act || sD.act)) return;
    const LAS unsigned char* vb = kb + NSA_KB;
    f32x4 SA[4], SB[4], SC[4], SD[4];
    { bf16x8 kf[4][2];
#pragma unroll
      for (int t = 0; t < 4; ++t)
#pragma unroll
          for (int ks = 0; ks < 2; ++ks) kf[t][ks] = *(const LAS bf16x8*)(kb + swz(16 * t + c16, 4 * ks + q4));
      if (sA.act) sel16_qk(GA, sA.bit, kf, q4, i, c0, SA);
      if (sB.act) sel16_qk(GB, sB.bit, kf, q4, i, c0, SB);
      if (sC.act) sel16_qk(GC, sC.bit, kf, q4, i, c0 + 1, SC);
      if (sD.act) sel16_qk(GD, sD.bit, kf, q4, i, c0 + 1, SD); }
    asm volatile("" ::: "memory");
    { bf16x8 vf[4][2];
#pragma unroll
      for (int dt = 0; dt < 4; ++dt)
#pragma unroll
          for (int ks2 = 0; ks2 < 2; ++ks2) { const int row = 16 * dt + c16;
              const u32x2_t lo = *(const LAS u32x2_t*)(vb + swz(row, 4 * ks2 + (q4 >> 1)) + 8 * (q4 & 1)), hi = *(const LAS u32x2_t*)(vb + swz(row, 4 * ks2 + 2 + (q4 >> 1)) + 8 * (q4 & 1));
              const v4u av = {lo.x, lo.y, hi.x, hi.y}; vf[dt][ks2] = __builtin_bit_cast(bf16x8, av); }
      if (sA.act) sel16_pv(GA, vf, SA);
      if (sB.act) sel16_pv(GB, vf, SB);
      if (sC.act) sel16_pv(GC, vf, SC);
      if (sD.act) sel16_pv(GD, vf, SD); }
    asm volatile("" ::: "memory");
}
constexpr int SEL_STAGE = 4 * NSA_BLK;
DI void nsa_stage_sel16(Frame& F, const NsaSrc& S, int s, int nst, int c0, Sel16& GA, Sel16& GB, Sel16& GC, Sel16& GD, const LAS unsigned* sel0, const LAS unsigned* sel1) {
    LAS unsigned char* ring = F.lds + RING_OFF;
    const int lane = F.lane, c16 = lane & 15, q4 = lane >> 4, w = F.wave;
    if (s + 1 < nst) { LAS unsigned char* nb = ring + ((s + 1) & 1) * SEL_STAGE;
#pragma unroll
        for (int bb = 0; bb < 4; ++bb) nsa_dma<true>(S, 4 * s + 4 + bb, nb + bb * NSA_BLK, w); }
#pragma unroll 1
    for (int bb = 0; bb < 4; ++bb) {
        const int i = 4 * s + bb;
        if (i < S.nt) {
            const LAS unsigned char* kb = ring + (s & 1) * SEL_STAGE + bb * NSA_BLK;
            const SelBits sA = sel_bits(GA, sel0 + (c16 >> 2) * 8, i), sB = sel_bits(GB, sel0 + (4 + (c16 >> 2)) * 8, i);
            const SelBits sC = sel_bits(GC, sel1 + (c16 >> 2) * 8, i), sD = sel_bits(GD, sel1 + (4 + (c16 >> 2)) * 8, i);
            sel16_block(kb, c16, q4, i, c0, GA, sA, GB, sB, GC, sC, GD, sD);
        }
    }
    asm volatile("s_waitcnt vmcnt(0) lgkmcnt(0)\n\ts_barrier" ::: "memory");
}
DI void sel16_init(Sel16& G, unsigned char* wsq, int b, int g, int tcol, int hh, int q4) {
    G.tcol = tcol; const size_t mr = (size_t)b * SEQ + tcol;
    const bf16* Qr = ((const bf16*)(wsq + WS_Q)) + mr * 512 + (g * 4 + hh) * 64 + 8 * q4;
    G.q0 = *(const bf16x8*)Qr; G.q1 = *(const bf16x8*)(Qr + 32);
    G.m = -INFINITY; G.l = 0.f; const f32x4 z = {0.f, 0.f, 0.f, 0.f}; G.O0 = z; G.O1 = z; G.O2 = z; G.O3 = z;
}
DI void sel16_finish(Sel16& G, unsigned char* wsq, int b, int g, int hh, int q4, size_t out_off) {
    float l = G.l; l += __shfl_xor(l, 16); l += __shfl_xor(l, 32);
    const float g1 = pg8::sigm(((const float*)(wsq + WS_SMALL))[((size_t)b * SEQ + G.tcol) * 64 + (g * 4 + hh) * 3 + 1]);
    const float il = l > 0.f ? g1 / l : 0.f;
    const size_t base = ((size_t)b * SEQ + G.tcol) * 512 + (g * 4 + hh) * 64 + 4 * q4;
    const bf16* yp = ((const bf16*)(wsq + WS_YP)) + base; bf16* op = ((bf16*)(wsq + out_off)) + base;
    u32x2_t y[4];
#pragma unroll
    for (int dt = 0; dt < 4; ++dt) y[dt] = *(const u32x2_t*)(yp + 16 * dt);
    const f32x4 o[4] = {G.O0, G.O1, G.O2, G.O3};
#pragma unroll
    for (int dt = 0; dt < 4; ++dt) { u32x2_t w; w.x = cvtpk(pg8::bf_lo(y[dt].x) + il * o[dt][0], pg8::bf_hi(y[dt].x) + il * o[dt][1]); w.y = cvtpk(pg8::bf_lo(y[dt].y) + il * o[dt][2], pg8::bf_hi(y[dt].y) + il * o[dt][3]);
        *(u32x2_t*)(op + 16 * dt) = w; }
}
DI void nsa_selpair(Frame& F, unsigned char* wsq, int b, int g, int c0, size_t out_off) {
    const int tid = F.tid, lane = F.lane, w = F.wave, c16 = lane & 15, q4 = lane >> 4, hh = c16 & 3;
    NsaSrc S;
    nsa_src_init(S, ((const bf16*)(wsq + WS_KV)) + ((size_t)(2 * 2 + g) * M + (size_t)b * SEQ) * 64, 64, ((const bf16*)(wsq + WS_VST)) + (size_t)((b * 2 + g) * 256) * 4096, c0 + 2, tid);
    Sel16 GA, GB, GC, GD;
    sel16_init(GA, wsq, b, g, 64 * c0 + 8 * w + (c16 >> 2), hh, q4); sel16_init(GB, wsq, b, g, 64 * c0 + 8 * w + 4 + (c16 >> 2), hh, q4);
    sel16_init(GC, wsq, b, g, 64 * (c0 + 1) + 8 * w + (c16 >> 2), hh, q4); sel16_init(GD, wsq, b, g, 64 * (c0 + 1) + 8 * w + 4 + (c16 >> 2), hh, q4);
    asm volatile("s_waitcnt vmcnt(0)" ::: "memory");
    const LAS unsigned* sel0 = (const LAS unsigned*)(F.lds + RING_OFF + NSA_OFF_SELB) + w * 64; const LAS unsigned* sel1 = sel0 + 512;
    const int nst = (S.nt + 3) >> 2;
    { LAS unsigned char* ring = F.lds + RING_OFF;
#pragma unroll
      for (int bb = 0; bb < 4; ++bb) nsa_dma<true>(S, bb, ring + bb * NSA_BLK, w); }
    asm volatile("s_waitcnt vmcnt(0)\n\ts_barrier" ::: "memory");
    for (int s = 0; s < nst; ++s) nsa_stage_sel16(F, S, s, nst, c0, GA, GB, GC, GD, sel0, sel1);
    unsigned char* const w2 = ws_opaque();
    sel16_finish(GA, w2, b, g, hh, q4, out_off); sel16_finish(GB, w2, b, g, hh, q4, out_off);
    sel16_finish(GC, w2, b, g, hh, q4, out_off); sel16_finish(GD, w2, b, g, hh, q4, out_off);
}

DI void nsa_pre(Frame& F, unsigned char* wsq, int b, int g, int c, int slot) {
    const int lane = F.lane, w = F.wave, h = lane >> 5, colx = lane & 31, qi = colx >> 2, hh = colx & 3;
    NsaCol col; col.tcol = 64 * c + 8 * w + qi; col.cnt = col.tcol >= 31 ? ((col.tcol - 31) >> 4) + 1 : 0;
#define NSA_GATE(k) pg8::sigm(((const float*)(ws_opaque() + WS_SMALL))[((size_t)b * SEQ + col.tcol) * 64 + (g * 4 + hh) * 3 + (k)])
    LAS float* impw = (LAS float*)(F.lds + RING_OFF + NSA_OFF_IMP) + w * 2048;
    LAS unsigned* selb = (LAS unsigned*)(F.lds + RING_OFF + NSA_OFF_SELB) + slot * 512 + w * 64;
    LAS float* rpark = (LAS float*)(F.lds + RING_OFF) + w * 2048;
    { f32x16 O0, O1;
#pragma unroll
      for (int r = 0; r < 16; ++r) { O0[r] = 0.f; O1[r] = 0.f; }
      const int ntc = (4 * c + 3 + 63) >> 6;
      const bf16* Qp = ((const bf16*)(ws_opaque() + WS_Q)) + ((size_t)b * SEQ + col.tcol) * 512 + (g * 4 + hh) * 64;
      bf16x8 qf[4];
#pragma unroll
      for (int ks = 0; ks < 4; ++ks) qf[ks] = *(const bf16x8*)(Qp + 16 * ks + 8 * h);
      col.m = -INFINITY; col.l = 0.f;
      nsa_tiles<MODE_CMP1, true, false>(F, ws_opaque(), b, g, c, ntc, 0, qf, col, 0.f, O0, O1, impw);
      col.l += __shfl_xor(col.l, 32);
      const float inv_l = col.l > 0.f ? 1.0f / col.l : 0.f;
      nsa_tiles<MODE_CMP2, false, true>(F, ws_opaque(), b, g, c, ntc, 0, qf, col, inv_l, O0, O1, impw);
      const float g0 = NSA_GATE(0);
#pragma unroll
      for (int r = 0; r < 16; ++r) { rpark[r * 64 + lane] = g0 * O0[r]; rpark[(16 + r) * 64 + lane] = g0 * O1[r]; } }
    asm volatile("s_waitcnt lgkmcnt(0)" ::: "memory");
    { const int nforced = c >= 2 ? 3 : c + 1, K = 16 - nforced, ncand = c + 1 - nforced;
      constexpr int TKQ = 4;
      for (int q0 = 0; q0 < 8; q0 += TKQ) {
      unsigned kx[TKQ][4]; unsigned T[TKQ];
#pragma unroll
      for (int q = 0; q < TKQ; ++q) {
#pragma unroll
          for (int jj = 0; jj < 4; ++jj) { const int j = lane + 64 * jj; const bool cd = (j <= c) && !((j == 0) || (j == c) || (j == c - 1));
              kx[q][jj] = cd ? (__float_as_uint(impw[(q0 + q) * 256 + j]) + 1u) : 0u; }
          T[q] = 1u; }
      if (ncand > K) {
#pragma unroll
          for (int q = 0; q < TKQ; ++q) T[q] = 0u;
          int cntT[TKQ];
#pragma unroll
          for (int q = 0; q < TKQ; ++q) cntT[q] = 256;
          for (int bit = 30; bit >= 0; --bit) {
              bool alldone = true;
#pragma unroll
              for (int q = 0; q < TKQ; ++q) {
                  if (cntT[q] != K) {
                      const unsigned cand = T[q] | (1u << bit);
                      int cnt = __popcll(__ballot(kx[q][0] >= cand));
                      if (c >= 64) cnt += __popcll(__ballot(kx[q][1] >= cand));
                      if (c >= 128) cnt += __popcll(__ballot(kx[q][2] >= cand)) + ((c >= 192) ? __popcll(__ballot(kx[q][3] >= cand)) : 0);
                      if (cnt >= K) { T[q] = cand; cntT[q] = cnt; }
                  }
                  alldone = alldone && (cntT[q] == K);
              }
              if (alldone) break;
          }
      }
#pragma unroll
      for (int q = 0; q < TKQ; ++q) {
          int quota = 1 << 20;
          if (ncand > K) quota = K - (__popcll(__ballot(kx[q][0] > T[q])) + __popcll(__ballot(kx[q][1] > T[q])) + __popcll(__ballot(kx[q][2] > T[q])) + __popcll(__ballot(kx[q][3] > T[q])));
          int base = 0;
#pragma unroll
          for (int jj = 0; jj < 4; ++jj) {
              const int j = lane + 64 * jj; const bool fr = (j <= c) && ((j == 0) || (j == c) || (j == c - 1)), cd = kx[q][jj] != 0u;
              const unsigned long long eqm = __ballot(cd && kx[q][jj] == T[q]);
              const int rank = base + (int)__builtin_amdgcn_mbcnt_hi((unsigned)(eqm >> 32), __builtin_amdgcn_mbcnt_lo((unsigned)eqm, 0u));
              const bool sel = fr || (cd && (kx[q][jj] > T[q] || (kx[q][jj] == T[q] && rank < quota)));
              const unsigned long long sm = __ballot(sel);
              if (lane == 0) { selb[(q0 + q) * 8 + 2 * jj] = (unsigned)sm; selb[(q0 + q) * 8 + 2 * jj + 1] = (unsigned)(sm >> 32); }
              base += __popcll(eqm);
          }
      } } }
    asm volatile("s_waitcnt lgkmcnt(0)" ::: "memory");
#pragma unroll
    for (int r = 0; r < 32; ++r) impw[r * 64 + lane] = rpark[r * 64 + lane];
    asm volatile("s_waitcnt lgkmcnt(0)" ::: "memory");
    __syncthreads();
    f32x16 O0, O1;
#pragma unroll
    for (int r = 0; r < 16; ++r) { O0[r] = 0.f; O1[r] = 0.f; }
    col.m = -INFINITY; col.l = 0.f;
    { const int i0 = c < 8 ? 8 - c : 0;
      const bf16* Qp = ((const bf16*)(ws_opaque() + WS_Q)) + ((size_t)b * SEQ + col.tcol) * 512 + (g * 4 + hh) * 64;
      bf16x8 qf[4];
#pragma unroll
      for (int ks = 0; ks < 4; ++ks) qf[ks] = *(const bf16x8*)(Qp + 16 * ks + 8 * h);
      nsa_tiles<MODE_WIN>(F, ws_opaque(), b, g, c, 9 - i0, i0, qf, col, 0.f, O0, O1, impw); }
    col.l += __shfl_xor(col.l, 32);
    const float il = col.l > 0.f ? NSA_GATE(2) / col.l : 0.f;
    bf16* Op = ((bf16*)(ws_opaque() + WS_YP)) + ((size_t)b * SEQ + col.tcol) * 512 + (g * 4 + hh) * 64;
#pragma unroll
    for (int u = 0; u < 4; ++u) {
        float y0[4], y1[4];
#pragma unroll
        for (int e = 0; e < 4; ++e) { y0[e] = impw[(4 * u + e) * 64 + lane] + il * O0[4 * u + e]; y1[e] = impw[(16 + 4 * u + e) * 64 + lane] + il * O1[4 * u + e]; }
        u32x2_t w0; w0.x = cvtpk(y0[0], y0[1]); w0.y = cvtpk(y0[2], y0[3]);
        u32x2_t w1; w1.x = cvtpk(y1[0], y1[1]); w1.y = cvtpk(y1[2], y1[3]);
        *(u32x2_t*)(Op + 8 * u + 4 * h) = w0; *(u32x2_t*)(Op + 32 + 8 * u + 4 * h) = w1;
    }
}
DI void nsa_phase(Frame& F, size_t out_off) {
    unsigned char* const wsq = ws_opaque();
    const bool xcd = (F.G == 256);
    const int nit = xcd ? 2 : (512 + F.G - 1) / F.G;
    for (int it = 0; it < nit; ++it) {
        int C, bg;
        if (xcd) { const int x = F.bid & 7, q = F.bid >> 3, k = q * 2 + (x & 1); bg = x >> 1; C = (it == 0) ? 127 - k : k; }
        else { const int idx = it * F.G + ((it & 1) ? (F.G - 1 - F.bid) : F.bid); if (idx >= 512) continue; C = 127 - (idx >> 2); bg = idx & 3; }
        asm volatile("" : "+v"(F.tid)); F.lane = F.tid & 63;
        for (int hf_ = 0; hf_ < 2; ++hf_) nsa_pre(F, wsq, bg >> 1, bg & 1, 2 * C + hf_, hf_);
        asm volatile("s_waitcnt vmcnt(0)" ::: "memory"); __syncthreads();
        asm volatile("" : "+v"(F.tid)); F.lane = F.tid & 63;
        nsa_selpair(F, ws_opaque(), bg >> 1, bg & 1, 2 * C, out_off);
        F.lane = (int)__builtin_amdgcn_mbcnt_hi(~0u, __builtin_amdgcn_mbcnt_lo(~0u, 0u)); F.tid = F.wave * 64 + F.lane;
    }
}

DI void compress_phase(Frame& F, int l) {
    unsigned char* const wsq = ws_opaque();
    constexpr int XP = 144;
    LAS unsigned char* xt = F.lds + RING_OFF; LAS float* red = (LAS float*)(F.lds + RING_OFF + 528 * XP);
    static_assert(528 * 144 + 65536 <= RING_BYTES, "compress LDS map");
    const int w = F.wave, lane = F.lane, tid = F.tid, r = lane & 31, hf = lane >> 5;
    for (int u = F.bid; u < 256; u += F.G) {
        const int which = u & 1, rest = u >> 1, nb = rest & 31, g = (rest >> 5) & 1, b = rest >> 6, n0 = nb * 32;
        const bf16* src = ((const bf16*)(wsq + WS_KV)) + ((size_t)(which * 2 + g) * M + (size_t)b * SEQ) * 64;
        { v4u xv[9];
#pragma unroll
          for (int k = 0; k < 9; ++k) { const int p = tid + 512 * k, tk = (p < 528 * 8 ? p : 0) >> 3, cc = p & 7; int tok = 16 * n0 + tk; tok = tok < SEQ ? tok : SEQ - 1; xv[k] = *(const v4u*)(src + (size_t)tok * 64 + cc * 8); }
#pragma unroll
          for (int k = 0; k < 9; ++k) { const int p = tid + 512 * k; if (p < 528 * 8) *(LAS v4u*)(xt + (p >> 3) * XP + (p & 7) * 16) = xv[k]; } }
        __syncthreads();
        const bf16* WT = ((const bf16*)(wsq + WS_WCT)) + (size_t)(l * 2 + which) * 64 * 2048;
        f32x16 a0, a1;
#pragma unroll
        for (int i = 0; i < 16; ++i) { a0[i] = 0.f; a1[i] = 0.f; }
#pragma unroll 4
        for (int kk = 0; kk < 16; ++kk) { const int ks = 16 * w + kk, li = ks >> 2;
            const bf16x8 af = *(const LAS bf16x8*)(xt + (16 * r + li) * XP + ((ks & 3) * 16 + 8 * hf) * 2);
            const bf16x8 b0 = *(const bf16x8*)(WT + (size_t)r * 2048 + 16 * ks + 8 * hf), b1 = *(const bf16x8*)(WT + (size_t)(32 + r) * 2048 + 16 * ks + 8 * hf);
            a0 = MFMA32(af, b0, a0); a1 = MFMA32(af, b1, a1); }
#pragma unroll
        for (int i = 0; i < 16; ++i) { red[(w * 32 + crow(i, hf)) * 64 + r] = a0[i]; red[(w * 32 + crow(i, hf)) * 64 + 32 + r] = a1[i]; }
        __syncthreads();
        const float* cp = ((const float*)(wsq + WS_CPOS)) + (l * 2 + which) * 64;
#pragma unroll
        for (int q = 0; q < 4; ++q) { const int o = tid + 512 * q, nl = o >> 6, e = o & 63; float s = cp[e];
#pragma unroll
            for (int ww = 0; ww < 8; ++ww) s += red[(ww * 32 + nl) * 64 + e];
            const int n = n0 + nl; const bf16 val = (n < NCMP) ? (bf16)f2bf(s) : (bf16)0;
            if (which) ((bf16*)(wsq + WS_VCT))[(size_t)((b * 2 + g) * 16 + (n >> 6)) * 4096 + e * 64 + (n & 63)] = val;
            else ((bf16*)(wsq + WS_KCMP))[((size_t)(b * 1024 + n) * 2 + g) * 64 + e] = val; }
        __syncthreads();
    }
}

DI void vtrans_phase(Frame& F) {
    unsigned char* const wsq = ws_opaque();
    const int tid = F.tid, row = tid >> 3, cc = tid & 7;
    for (int u0 = F.bid; u0 < 2048; u0 += 4 * F.G) {
        v4u r[4];
#pragma unroll
        for (int q = 0; q < 4; ++q) { const int u = u0 + q * F.G; const int uu = u < 2048 ? u : u0; const int j = uu & 255, g = (uu >> 8) & 1, b = (uu >> 9) & 1, kind = uu >> 10;
            r[q] = *(const v4u*)(((const bf16*)(wsq + WS_KV)) + ((size_t)((kind ? 5 : 3) * 2 + g) * M + (size_t)b * SEQ + 64 * j + row) * 64 + cc * 8); }
#pragma unroll
        for (int q = 0; q < 4; ++q) { LAS unsigned short* tp = (LAS unsigned short*)(F.lds + RING_OFF) + q * (64 * 72) + (8 * cc) * 72 + row;
            tp[0 * 72] = (unsigned short)(r[q].x & 0xffffu); tp[1 * 72] = (unsigned short)(r[q].x >> 16); tp[2 * 72] = (unsigned short)(r[q].y & 0xffffu); tp[3 * 72] = (unsigned short)(r[q].y >> 16);
            tp[4 * 72] = (unsigned short)(r[q].z & 0xffffu); tp[5 * 72] = (unsigned short)(r[q].z >> 16); tp[6 * 72] = (unsigned short)(r[q].w & 0xffffu); tp[7 * 72] = (unsigned short)(r[q].w >> 16); }
        __syncthreads();
#pragma unroll
        for (int q = 0; q < 4; ++q) { const int u = u0 + q * F.G;
            if (u < 2048) { const int j = u & 255, g = (u >> 8) & 1, b = (u >> 9) & 1, kind = u >> 10;
                const v4u o = *(const LAS v4u*)((LAS unsigned short*)(F.lds + RING_OFF) + q * (64 * 72) + row * 72 + cc * 8);
                *(v4u*)(((bf16*)(wsq + (kind ? WS_VWT : WS_VST))) + (size_t)((b * 2 + g) * 256 + j) * 4096 + row * 64 + cc * 8) = o; } }
        __syncthreads();
    }
}

DI float logsig(float z) { return fminf(z, 0.f) - 0.6931471805599453f * __builtin_amdgcn_logf(1.0f + __builtin_amdgcn_exp2f(-1.4426950408889634f * fabsf(z))); }
DI float fexp(float x) { return __builtin_amdgcn_exp2f(1.4426950408889634f * x); }
constexpr int GLP = 144;
template <int CTRL, int ROWS> DI float dpp_or0(float x) { return __builtin_bit_cast(float, __builtin_amdgcn_update_dpp(0, __builtin_bit_cast(int, x), CTRL, ROWS, 0xF, true)); }
DI float wave_scan_incl(float x) {
    x += dpp_or0<0x111, 0xF>(x); x += dpp_or0<0x112, 0xF>(x); x += dpp_or0<0x114, 0xF>(x); x += dpp_or0<0x118, 0xF>(x);
    x += dpp_or0<0x142, 0xA>(x); x += dpp_or0<0x143, 0xC>(x);
    return x;
}
constexpr int GLA_WG_OFF = RING_OFF + 98304;
static_assert(GLA_WG_OFF + 17 * 1024 <= LDS_BYTES, "gate weights in LDS");
DI void gla_stage_wg(Frame& F, int l) {
    LAS float* wgl = (LAS float*)(F.lds + GLA_WG_OFF);
    const float* wg = IN_gla_w_gate + (size_t)l * 16 * 256; const float* bg = IN_gla_b_gate + (size_t)l * 256;
#pragma unroll
    for (int k = 0; k < 2; ++k) ((LAS f32x4*)wgl)[F.tid + 512 * k] = ((const f32x4*)wg)[F.tid + 512 * k];
    if (F.tid < 64) ((LAS f32x4*)wgl)[1024 + F.tid] = ((const f32x4*)bg)[F.tid];
    __syncthreads();
}
DI void gla_gates_c(Frame& F, const f32x4 (&gl4)[4], int h, int w, int lane, float (&bcv)[8], float (&blv)[8]) {
    const LAS float* wgl = (const LAS float*)(F.lds + GLA_WG_OFF) + h * 64 + 8 * w;
    float glr[16];
#pragma unroll
    for (int r4 = 0; r4 < 4; ++r4) { glr[4 * r4] = gl4[r4].x; glr[4 * r4 + 1] = gl4[r4].y; glr[4 * r4 + 2] = gl4[r4].z; glr[4 * r4 + 3] = gl4[r4].w; }
    { const f32x4 b0 = *(const LAS f32x4*)(wgl + 4096), b1 = *(const LAS f32x4*)(wgl + 4096 + 4);
      float z[8] = {b0.x, b0.y, b0.z, b0.w, b1.x, b1.y, b1.z, b1.w};
#pragma unroll
      for (int r = 0; r < 16; ++r) { const f32x4 w0 = *(const LAS f32x4*)(wgl + r * 256), w1 = *(const LAS f32x4*)(wgl + r * 256 + 4);
          z[0] += glr[r] * w0.x; z[1] += glr[r] * w0.y; z[2] += glr[r] * w0.z; z[3] += glr[r] * w0.w; z[4] += glr[r] * w1.x; z[5] += glr[r] * w1.y; z[6] += glr[r] * w1.z; z[7] += glr[r] * w1.w; }
#pragma unroll
      for (int e = 0; e < 8; ++e) bcv[e] = logsig(z[e]) * (1.0f / 16.0f); }
#pragma unroll
    for (int e = 0; e < 8; ++e) bcv[e] = wave_scan_incl(bcv[e]);
#pragma unroll
    for (int e = 0; e < 8; ++e) blv[e] = __builtin_bit_cast(float, __builtin_amdgcn_readlane(__builtin_bit_cast(int, bcv[e]), 63));
}
DI void gla_gates_ld(unsigned char* wsq, size_t m0, int lane, f32x4 (&gl4)[4]) {
#pragma unroll
    for (int r4 = 0; r4 < 4; ++r4) gl4[r4] = *(const f32x4*)(((const float*)(wsq + WS_SMALL)) + (m0 + lane) * 64 + 24 + 4 * r4);
}
DI void gla_gates(Frame& F, unsigned char* wsq, int l, size_t m0, int h, int w, int lane, float (&bcv)[8], float (&blv)[8]) {
    f32x4 gl4[4]; gla_gates_ld(wsq, m0, lane, gl4); gla_gates_c(F, gl4, h, w, lane, bcv, blv);
}
DI void gla_vt_ld(unsigned char* wsq, size_t m0, int h, int w, int lane, v4u (&vr)[2]) {
#pragma unroll
    for (int pp = 0; pp < 2; ++pp) vr[pp] = *(const v4u*)(((const bf16*)(wsq + WS_VG)) + (m0 + lane) * 512 + h * 128 + 8 * (2 * w + pp));
}
DI void gla_vt_st(const v4u (&vr)[2], int w, int lane, LAS unsigned char* VT) {
#pragma unroll
    for (int pp = 0; pp < 2; ++pp) { const int cc = 2 * w + pp; const v4u r = vr[pp];
        LAS unsigned short* tp = (LAS unsigned short*)(VT + (8 * cc) * GLP) + lane;
        tp[0 * (GLP / 2)] = (unsigned short)(r.x & 0xffffu); tp[1 * (GLP / 2)] = (unsigned short)(r.x >> 16); tp[2 * (GLP / 2)] = (unsigned short)(r.y & 0xffffu); tp[3 * (GLP / 2)] = (unsigned short)(r.y >> 16);
        tp[4 * (GLP / 2)] = (unsigned short)(r.z & 0xffffu); tp[5 * (GLP / 2)] = (unsigned short)(r.z >> 16); tp[6 * (GLP / 2)] = (unsigned short)(r.w & 0xffffu); tp[7 * (GLP / 2)] = (unsigned short)(r.w >> 16); }
}
DI void gla_stage_vt(unsigned char* wsq, size_t m0, int h, int w, int lane, LAS unsigned char* VT) { v4u vr[2]; gla_vt_ld(wsq, m0, h, w, lane, vr); gla_vt_st(vr, w, lane, VT); }
DI void gla_g1(Frame& F, int l) {
    unsigned char* const wsq = ws_opaque();
    gla_stage_wg(F, l);
    constexpr int UB = 64 * GLP + 128 * GLP;
    const int w = F.wave, lane = F.lane, r = lane & 31, hf = lane >> 5;
    for (int u0 = F.bid; u0 < 2048; u0 += 2 * F.G) {
#pragma unroll
        for (int p = 0; p < 2; ++p) {
            const int u = (p == 0 || u0 + F.G < 2048) ? u0 + p * F.G : u0;
            LAS unsigned char* KTT = F.lds + RING_OFF + p * UB; LAS unsigned char* VT = KTT + 64 * GLP;
            const int h = u & 3, n = (u >> 2) & 255, b = u >> 10; const size_t m0 = (size_t)b * SEQ + n * 64;
            float bcv[8], blv[8]; gla_gates(F, wsq, l, m0, h, w, lane, bcv, blv);
            { float kf[8]; unpack8(*(const v4u*)(((const bf16*)(wsq + WS_QKG)) + (m0 + lane) * 512 + 256 + h * 64 + 8 * w), kf);
#pragma unroll
              for (int e = 0; e < 8; ++e) ((LAS unsigned short*)(KTT + (8 * w + e) * GLP))[lane] = (unsigned short)f2bf(kf[e] * fexp(blv[e] - bcv[e]));
              if (lane == 0) {
#pragma unroll
                  for (int e = 0; e < 8; ++e) ((float*)(wsq + WS_DECAY))[u * 64 + 8 * w + e] = fexp(blv[e]); } }
            gla_stage_vt(wsq, m0, h, w, lane, VT);
        }
        __syncthreads();
        const int et = w >> 1, dt = w & 1;
#pragma unroll
        for (int p = 0; p < 2; ++p) {
            const int u = (p == 0 || u0 + F.G < 2048) ? u0 + p * F.G : u0;
            const LAS unsigned char* KTT = F.lds + RING_OFF + p * UB; const LAS unsigned char* VT = KTT + 64 * GLP;
            f32x16 acc;
#pragma unroll
            for (int i = 0; i < 16; ++i) acc[i] = 0.f;
#pragma unroll
            for (int ks = 0; ks < 4; ++ks) {
                const bf16x8 a = *(const LAS bf16x8*)(VT + (32 * et + r) * GLP + ks * 32 + hf * 16);
                const bf16x8 bq = *(const LAS bf16x8*)(KTT + (32 * dt + r) * GLP + ks * 32 + hf * 16);
                acc = MFMA32(a, bq, acc);
            }
            float* dst = ((float*)(wsq + WS_GLA)) + (size_t)u * 8192 + 32 * dt + r;
#pragma unroll
            for (int i = 0; i < 16; ++i) dst[(32 * et + crow(i, hf)) * 64] = acc[i];
        }
        __syncthreads();
    }
}
DI void gla_g2(Frame& F, const float* gbase, unsigned* sbase) {
    unsigned char* const wsq = ws_opaque();
    if (F.tid >= 256) return;
    for (int ch = F.bid * 256 + F.tid; ch < 65536; ch += F.G * 256) {
        const int d = ch & 63, e = (ch >> 6) & 127, h = (ch >> 13) & 3, b = ch >> 15;
        float st = 0.f;
        const float* gp = gbase + (size_t)((b * 256) * 4 + h) * 8192 + e * 64 + d;
        unsigned* sp = sbase + (((size_t)((b * 256) * 4 + h) * 8192 + e * 64 + d) >> 1);
        const float* dp = ((const float*)(wsq + WS_DECAY)) + ((b * 256) * 4 + h) * 64 + d;
        float dlA[16], dcA[16], dlB[16], dcB[16];
#pragma unroll
        for (int k = 0; k < 16; ++k) { dlA[k] = gp[(size_t)k * 32768]; dcA[k] = dp[k * 256]; }
        for (int n0 = 0; n0 < 256; n0 += 32) {
#pragma unroll
            for (int k = 0; k < 16; ++k) { dlB[k] = gp[(size_t)(n0 + 16 + k) * 32768]; dcB[k] = dp[(n0 + 16 + k) * 256]; }
#pragma unroll
            for (int k = 0; k < 16; ++k) { const float nb = __shfl_xor(st, 1); if ((d & 1) == 0) sp[(size_t)(n0 + k) * 16384] = cvtpk(st, nb); st = st * dcA[k] + dlA[k]; }
            if (n0 + 32 < 256) {
#pragma unroll
                for (int k = 0; k < 16; ++k) { dlA[k] = gp[(size_t)(n0 + 32 + k) * 32768]; dcA[k] = dp[(n0 + 32 + k) * 256]; }
            }
#pragma unroll
            for (int k = 0; k < 16; ++k) { const float nb = __shfl_xor(st, 1); if ((d & 1) == 0) sp[(size_t)(n0 + 16 + k) * 16384] = cvtpk(st, nb); st = st * dcB[k] + dlB[k]; }
        }
    }
}
DI bf16x8 f8_to_bf16x8(const f32x4 a, const f32x4 b) { v4u p; p.x = cvtpk(a.x, a.y); p.y = cvtpk(a.z, a.w); p.z = cvtpk(b.x, b.y); p.w = cvtpk(b.z, b.w); return __builtin_bit_cast(bf16x8, p); }
struct G3A { f32x4 gl4[4]; v4u qv, kv; v4u vr[2]; };
DI void gla_g3(Frame& F, int l, size_t out_off) {
    unsigned char* const wsq = ws_opaque();
    gla_stage_wg(F, l);
    constexpr int UB = 64 * GLP * 2 + 128 * GLP + 1024;
    const int w = F.wave, lane = F.lane, r = lane & 31, hf = lane >> 5;
    const float* gn = IN_gla_norm + (size_t)l * 128;
    const int et = w >> 1, it = w & 1, ii = 32 * it + r;
    auto unit_of = [&](int u0, int p) { return (p == 0 || u0 + F.G < 2048) ? u0 + p * F.G : u0; };
    auto loadA = [&](int u, G3A& x) { const int h = u & 3, n = (u >> 2) & 255, b = u >> 10; const size_t m0 = (size_t)b * SEQ + n * 64;
        gla_gates_ld(wsq, m0, lane, x.gl4);
        x.qv = *(const v4u*)(((const bf16*)(wsq + WS_QKG)) + (m0 + lane) * 512 + h * 64 + 8 * w); x.kv = *(const v4u*)(((const bf16*)(wsq + WS_QKG)) + (m0 + lane) * 512 + 256 + h * 64 + 8 * w);
        gla_vt_ld(wsq, m0, h, w, lane, x.vr); };
    auto loadB = [&](int u, bf16x8 (&sf)[4], u32x2_t (&rw)[4]) { const int h = u & 3, n = (u >> 2) & 255, b = u >> 10; const size_t m0 = (size_t)b * SEQ + n * 64;
        const bf16* sp = ((const bf16*)OUTP) + (size_t)u * 8192 + (32 * et + r) * 64 + 8 * hf;
#pragma unroll
        for (int ks = 0; ks < 4; ++ks) sf[ks] = *(const bf16x8*)(sp + 16 * ks);
#pragma unroll
        for (int q = 0; q < 4; ++q) rw[q] = *(const u32x2_t*)(((const bf16*)(wsq + WS_RG)) + (m0 + ii) * 512 + h * 128 + 32 * et + 8 * q + 4 * hf); };
    G3A in[2]; bf16x8 sf[2][4]; u32x2_t rw[2][4];
    if (F.bid < 2048) {
#pragma unroll
        for (int p = 0; p < 2; ++p) { loadA(unit_of(F.bid, p), in[p]); loadB(unit_of(F.bid, p), sf[p], rw[p]); } }
    for (int u0 = F.bid; u0 < 2048; u0 += 2 * F.G) {
        const int un = u0 + 2 * F.G; const bool has_next = un < 2048;
#pragma unroll
        for (int p = 0; p < 2; ++p) {
            const int u = unit_of(u0, p);
            LAS unsigned char* QS = F.lds + RING_OFF + p * UB; LAS unsigned char* KS = QS + 64 * GLP; LAS unsigned char* VT = KS + 64 * GLP;
            const int h = u & 3;
            float bcv[8], blv[8]; gla_gates_c(F, in[p].gl4, h, w, lane, bcv, blv);
            { float qv[8], kf[8];
              unpack8(in[p].qv, qv); unpack8(in[p].kv, kf);
              float qo[8], ko[8];
#pragma unroll
              for (int e = 0; e < 8; ++e) { qo[e] = qv[e] * 0.125f * fexp(bcv[e]); ko[e] = kf[e] * fexp(-bcv[e]); }
              v4u qp, kp; qp.x = cvtpk(qo[0], qo[1]); qp.y = cvtpk(qo[2], qo[3]); qp.z = cvtpk(qo[4], qo[5]); qp.w = cvtpk(qo[6], qo[7]);
              kp.x = cvtpk(ko[0], ko[1]); kp.y = cvtpk(ko[2], ko[3]); kp.z = cvtpk(ko[4], ko[5]); kp.w = cvtpk(ko[6], ko[7]);
              *(LAS v4u*)(QS + lane * GLP + 16 * w) = qp; *(LAS v4u*)(KS + lane * GLP + 16 * w) = kp; }
            gla_vt_st(in[p].vr, w, lane, VT);
        }
        if (has_next) {
#pragma unroll
            for (int p = 0; p < 2; ++p) loadA(unit_of(un, p), in[p]); }
        LDS_BARRIER();
        f32x16 acc[2];
#pragma unroll
        for (int p = 0; p < 2; ++p) {
            const LAS unsigned char* QS = F.lds + RING_OFF + p * UB; const LAS unsigned char* KS = QS + 64 * GLP; const LAS unsigned char* VT = KS + 64 * GLP; LAS float* red = (LAS float*)(VT + 128 * GLP);
            bf16x8 qf[4];
#pragma unroll
            for (int ks = 0; ks < 4; ++ks) qf[ks] = *(const LAS bf16x8*)(QS + (32 * it + r) * GLP + ks * 32 + hf * 16);
#pragma unroll
            for (int i = 0; i < 16; ++i) acc[p][i] = 0.f;
#pragma unroll
            for (int ks = 0; ks < 4; ++ks) acc[p] = MFMA32(sf[p][ks], qf[ks], acc[p]);
#pragma unroll
            for (int jt = 0; jt < 2; ++jt) {
                if (jt <= it) {
                    f32x16 X;
#pragma unroll
                    for (int i = 0; i < 16; ++i) X[i] = 0.f;
#pragma unroll
                    for (int ks = 0; ks < 4; ++ks) { const bf16x8 a = *(const LAS bf16x8*)(KS + (32 * jt + r) * GLP + ks * 32 + hf * 16); X = MFMA32(a, qf[ks], X); }
                    if (jt == it) {
#pragma unroll
                        for (int i = 0; i < 16; ++i) X[i] = (crow(i, hf) <= r) ? X[i] : 0.f;
                    }
                    const LAS unsigned char* vr = VT + (32 * et + r) * GLP + (32 * jt + 4 * hf) * 2;
                    { const u32x2_t lo = *(const LAS u32x2_t*)vr, hi = *(const LAS u32x2_t*)(vr + 16); const v4u av = {lo.x, lo.y, hi.x, hi.y}; acc[p] = MFMA32(__builtin_bit_cast(bf16x8, av), pack8<0>(X), acc[p]); }
                    { const u32x2_t lo = *(const LAS u32x2_t*)(vr + 32), hi = *(const LAS u32x2_t*)(vr + 48); const v4u av = {lo.x, lo.y, hi.x, hi.y}; acc[p] = MFMA32(__builtin_bit_cast(bf16x8, av), pack8<1>(X), acc[p]); }
                }
            }
            float ss = 0.f;
#pragma unroll
            for (int i = 0; i < 16; ++i) ss += acc[p][i] * acc[p][i];
            ss += __shfl_xor(ss, 32);
            if (hf == 0) red[et * 64 + 32 * it + r] = ss;
        }
        LDS_BARRIER();
#pragma unroll
        for (int p = 0; p < 2; ++p) {
            const int u = unit_of(u0, p);
            const LAS float* red = (const LAS float*)(F.lds + RING_OFF + p * UB + 64 * GLP * 2 + 128 * GLP);
            const int h = u & 3, n = (u >> 2) & 255, b = u >> 10; const size_t m0 = (size_t)b * SEQ + n * 64;
            const float tot = (red[ii] + red[64 + ii]) + (red[128 + ii] + red[192 + ii]);
            const float rs = 1.0f / sqrtf(tot * (1.0f / 128.0f) + EPS);
#pragma unroll
            for (int q = 0; q < 4; ++q) {
                const int e0 = 32 * et + 8 * q + 4 * hf;
                const size_t idx = (m0 + ii) * 512 + h * 128 + e0;
                const u32x2_t rwv = rw[p][q];
                const f32x4 g4 = *(const f32x4*)(gn + e0);
                const float r0 = pg8::bf_lo(rwv.x), r1 = pg8::bf_hi(rwv.x), r2 = pg8::bf_lo(rwv.y), r3 = pg8::bf_hi(rwv.y);
                const float y0 = acc[p][4 * q] * rs * g4.x * (r0 * __builtin_amdgcn_rcpf(1.0f + fexp(-r0))), y1 = acc[p][4 * q + 1] * rs * g4.y * (r1 * __builtin_amdgcn_rcpf(1.0f + fexp(-r1)));
                const float y2 = acc[p][4 * q + 2] * rs * g4.z * (r2 * __builtin_amdgcn_rcpf(1.0f + fexp(-r2))), y3 = acc[p][4 * q + 3] * rs * g4.w * (r3 * __builtin_amdgcn_rcpf(1.0f + fexp(-r3)));
                u32x2_t o; o.x = cvtpk(y0, y1); o.y = cvtpk(y2, y3);
                *(u32x2_t*)(((bf16*)(wsq + out_off)) + idx) = o;
            }
        }
        if (has_next) {
#pragma unroll
            for (int p = 0; p < 2; ++p) loadB(unit_of(un, p), sf[p], rw[p]); }
        LDS_BARRIER();
    }
}

struct Args { const void* in[23]; float* out; unsigned char* ws; };
#define PG8_SP2 true
#define PG8_ALIGN true
constexpr int RSTD_TAB_OFF = RING_OFF + pg8::STAGE_BYTES;
static_assert(RSTD_TAB_OFF + pg8::RSTD_CAP * 1024 <= LDS_BYTES, "rstd table");
DI pg8::RstdTab rstd_prep(Frame& F, const pg8::StaticOrder& S, const float* ssq) {
    LAS float* tab = (LAS float*)(F.lds + RSTD_TAB_OFF);
    const int r = F.tid & 255, i0 = F.tid >> 8;
    float v[pg8::RSTD_CAP / 2];
#pragma unroll
    for (int k = 0; k < pg8::RSTD_CAP / 2; ++k) { pg8::Unit u; const bool ok = S.next(2 * k + i0, u); v[k] = pg8::row_rstd(ssq, ok ? (size_t)u.pm * 256 + r : (size_t)r); }
#pragma unroll
    for (int k = 0; k < pg8::RSTD_CAP / 2; ++k) tab[(2 * k + i0) * 256 + r] = v[k];
    __syncthreads();
    return pg8::RstdTab{(const LAS float*)tab};
}
__global__ void __launch_bounds__(NWAVES * 64, 2) mk_fwd(Args args) {
    extern __shared__ __attribute__((aligned(16))) unsigned char lds[];
    Frame F;
    F.lds = (LAS unsigned char*)lds;
    F.MISC = (volatile LAS unsigned*)(F.lds + MISC_OFF);
    F.tid = threadIdx.x; F.lane = F.tid & 63; F.wave = __builtin_amdgcn_readfirstlane(F.tid >> 6);
    F.G = gridDim.x; F.bid = blockIdx.x;
    unsigned char* wsq = ws_opaque();
    F.ctl = (gu32*)(wsq + WS_CTL);
    if (F.tid < 256) ((LAS unsigned*)(F.lds + LDSCTL_OFF))[F.tid] = 0u;
    __syncthreads();
    (void)xcd_barrier_post((unsigned*)(F.ctl + CW_BAR), F.MISC + 8);
#define NBAR_ 1
#define TS_REC() do {} while (0)
#define GRID_BAR() do { for (int nb_ = 0; nb_ < NBAR_; ++nb_) { XcdBarrier bb_; bb_.bar = (unsigned*)((gu32*)(ws_opaque() + WS_CTL) + CW_BAR); bb_.x = xb_xcc_id(); bb_.st = F.MISC + 8; xcd_barrier(bb_); } wsq = ws_opaque(); asm volatile("" : "+v"(F.tid)); F.lane = F.tid & 63; F.wave = __builtin_amdgcn_readfirstlane(F.tid >> 6); TS_REC(); } while (0)
    using pg8::Gemm; using pg8::StaticOrder; using pg8::gemm_phase;
    int ts_n = 0; (void)ts_n;
    TS_REC();
    const int bid = (int)blockIdx.x;

    p0_prologue(F);
    cast_rows_bf16(F, IN_x, ((bf16*)(wsq + WS_A16)), ((float*)(wsq + WS_SSQ0)));
    GRID_BAR();
    for (int l = 0; l < DEPTH; ++l) {
        { Gemm g{((bf16*)(wsq + WS_A16)), wptr(F, l, W_IN), M, NIN, D}; StaticOrder S; S.init(M, NIN, F.G, bid);
          for (S.cnt = pg8::RSTD_CAP; ; S.i0 += pg8::RSTD_CAP) { pg8::Unit u0; if (!S.next(0, u0)) break;
          pg8::EpiProj E{((bf16*)(wsq + WS_U)), ((bf16*)(wsq + WS_Q)), ((bf16*)(wsq + WS_KV)), ((bf16*)(wsq + WS_QKG)), ((bf16*)(wsq + WS_VG)), ((bf16*)(wsq + WS_RG)), ((float*)(wsq + WS_SMALL)), ((float*)(wsq + WS_ROPE)), rstd_prep(F, S, (const float*)(wsq + WS_SSQ0)), M, ((bf16*)(wsq + WS_VST)), ((bf16*)(wsq + WS_VWT)), SEQ};
          gemm_phase<pg8::EpiProj, StaticOrder, PG8_ALIGN, PG8_SP2>(F.lds + RING_OFF, g, S, E, F.tid); } }
        GRID_BAR();
        pool_phase(F); compress_phase(F, l); gla_g1(F, l);
        GRID_BAR();
        gla_g2(F, (const float*)(wsq + WS_GLA), (unsigned*)OUTP);
        nsa_phase(F, WS_Q);
        GRID_BAR();
        gla_g3(F, l, WS_RG);
        GRID_BAR();
        { pg8::GateBranchOrder S; S.init(M, D, F.G, bid);
          pg8::Gemm2 g{{((bf16*)(wsq + WS_A16)), ((bf16*)(wsq + WS_POOLED))}, {wptr(F, l, W_GM), wptr(F, l, W_BR)}, {D, 512}};
          bf16* const gtile = ((bf16*)(wsq + WS_GM)) + (size_t)F.bid * 131072;
          pg8::EpiSigN E0{gtile, NGM, rstd_prep(F, S.S0, (const float*)(wsq + WS_SSQ0))};
          pg8::EpiBranchR E1{((bf16*)(wsq + WS_MG)), gtile, gtile + 65536, M / 256};
          pg8::gemm_stream2<pg8::EpiSigN, pg8::EpiBranchR, pg8::GateBranchOrder>(F.lds + RING_OFF, g, S, E0, E1, F.tid); }
        GRID_BAR();
        { Gemm g{((bf16*)(wsq + WS_MG)), wptr(F, l, W_O), M, D, D}; StaticOrder S; S.init(M, D, F.G, bid);
          pg8::EpiStream<0, false> E{((bf16*)(wsq + WS_A16)), nullptr, ((float*)(wsq + WS_SSQ1)), pg8::RstdTab{nullptr}, nullptr};
          gemm_phase<pg8::EpiStream<0, false>, StaticOrder, PG8_ALIGN, PG8_SP2>(F.lds + RING_OFF, g, S, E, F.tid); }
        GRID_BAR();
        { Gemm g{((bf16*)(wsq + WS_A16)), wptr(F, l, W_1), M, FF, D}; StaticOrder S; S.init(M, FF, F.G, bid);
          for (S.cnt = pg8::RSTD_CAP; ; S.i0 += pg8::RSTD_CAP) { pg8::Unit u0; if (!S.next(0, u0)) break;
          pg8::EpiRelu2N E{((bf16*)(wsq + WS_HID)), FF, rstd_prep(F, S, (const float*)(wsq + WS_SSQ1))};
          gemm_phase<pg8::EpiRelu2N, StaticOrder, PG8_ALIGN, PG8_SP2>(F.lds + RING_OFF, g, S, E, F.tid); } }
        cvt_p16(F, l);
        GRID_BAR();
        { Gemm g{((bf16*)(wsq + WS_HID)), wptr(F, l, W_2), M, D, FF}; StaticOrder S; S.init(M, D, F.G, bid);
          pg8::EpiStream<0, true> E{((bf16*)(wsq + WS_A16)), ((bf16*)(wsq + WS_HB2)), ((float*)(wsq + WS_SSQ2)), pg8::RstdTab{nullptr}, nullptr};
          gemm_phase<pg8::EpiStream<0, true>, StaticOrder, PG8_ALIGN, PG8_SP2>(F.lds + RING_OFF, g, S, E, F.tid); }
        GRID_BAR();
        { pg8::PlePairOrder S; S.init(M, D, F.G, bid);
          int kp = PLE; asm volatile("" : "+s"(kp));
          pg8::Gemm2 g{{((bf16*)(wsq + WS_P16)), ((bf16*)(wsq + WS_HB2))}, {wptr(F, l, W_PP), wptr(F, l, W_PG)}, {kp, D}};
          bf16* const ptile = ((bf16*)(wsq + WS_GM)) + (size_t)F.bid * 131072;
          pg8::EpiTile E0{ptile};
          pg8::EpiStream<1, true> E1{((bf16*)(wsq + WS_HB2)), ((bf16*)(wsq + WS_A16)), ((float*)(wsq + WS_SSQ0)), rstd_prep(F, S.S0, (const float*)(wsq + WS_SSQ2)), ptile};
          pg8::gemm_stream2<pg8::EpiTile, pg8::EpiStream<1, true>, pg8::PlePairOrder>(F.lds + RING_OFF, g, S, E0, E1, F.tid); }
        GRID_BAR();
    }
    final_norm(F, ((const bf16*)(wsq + WS_A16)), ((const float*)(wsq + WS_SSQ0)), IN_norm_final, OUTP);
}

extern "C" void kernel_launch(void* const* d_in, const int* in_sizes, int n_in, void* d_out, int out_size, void* d_ws, size_t ws_size, hipStream_t stream) {
    static int grid = 0;
    if (grid == 0) {
        if (n_in != 23 || out_size != M * D || ws_size < WS_END) { fprintf(stderr, "kernel_launch: unexpected problem (n_in %d, out %d, ws %zu)\n", n_in, out_size, ws_size); grid = -1; return; }
        int dev = 0, cus = 0, per_cu = 0;
        if (hipGetDevice(&dev) != hipSuccess || hipDeviceGetAttribute(&cus, hipDeviceAttributeMultiprocessorCount, dev) != hipSuccess) { grid = -1; return; }
        if (hipFuncSetAttribute((const void*)mk_fwd, hipFuncAttributeMaxDynamicSharedMemorySize, LDS_BYTES) != hipSuccess) { fprintf(stderr, "kernel_launch: hipFuncSetAttribute failed\n"); grid = -1; return; }
        if (hipOccupancyMaxActiveBlocksPerMultiprocessor(&per_cu, (const void*)mk_fwd, NWAVES * 64, LDS_BYTES) != hipSuccess || per_cu < 1) fprintf(stderr, "kernel_launch: occupancy query reports %d\n", per_cu);
        (void)hipGetLastError();
        if ((M / 256) * (D / 256) > cus * pg8::RSTD_CAP) { fprintf(stderr, "kernel_launch: %d CUs: a workgroup's deal of output tiles exceeds the rstd table\n", cus); grid = -1; return; }
        grid = cus;
    }
    if (grid < 0) return;
    if (hipMemsetAsync((char*)d_ws + WS_CTL, 0, CTL_ZERO_BYTES, stream) != hipSuccess) return;
    Args a{};
    for (int i = 0; i < 23; ++i) a.in[i] = d_in[i];
    a.out = (float*)d_out; a.ws = (unsigned char*)d_ws;
    hipLaunchKernelGGL(mk_fwd, dim3(grid), dim3(NWAVES * 64), LDS_BYTES, stream, a);
}
```

```cpp
#include <hip/hip_runtime.h>
#include <cstdio>
#include <cstdint>
#include <cmath>
namespace pg8 {
#define PG8_LAS __attribute__((address_space(3)))
typedef unsigned short bf16_t;
typedef short bf16x8 __attribute__((ext_vector_type(8)));
typedef float f32x4 __attribute__((ext_vector_type(4)));
typedef unsigned u32x4 __attribute__((ext_vector_type(4)));
constexpr int BM = 256, BK = 64, HALF = 128, HTB = HALF * BK * 2  , STAGE_BYTES = 8 * HTB, NXCD = 8, WGM = 8;

__host__ __device__ __forceinline__ int lds_byte(int r, int c) { const int st = (r >> 4) * 2 + (c >> 5), rr = r & 15, cc = c & 31, ob = rr * 64 + cc * 2; return st * 1024 + (ob ^ (((ob >> 9) & 1) << 5)); }
__host__ __device__ __forceinline__ void stage_rc(int b, int& R, int& C) { const int st = b / 1024, sb = b % 1024, swz = sb ^ (((sb >> 9) & 1) << 5); R = (st >> 1) * 16 + swz / 64; C = (st & 1) * 32 + (swz % 64) / 2; }
__host__ __device__ __forceinline__ int perm32(int rho) { const int n = rho >> 4, i = rho & 15; return 8 * (i >> 2) + 4 * n + (i & 3); }

template <class E> struct ABlocked { static constexpr bool v = false; };
struct Unit { int pm, pn, idx, g; };
struct Gemm { const bf16_t* A; const bf16_t* Bt; int M, N, K; };
struct Gemm2 { const bf16_t* A[2]; const bf16_t* Bt[2]; int K[2]; };

struct StaticOrder {
    int nM, nN, nwg, G, c, i0, cnt;
    __host__ __device__ void init(int M, int N, int G_, int c_) { nM = M / BM; nN = N / BM; nwg = nM * nN; G = G_; c = c_; i0 = 0; cnt = 1 << 30; }
    __host__ __device__ __forceinline__ bool next(int i, Unit& u) const {
        if (i >= cnt) return false;
        const int L = (i + i0) * G + c; if (L >= nwg) return false;
        int wgid = L; { const int q = nwg / NXCD, r = nwg % NXCD, xcd = wgid % NXCD, off = wgid / NXCD; wgid = (xcd < r ? xcd * (q + 1) : r * (q + 1) + (xcd - r) * q) + off; }
        const int nig = WGM * nN, gid = wgid / nig, fm = gid * WGM, gsz = (nM - fm) < WGM ? (nM - fm) : WGM;
        u.pm = fm + ((wgid % nig) % gsz); u.pn = (wgid % nig) / gsz; u.idx = i; u.g = 0; return true;
    }
    __device__ __forceinline__ void a_ready(const Unit&) const {}
    __device__ __forceinline__ void done(const Unit&) const {}
};

typedef float f32x2 __attribute__((ext_vector_type(2)));
typedef __bf16 bf16x2_pk __attribute__((ext_vector_type(2)));
__device__ __forceinline__ unsigned cvt_pk_bf16(float lo, float hi) { const f32x2 v = {lo, hi}; return __builtin_bit_cast(unsigned, __builtin_convertvector(v, bf16x2_pk)); }
__device__ __forceinline__ f32x2 gelu_pk(f32x2 v) {
    const f32x2 av = __builtin_elementwise_abs(v), d = av * 0.2316418882f + 1.0f;
    f32x2 t; t.x = __builtin_amdgcn_rcpf(d.x); t.y = __builtin_amdgcn_rcpf(d.y);
    f32x2 q = t * 0.5307027145f + (-0.7265760135f); q = q * t + 0.7107068705f; q = q * t + (-0.142248368f); q = q * t + 0.127414796f; q = q * t;
    const f32x2 s = (v * v) * (-0.72134752044f);
    f32x2 e; e.x = __builtin_amdgcn_exp2f(s.x); e.y = __builtin_amdgcn_exp2f(s.y);
    const f32x2 m = v * (q * e), r = v - m;
    f32x2 o; o.x = v.x < 0.f ? m.x : r.x; o.y = v.y < 0.f ? m.y : r.y; return o;
}

template <int ACT  > struct EpiBf16 {
    static constexpr bool PERM = true, AFTER_DRAIN = false; static_assert(ACT == 0 || ACT == 1, "EpiBf16: ACT is 0 (none) or 1 (gelu_pk)");
    bf16_t* O; int ldc; const float* bias; int split_cols; size_t split_stride; float scale0;
    __device__ __forceinline__ void operator()(const f32x4 (&acc)[2][2][4][2], const Unit& u, int wr, int wc, int fr, int fq) const {
        const int row0 = u.pm * BM + wr * 64 + fr; int colt = u.pn * BM; bf16_t* base = O;
        float sc = 1.f; if (split_cols) { const int t = colt / split_cols; base += (size_t)t * split_stride; colt -= t * split_cols; if (t == 0) sc = scale0; }
        const int col0 = colt + wc * 32 + 8 * fq, bcol0 = u.pn * BM + wc * 32 + 8 * fq;
        f32x4 bv[2][2];
#pragma unroll
        for (int bj = 0; bj < 2; ++bj)
#pragma unroll
            for (int n = 0; n < 2; ++n) bv[bj][n] = bias ? *(const f32x4*)(bias + bcol0 + bj * HALF + 4 * n) : (f32x4){0.f, 0.f, 0.f, 0.f};
#pragma unroll
        for (int ai = 0; ai < 2; ++ai)
#pragma unroll
            for (int m = 0; m < 4; ++m) { bf16_t* rowp = base + (size_t)(row0 + ai * HALF + m * 16) * ldc + col0;
#pragma unroll
                for (int bj = 0; bj < 2; ++bj) { f32x4 v0 = acc[ai][bj][m][0] + bv[bj][0], v1 = acc[ai][bj][m][1] + bv[bj][1];
                    if (ACT == 1) { f32x2 a = gelu_pk((f32x2){v0[0], v0[1]}), b = gelu_pk((f32x2){v0[2], v0[3]}), c = gelu_pk((f32x2){v1[0], v1[1]}), d = gelu_pk((f32x2){v1[2], v1[3]});
                        v0 = (f32x4){a.x, a.y, b.x, b.y}; v1 = (f32x4){c.x, c.y, d.x, d.y}; }
                    v0 = v0 * sc; v1 = v1 * sc; u32x4 w; w.x = cvt_pk_bf16(v0[0], v0[1]); w.y = cvt_pk_bf16(v0[2], v0[3]); w.z = cvt_pk_bf16(v1[0], v1[1]); w.w = cvt_pk_bf16(v1[2], v1[3]);
                    *(u32x4*)(rowp + bj * HALF) = w; } }
    }
};
template <class Epi, class Sched, bool ALIGN_EPI = false, bool SP2 = false>
__device__ __forceinline__ void gemm_phase(PG8_LAS unsigned char* lds, const Gemm g, const Sched& S, const Epi& E, int tid_in) {
    int tid_ = tid_in; asm volatile("" : "+v"(tid_));
    const int tid = tid_, wid = __builtin_amdgcn_readfirstlane(tid >> 6), lane = tid & 63, wr = wid >> 2, wc = wid & 3, fr = lane & 15, fq = lane >> 4;
    const int K = g.K, nt = K / BK;
    unsigned voffA[2], voffB[2];
#pragma unroll
    for (int i = 0; i < 2; ++i) { int R, C; stage_rc(tid * 16 + i * 8192, R, C); const int Rb = Epi::PERM ? ((R & ~31) + perm32(R & 31)) : R;
        voffA[i] = (unsigned)(R * (ABlocked<Epi>::v ? BK : K) + C) * 2u; voffB[i] = (unsigned)(Rb * K + C) * 2u; }
    const size_t kstep = (size_t)(BK * 2);
    const size_t hstep = (size_t)HALF * K * 2;
    const size_t kstepA = ABlocked<Epi>::v ? (size_t)(BM * BK * 2) : kstep, hstepA = ABlocked<Epi>::v ? (size_t)(HALF * BK * 2) : hstep;
    const size_t tstep = 2 * hstep;
    const unsigned ldsw = (unsigned)wid * 1024u;
    const int aoff = lds_byte(wr * 64 + fr, fq * 8), boff = lds_byte(wc * 32 + fr, fq * 8);
#define PG8_SA(b, h) (((b) * 2 + (h)) * HTB)
#define PG8_SB(b, h) ((4 + (b) * 2 + (h)) * HTB)
#define PG8_STAGE(bufoff, gbase, voff) do { _Pragma("unroll") for (int _i = 0; _i < 2; ++_i) \
        __builtin_amdgcn_global_load_lds((const unsigned*)((const char*)(gbase) + (voff)[_i]), (PG8_LAS unsigned*)(lds + (bufoff) + ldsw + _i * 8192), 16, 0, 0); } while (0)
#define PG8_LDA(dst, b, h) do { _Pragma("unroll") for (int m = 0; m < 4; ++m) _Pragma("unroll") for (int k = 0; k < 2; ++k) dst[m][k] = *(const PG8_LAS bf16x8*)(lds + PG8_SA(b, h) + aoff + m * 2048 + k * 1024); } while (0)
#define PG8_LDB(dst, b, h) do { _Pragma("unroll") for (int n = 0; n < 2; ++n) _Pragma("unroll") for (int k = 0; k < 2; ++k) dst[n][k] = *(const PG8_LAS bf16x8*)(lds + PG8_SB(b, h) + boff + n * 2048 + k * 1024); } while (0)
#define PG8_MMA(ai, bj, At, Bt) do { __builtin_amdgcn_s_setprio(1); _Pragma("unroll") for (int m = 0; m < 4; ++m) _Pragma("unroll") for (int n = 0; n < 2; ++n) _Pragma("unroll") for (int k = 0; k < 2; ++k) \
        acc[ai][bj][m][n] = __builtin_amdgcn_mfma_f32_16x16x32_bf16(Bt[n][k], At[m][k], acc[ai][bj][m][n], 0, 0, 0); __builtin_amdgcn_s_setprio(0); } while (0)
#define PG8_WAIT_V(n) asm volatile("s_waitcnt vmcnt(" #n ")" ::: "memory")
#define PG8_WAIT_L(n) asm volatile("s_waitcnt lgkmcnt(" #n ")" ::: "memory")
#define PG8_BAR __builtin_amdgcn_s_barrier()
#define PG8_SCHED __builtin_amdgcn_sched_barrier(0)
    Unit cur, nxt; int ui = 0;
    if (!S.next(0, cur)) return;
    f32x4 acc[2][2][4][2];
#pragma unroll
    for (int a = 0; a < 2; ++a)
#pragma unroll
        for (int b = 0; b < 2; ++b)
#pragma unroll
            for (int m = 0; m < 4; ++m)
#pragma unroll
                for (int n = 0; n < 2; ++n) acc[a][b][m][n] = (f32x4){0.f, 0.f, 0.f, 0.f};
    bf16x8 At[4][2], B0[2][2], B1[2][2];
    const char* cA = (const char*)g.A + (size_t)cur.pm * tstep; const char* cB = (const char*)g.Bt + (size_t)cur.pn * tstep;
    S.a_ready(cur);
    if constexpr (SP2) {
        PG8_STAGE(PG8_SB(0, 0), cB, voffB); PG8_STAGE(PG8_SB(0, 1), cB + hstep, voffB); PG8_STAGE(PG8_SA(0, 0), cA, voffA); PG8_STAGE(PG8_SA(0, 1), cA + hstepA, voffA);
        if (wr == 1) PG8_BAR;
        PG8_WAIT_V(2); PG8_BAR;
        PG8_STAGE(PG8_SB(1, 0), cB + kstep, voffB); PG8_STAGE(PG8_SA(1, 0), cA + kstepA, voffA); PG8_STAGE(PG8_SB(1, 1), cB + hstep + kstep, voffB);
        PG8_WAIT_V(6); PG8_BAR;
    } else {
        PG8_STAGE(PG8_SB(0, 0), cB, voffB); PG8_STAGE(PG8_SA(0, 0), cA, voffA); PG8_STAGE(PG8_SB(0, 1), cB + hstep, voffB); PG8_STAGE(PG8_SA(0, 1), cA + hstepA, voffA);
        if (wr == 1) PG8_BAR;
        PG8_WAIT_V(4); PG8_BAR;
        PG8_STAGE(PG8_SB(1, 0), cB + kstep, voffB); PG8_STAGE(PG8_SA(1, 0), cA + kstepA, voffA); PG8_STAGE(PG8_SB(1, 1), cB + hstep + kstep, voffB);
        PG8_WAIT_V(6); PG8_BAR;
    }
    for (;;) {
        const bool has_next = S.next(ui + 1, nxt);
        const char* nA = has_next ? (const char*)g.A + (size_t)nxt.pm * tstep : cA; const char* nB = has_next ? (const char*)g.Bt + (size_t)nxt.pn * tstep : cB;
        for (int t = 0; t < nt; t += 2) {
            const bool last = (t == nt - 2);
            const char* a1 = cA + (size_t)(t + 1) * kstepA;
            const char* a2 = last ? nA : cA + (size_t)(t + 2) * kstepA; const char* b2 = last ? nB : cB + (size_t)(t + 2) * kstep;
            const char* a3 = a2 + kstepA; const char* b3 = b2 + kstep;
            if (last && has_next) S.a_ready(nxt);
            if constexpr (SP2) {
            PG8_LDB(B0, 0, 0); PG8_LDB(B1, 0, 1); PG8_SCHED; PG8_LDA(At, 0, 0); PG8_STAGE(PG8_SA(1, 1), a1 + hstepA, voffA);
            PG8_WAIT_V(8); PG8_WAIT_L(0); PG8_BAR; PG8_MMA(0, 0, At, B0); PG8_MMA(0, 1, At, B1); PG8_BAR; PG8_SCHED;
            PG8_LDA(At, 0, 1); PG8_STAGE(PG8_SB(0, 0), b2, voffB); PG8_STAGE(PG8_SB(0, 1), b2 + hstep, voffB); PG8_STAGE(PG8_SA(0, 0), a2, voffA);
            PG8_WAIT_V(8); PG8_WAIT_L(0); PG8_BAR; PG8_MMA(1, 0, At, B0); PG8_MMA(1, 1, At, B1); PG8_BAR; PG8_SCHED;
            PG8_LDB(B0, 1, 0); PG8_LDB(B1, 1, 1); PG8_SCHED; PG8_LDA(At, 1, 0); PG8_STAGE(PG8_SA(0, 1), a2 + hstepA, voffA);
            PG8_WAIT_V(8); PG8_WAIT_L(0); PG8_BAR; PG8_MMA(0, 0, At, B0); PG8_MMA(0, 1, At, B1); PG8_BAR; PG8_SCHED;
            PG8_LDA(At, 1, 1); PG8_STAGE(PG8_SB(1, 0), b3, voffB); PG8_STAGE(PG8_SB(1, 1), b3 + hstep, voffB); PG8_STAGE(PG8_SA(1, 0), a3, voffA);
            PG8_WAIT_V(8); PG8_WAIT_L(0); PG8_BAR; PG8_MMA(1, 0, At, B0); PG8_MMA(1, 1, At, B1); PG8_BAR; PG8_SCHED;
            } else {
            PG8_LDB(B0, 0, 0); PG8_SCHED; PG8_LDA(At, 0, 0); PG8_STAGE(PG8_SA(1, 1), a1 + hstepA, voffA);
            PG8_WAIT_L(8); PG8_BAR; PG8_WAIT_L(0); PG8_MMA(0, 0, At, B0); PG8_BAR; PG8_SCHED;
            PG8_LDB(B1, 0, 1); PG8_STAGE(PG8_SB(0, 0), b2, voffB);
            PG8_BAR; PG8_WAIT_L(0); PG8_MMA(0, 1, At, B1); PG8_BAR;
            PG8_LDA(At, 0, 1); PG8_STAGE(PG8_SA(0, 0), a2, voffA);
            PG8_BAR; PG8_WAIT_L(0); PG8_MMA(1, 0, At, B0); PG8_BAR; PG8_SCHED;
            PG8_STAGE(PG8_SB(0, 1), b2 + hstep, voffB);
            PG8_WAIT_V(6); PG8_BAR; PG8_MMA(1, 1, At, B1); PG8_BAR;
            PG8_LDB(B0, 1, 0); PG8_SCHED; PG8_LDA(At, 1, 0); PG8_STAGE(PG8_SA(0, 1), a2 + hstepA, voffA);
            PG8_WAIT_L(8); PG8_BAR; PG8_WAIT_L(0); PG8_MMA(0, 0, At, B0); PG8_BAR; PG8_SCHED;
            PG8_LDB(B1, 1, 1); PG8_STAGE(PG8_SB(1, 0), b3, voffB);
            PG8_BAR; PG8_WAIT_L(0); PG8_MMA(0, 1, At, B1); PG8_BAR;
            PG8_LDA(At, 1, 1); PG8_STAGE(PG8_SA(1, 0), a3, voffA);
            PG8_BAR; PG8_WAIT_L(0); PG8_MMA(1, 0, At, B0); PG8_BAR; PG8_SCHED;
            PG8_STAGE(PG8_SB(1, 1), b3 + hstep, voffB);
            PG8_WAIT_V(6); PG8_BAR; PG8_MMA(1, 1, At, B1); PG8_BAR;
            }
        }
        if constexpr (ALIGN_EPI) { if (wr == 0) PG8_BAR; }
        if constexpr (!Epi::AFTER_DRAIN) { E(acc, cur, wr, wc, fr, fq); S.done(cur); }
        if (!has_next) break;
#pragma unroll
        for (int a = 0; a < 2; ++a)
#pragma unroll
            for (int b = 0; b < 2; ++b)
#pragma unroll
                for (int m = 0; m < 4; ++m)
#pragma unroll
                    for (int n = 0; n < 2; ++n) acc[a][b][m][n] = (f32x4){0.f, 0.f, 0.f, 0.f};
        cur = nxt; cA = nA; cB = nB; ++ui;
        if constexpr (ALIGN_EPI) { if (wr == 1) PG8_BAR; }
    }
    PG8_WAIT_V(0);
    if constexpr (!ALIGN_EPI) { if (wr == 0) PG8_BAR; }
    PG8_BAR;
    if constexpr (Epi::AFTER_DRAIN) { E.fused(acc, cur, wr, wc, fr, fq, lds, wid, lane); S.done(cur); }
#undef PG8_SA
#undef PG8_SB
#undef PG8_STAGE
#undef PG8_LDA
#undef PG8_LDB
#undef PG8_MMA
#undef PG8_WAIT_V
#undef PG8_WAIT_L
#undef PG8_BAR
#undef PG8_SCHED
}

template <class Epi0, class Epi1, class Sched>
__device__ __forceinline__ void gemm_stream2(PG8_LAS unsigned char* lds, const Gemm2 g, const Sched& S, const Epi0& E0, const Epi1& E1, int tid_in) {
    static_assert(Epi0::PERM == Epi1::PERM && !Epi0::AFTER_DRAIN && !Epi1::AFTER_DRAIN, "gemm_stream2: same accumulator layout, in-loop epilogues");
    int tid_ = tid_in; asm volatile("" : "+v"(tid_));
    const int tid = tid_, wid = __builtin_amdgcn_readfirstlane(tid >> 6), lane = tid & 63, wr = wid >> 2, wc = wid & 3, fr = lane & 15, fq = lane >> 4;
    int rA[2], rB[2], cC[2];
#pragma unroll
    for (int i = 0; i < 2; ++i) { int R, C; stage_rc(tid * 16 + i * 8192, R, C); rA[i] = R; rB[i] = Epi0::PERM ? ((R & ~31) + perm32(R & 31)) : R; cC[i] = C; }
    const size_t kstep = (size_t)(BK * 2);
    const unsigned ldsw = (unsigned)wid * 1024u;
    const int aoff = lds_byte(wr * 64 + fr, fq * 8), boff = lds_byte(wc * 32 + fr, fq * 8);
#define PG8_SA(b, h) (((b) * 2 + (h)) * HTB)
#define PG8_SB(b, h) ((4 + (b) * 2 + (h)) * HTB)
#define PG8_STAGE(bufoff, gbase, voff) do { _Pragma("unroll") for (int _i = 0; _i < 2; ++_i) \
        __builtin_amdgcn_global_load_lds((const unsigned*)((const char*)(gbase) + (voff)[_i]), (PG8_LAS unsigned*)(lds + (bufoff) + ldsw + _i * 8192), 16, 0, 0); } while (0)
#define PG8_LDA(dst, b, h) do { _Pragma("unroll") for (int m = 0; m < 4; ++m) _Pragma("unroll") for (int k = 0; k < 2; ++k) dst[m][k] = *(const PG8_LAS bf16x8*)(lds + PG8_SA(b, h) + aoff + m * 2048 + k * 1024); } while (0)
#define PG8_LDB(dst, b, h) do { _Pragma("unroll") for (int n = 0; n < 2; ++n) _Pragma("unroll") for (int k = 0; k < 2; ++k) dst[n][k] = *(const PG8_LAS bf16x8*)(lds + PG8_SB(b, h) + boff + n * 2048 + k * 1024); } while (0)
#define PG8_MMA(ai, bj, At, Bt) do { __builtin_amdgcn_s_setprio(1); _Pragma("unroll") for (int m = 0; m < 4; ++m) _Pragma("unroll") for (int n = 0; n < 2; ++n) _Pragma("unroll") for (int k = 0; k < 2; ++k) \
        acc[ai][bj][m][n] = __builtin_amdgcn_mfma_f32_16x16x32_bf16(Bt[n][k], At[m][k], acc[ai][bj][m][n], 0, 0, 0); __builtin_amdgcn_s_setprio(0); } while (0)
#define PG8_WAIT_V(n) asm volatile("s_waitcnt vmcnt(" #n ")" ::: "memory")
#define PG8_WAIT_L(n) asm volatile("s_waitcnt lgkmcnt(" #n ")" ::: "memory")
#define PG8_BAR __builtin_amdgcn_s_barrier()
#define PG8_SCHED __builtin_amdgcn_sched_barrier(0)
    Unit cur, nxt; int ui = 0;
    if (!S.next(0, cur)) return;
    f32x4 acc[2][2][4][2];
#pragma unroll
    for (int a = 0; a < 2; ++a)
#pragma unroll
        for (int b = 0; b < 2; ++b)
#pragma unroll
            for (int m = 0; m < 4; ++m)
#pragma unroll
                for (int n = 0; n < 2; ++n) acc[a][b][m][n] = (f32x4){0.f, 0.f, 0.f, 0.f};
    bf16x8 At[4][2], B0[2][2], B1[2][2];
    int Kc = cur.g ? g.K[1] : g.K[0];
    size_t hsc = (size_t)HALF * Kc * 2;
    const char* cA = (const char*)(cur.g ? g.A[1] : g.A[0]) + (size_t)cur.pm * 2 * hsc; const char* cB = (const char*)(cur.g ? g.Bt[1] : g.Bt[0]) + (size_t)cur.pn * 2 * hsc;
    unsigned vAc[2], vBc[2];
#pragma unroll
    for (int i = 0; i < 2; ++i) { vAc[i] = (unsigned)(rA[i] * Kc + cC[i]) * 2u; vBc[i] = (unsigned)(rB[i] * Kc + cC[i]) * 2u; }
    PG8_STAGE(PG8_SB(0, 0), cB, vBc); PG8_STAGE(PG8_SB(0, 1), cB + hsc, vBc); PG8_STAGE(PG8_SA(0, 0), cA, vAc); PG8_STAGE(PG8_SA(0, 1), cA + hsc, vAc);
    if (wr == 1) PG8_BAR;
    PG8_WAIT_V(2); PG8_BAR;
    PG8_STAGE(PG8_SB(1, 0), cB + kstep, vBc); PG8_STAGE(PG8_SA(1, 0), cA + kstep, vAc); PG8_STAGE(PG8_SB(1, 1), cB + hsc + kstep, vBc);
    PG8_WAIT_V(6); PG8_BAR;
    for (;;) {
        const bool has_next = S.next(ui + 1, nxt);
        const int Kn = has_next ? (nxt.g ? g.K[1] : g.K[0]) : Kc;
        const size_t hsn = (size_t)HALF * Kn * 2;
        const char* nA = has_next ? (const char*)(nxt.g ? g.A[1] : g.A[0]) + (size_t)nxt.pm * 2 * hsn : cA; const char* nB = has_next ? (const char*)(nxt.g ? g.Bt[1] : g.Bt[0]) + (size_t)nxt.pn * 2 * hsn : cB;
        unsigned vAn[2], vBn[2];
#pragma unroll
        for (int i = 0; i < 2; ++i) { vAn[i] = (unsigned)(rA[i] * Kn + cC[i]) * 2u; vBn[i] = (unsigned)(rB[i] * Kn + cC[i]) * 2u; }
        const int nt = Kc / BK;
        for (int t = 0; t < nt; t += 2) {
            const bool last = (t == nt - 2);
            const char* a1 = cA + (size_t)(t + 1) * kstep;
            const char* a2 = last ? nA : cA + (size_t)(t + 2) * kstep; const char* b2 = last ? nB : cB + (size_t)(t + 2) * kstep;
            const char* a3 = a2 + kstep; const char* b3 = b2 + kstep;
            const size_t hs2 = last ? hsn : hsc;
            unsigned vA2[2], vB2[2];
#pragma unroll
            for (int i = 0; i < 2; ++i) { vA2[i] = last ? vAn[i] : vAc[i]; vB2[i] = last ? vBn[i] : vBc[i]; }
            PG8_LDB(B0, 0, 0); PG8_LDB(B1, 0, 1); PG8_SCHED; PG8_LDA(At, 0, 0); PG8_STAGE(PG8_SA(1, 1), a1 + hsc, vAc);
            PG8_WAIT_V(8); PG8_WAIT_L(0); PG8_BAR; PG8_MMA(0, 0, At, B0); PG8_MMA(0, 1, At, B1); PG8_BAR; PG8_SCHED;
            PG8_LDA(At, 0, 1); PG8_STAGE(PG8_SB(0, 0), b2, vB2); PG8_STAGE(PG8_SB(0, 1), b2 + hs2, vB2); PG8_STAGE(PG8_SA(0, 0), a2, vA2);
            PG8_WAIT_V(8); PG8_WAIT_L(0); PG8_BAR; PG8_MMA(1, 0, At, B0); PG8_MMA(1, 1, At, B1); PG8_BAR; PG8_SCHED;
            PG8_LDB(B0, 1, 0); PG8_LDB(B1, 1, 1); PG8_SCHED; PG8_LDA(At, 1, 0); PG8_STAGE(PG8_SA(0, 1), a2 + hs2, vA2);
            PG8_WAIT_V(8); PG8_WAIT_L(0); PG8_BAR; PG8_MMA(0, 0, At, B0); PG8_MMA(0, 1, At, B1); PG8_BAR; PG8_SCHED;
            PG8_LDA(At, 1, 1); PG8_STAGE(PG8_SB(1, 0), b3, vB2); PG8_STAGE(PG8_SB(1, 1), b3 + hs2, vB2); PG8_STAGE(PG8_SA(1, 0), a3, vA2);
            PG8_WAIT_V(8); PG8_WAIT_L(0); PG8_BAR; PG8_MMA(1, 0, At, B0); PG8_MMA(1, 1, At, B1); PG8_BAR; PG8_SCHED;
        }
        if (wr == 0) PG8_BAR;
        if (cur.g == 0) E0(acc, cur, wr, wc, fr, fq); else E1(acc, cur, wr, wc, fr, fq);
        if (!has_next) break;
#pragma unroll
        for (int a = 0; a < 2; ++a)
#pragma unroll
            for (int b = 0; b < 2; ++b)
#pragma unroll
                for (int m = 0; m < 4; ++m)
#pragma unroll
                    for (int n = 0; n < 2; ++n) acc[a][b][m][n] = (f32x4){0.f, 0.f, 0.f, 0.f};
        cur = nxt; cA = nA; cB = nB; Kc = Kn; hsc = hsn; ++ui;
#pragma unroll
        for (int i = 0; i < 2; ++i) { vAc[i] = vAn[i]; vBc[i] = vBn[i]; }
        if (wr == 1) PG8_BAR;
    }
    PG8_WAIT_V(0);
    PG8_BAR;
#undef PG8_SA
#undef PG8_SB
#undef PG8_STAGE
#undef PG8_LDA
#undef PG8_LDB
#undef PG8_MMA
#undef PG8_WAIT_V
#undef PG8_WAIT_L
#undef PG8_BAR
#undef PG8_SCHED
}
}
namespace pg8 {
typedef unsigned u32x2 __attribute__((ext_vector_type(2)));
__device__ __forceinline__ float bf_lo(unsigned w) { return __builtin_bit_cast(float, w << 16); }
__device__ __forceinline__ float bf_hi(unsigned w) { return __builtin_bit_cast(float, w & 0xffff0000u); }
__device__ __forceinline__ float sigm_l2(float y) { return __builtin_amdgcn_rcpf(1.0f + __builtin_amdgcn_exp2f(y)); }
__device__ __forceinline__ float sigm(float x) { return __builtin_amdgcn_rcpf(1.0f + __expf(-x)); }

__device__ __forceinline__ float row_rstd(const float* ssq, size_t row) {
    const f32x4 a = *(const f32x4*)(ssq + row * 16), b = *(const f32x4*)(ssq + row * 16 + 4), c = *(const f32x4*)(ssq + row * 16 + 8), d = *(const f32x4*)(ssq + row * 16 + 12);
    const float s = ((a.x + a.y) + (a.z + a.w)) + ((b.x + b.y) + (b.z + b.w)) + ((c.x + c.y) + (c.z + c.w)) + ((d.x + d.y) + (d.z + d.w));
    return 1.0f / sqrtf(s * (1.0f / 1024.0f) + 1e-6f);
}
constexpr int RSTD_CAP = 12;
struct RstdTab { const PG8_LAS float* tab;
    __device__ __forceinline__ float get(const Unit& u, int lrow) const { return tab[u.idx * 256 + lrow]; } };
struct EpiProj {
    static constexpr bool PERM = true, AFTER_DRAIN = false;
    bf16_t *U, *Q, *KV, *QKG, *VG, *RG; float* SMALL; const float* rope; RstdTab RS; int Mrows; bf16_t *VST, *VWT; int seq;
    __device__ __forceinline__ void operator()(const f32x4 (&acc)[2][2][4][2], const Unit& u, int wr, int wc, int fr, int fq) const {
        const int pn = u.pn, row0 = u.pm * BM + wr * 64 + fr;
        if (pn == 13) {
            if (wc < 2) {
#pragma unroll
                for (int ai = 0; ai < 2; ++ai)
#pragma unroll
                    for (int m = 0; m < 4; ++m) { const size_t row = (size_t)(row0 + ai * HALF + m * 16); const float rs = RS.get(u, wr * 64 + fr + ai * HALF + m * 16); float* rp = SMALL + row * 64 + wc * 32 + 8 * fq;
                        *(f32x4*)rp = acc[ai][0][m][0] * rs; *(f32x4*)(rp + 4) = acc[ai][0][m][1] * rs; }
            }
            return;
        }
        bf16_t* base; int ld, colt; bool isq = false, iskv = false;
        if (pn < 2) { base = U; ld = 512; colt = pn * 256; }
        else if (pn < 4) { base = Q; ld = 512; colt = (pn - 2) * 256; isq = true; }
        else if (pn < 7) { base = KV; ld = 768; colt = (pn - 4) * 256; iskv = true; }
        else if (pn < 9) { base = QKG; ld = 512; colt = (pn - 7) * 256; }
        else if (pn < 11) { base = VG; ld = 512; colt = (pn - 9) * 256; }
        else { base = RG; ld = 512; colt = (pn - 11) * 256; }
        const int col0 = colt + wc * 32 + 8 * fq;
        const float sc = isq ? 0.125f * 1.4426950408889634f : 1.0f;
        const bool ropew = (isq || iskv) && ((wc & 1) == 0);
#pragma unroll
        for (int ap = 0; ap < 4; ++ap) {
            const int ai = ap >> 1;
            f32x4 rc[2][4];
#pragma unroll
            for (int mm = 0; mm < 2; ++mm)
#pragma unroll
                for (int q = 0; q < 4; ++q) rc[mm][q] = (ropew && fq < 2) ? *(const f32x4*)(rope + (size_t)(row0 + ai * HALF + (2 * (ap & 1) + mm) * 16) * 16 + 4 * q) : (f32x4){0.f, 0.f, 0.f, 0.f};
            float rsr[2];
#pragma unroll
            for (int mm = 0; mm < 2; ++mm) rsr[mm] = RS.get(u, wr * 64 + fr + ai * HALF + (2 * (ap & 1) + mm) * 16) * sc;
#pragma unroll
            for (int mm = 0; mm < 2; ++mm) {
                const int m = 2 * (ap & 1) + mm;
                const int row = row0 + ai * HALF + m * 16;
                bf16_t* rowp = base + (size_t)row * ld + col0;
#pragma unroll
                for (int bj = 0; bj < 2; ++bj) {
                    f32x4 v0 = acc[ai][bj][m][0] * rsr[mm], v1 = acc[ai][bj][m][1] * rsr[mm];
                    if (ropew && (isq || bj == 0)) {
                        f32x4 o0, o1;
#pragma unroll
                        for (int e = 0; e < 4; ++e) { o0[e] = __shfl_xor(v0[e], 16); o1[e] = __shfl_xor(v1[e], 16); }
                        if (fq < 2) {
                            const float sg = (fq == 0) ? -1.0f : 1.0f;
                            v0 = v0 * rc[mm][0] + (o0 * rc[mm][2]) * sg; v1 = v1 * rc[mm][1] + (o1 * rc[mm][3]) * sg;
                        }
                    }
                    u32x4 w; w.x = cvt_pk_bf16(v0[0], v0[1]); w.y = cvt_pk_bf16(v0[2], v0[3]); w.z = cvt_pk_bf16(v1[0], v1[1]); w.w = cvt_pk_bf16(v1[2], v1[3]);
                    if (iskv && bj == 1 && pn >= 5) {
                        const int bb = row / seq, tl = row - bb * seq;
                        bf16_t* vt = (pn == 5 ? VST : VWT) + ((size_t)((bb * 2 + (wc >> 1)) * (seq >> 6) + (tl >> 6)) * 64 + 32 * (wc & 1) + 8 * fq) * 64 + (tl & 63);
                        vt[0 * 64] = (bf16_t)(w.x & 0xffffu); vt[1 * 64] = (bf16_t)(w.x >> 16); vt[2 * 64] = (bf16_t)(w.y & 0xffffu); vt[3 * 64] = (bf16_t)(w.y >> 16);
                        vt[4 * 64] = (bf16_t)(w.z & 0xffffu); vt[5 * 64] = (bf16_t)(w.z >> 16); vt[6 * 64] = (bf16_t)(w.w & 0xffffu); vt[7 * 64] = (bf16_t)(w.w >> 16); }
                    else if (iskv) *(u32x4*)(KV + ((size_t)((2 * (pn - 4) + bj) * 2 + (wc >> 1)) * Mrows + row) * 64 + 32 * (wc & 1) + 8 * fq) = w;
                    else *(u32x4*)(rowp + bj * HALF) = w;
                }
            }
        }
    }
};

template <int FN> struct EpiAct {
    static constexpr bool PERM = true, AFTER_DRAIN = false;
    bf16_t* O; int ldc;
    __device__ __forceinline__ void operator()(const f32x4 (&acc)[2][2][4][2], const Unit& u, int wr, int wc, int fr, int fq) const {
        const int row0 = u.pm * BM + wr * 64 + fr, col0 = u.pn * BM + wc * 32 + 8 * fq;
#pragma unroll
        for (int ai = 0; ai < 2; ++ai)
#pragma unroll
            for (int m = 0; m < 4; ++m) { bf16_t* rowp = O + (size_t)(row0 + ai * HALF + m * 16) * ldc + col0;
#pragma unroll
                for (int bj = 0; bj < 2; ++bj) { f32x4 v0 = acc[ai][bj][m][0], v1 = acc[ai][bj][m][1];
                    if (FN == 1) {
#pragma unroll
                        for (int e = 0; e < 4; ++e) { v0[e] = sigm(v0[e]); v1[e] = sigm(v1[e]); } }
                    if (FN == 2) {
#pragma unroll
                        for (int e = 0; e < 4; ++e) { const float a = fmaxf(v0[e], 0.f), b = fmaxf(v1[e], 0.f); v0[e] = a * a; v1[e] = b * b; } }
                    u32x4 w; w.x = cvt_pk_bf16(v0[0], v0[1]); w.y = cvt_pk_bf16(v0[2], v0[3]); w.z = cvt_pk_bf16(v1[0], v1[1]); w.w = cvt_pk_bf16(v1[2], v1[3]);
                    *(u32x4*)(rowp + bj * HALF) = w; } }
    }
};

template <bool FIRST> struct EpiBranch {
    static constexpr bool PERM = true, AFTER_DRAIN = false;
    bf16_t* MG; const bf16_t* GM; int kofs;
    __device__ __forceinline__ void operator()(const f32x4 (&acc)[2][2][4][2], const Unit& u, int wr, int wc, int fr, int fq) const {
        const int row0 = u.pm * BM + wr * 64 + fr, col0 = u.pn * BM + wc * 32 + 8 * fq;
#pragma unroll
        for (int ai = 0; ai < 2; ++ai) {
            u32x4 gw[4][2], ow[4][2];
#pragma unroll
            for (int m = 0; m < 4; ++m)
#pragma unroll
                for (int bj = 0; bj < 2; ++bj) { const size_t row = (size_t)(row0 + ai * HALF + m * 16);
                    gw[m][bj] = *(const u32x4*)(GM + row * 3072 + kofs + col0 + bj * HALF);
                    if (!FIRST) ow[m][bj] = *(const u32x4*)(MG + row * 1024 + col0 + bj * HALF); }
#pragma unroll
            for (int m = 0; m < 4; ++m)
#pragma unroll
                for (int bj = 0; bj < 2; ++bj) { const size_t row = (size_t)(row0 + ai * HALF + m * 16);
                    f32x4 v0 = acc[ai][bj][m][0], v1 = acc[ai][bj][m][1]; const u32x4 g = gw[m][bj];
                    v0[0] *= bf_lo(g.x); v0[1] *= bf_hi(g.x); v0[2] *= bf_lo(g.y); v0[3] *= bf_hi(g.y);
                    v1[0] *= bf_lo(g.z); v1[1] *= bf_hi(g.z); v1[2] *= bf_lo(g.w); v1[3] *= bf_hi(g.w);
                    if (!FIRST) { const u32x4 o = ow[m][bj];
                        v0[0] += bf_lo(o.x); v0[1] += bf_hi(o.x); v0[2] += bf_lo(o.y); v0[3] += bf_hi(o.y);
                        v1[0] += bf_lo(o.z); v1[1] += bf_hi(o.z); v1[2] += bf_lo(o.w); v1[3] += bf_hi(o.w); }
                    u32x4 w; w.x = cvt_pk_bf16(v0[0], v0[1]); w.y = cvt_pk_bf16(v0[2], v0[3]); w.z = cvt_pk_bf16(v1[0], v1[1]); w.w = cvt_pk_bf16(v1[2], v1[3]);
                    *(u32x4*)(MG + row * 1024 + col0 + bj * HALF) = w; }
        }
    }
};

struct BranchOrder {
    StaticOrder S0; int per, nM;
    __device__ __forceinline__ void init(int M, int N, int G, int c) { S0.init(M, N, G, c); nM = M / BM; per = 0; Unit u; while (S0.next(per, u)) ++per; }
    __device__ __forceinline__ bool next(int i, Unit& u) const {
        if (i >= 3 * per) return false;
        const int k = (i >= 2 * per) ? 2 : ((i >= per) ? 1 : 0);
        if (!S0.next(i - k * per, u)) return false;
        u.pm += k * nM; u.pn += 4 * k; u.idx = i; return true;
    }
    __device__ __forceinline__ void a_ready(const Unit&) const {}
    __device__ __forceinline__ void done(const Unit&) const {}
};
struct GateBranchOrder {
    StaticOrder S0; int per, nM;
    __device__ __forceinline__ void init(int M, int N, int G, int c) { S0.init(M, N, G, c); nM = M / BM; per = 0; Unit u; while (S0.next(per, u)) ++per; }
    __device__ __forceinline__ bool next(int i, Unit& u) const {
        if (i >= 6 * per) return false;
        const int j = i / 6, r = i - 6 * j, k = r >> 1;
        if (!S0.next(j, u)) return false;
        if (r & 1) { u.g = 1; u.pm += k * nM; u.pn += 4 * k; u.idx = i; }
        else { u.g = 0; u.pn += 4 * k; u.idx = j; }
        return true;
    }
};
struct PlePairOrder {
    StaticOrder S0; int per;
    __device__ __forceinline__ void init(int M, int N, int G, int c) { S0.init(M, N, G, c); per = 0; Unit u; while (S0.next(per, u)) ++per; }
    __device__ __forceinline__ bool next(int i, Unit& u) const {
        if (i >= 2 * per) return false;
        const int j = i >> 1;
        if (!S0.next(j, u)) return false;
        u.g = i & 1; u.idx = j; return true;
    }
};
struct EpiTile {
    static constexpr bool PERM = true, AFTER_DRAIN = false;
    bf16_t* T;
    __device__ __forceinline__ void operator()(const f32x4 (&acc)[2][2][4][2], const Unit& u, int wr, int wc, int fr, int fq) const {
        int lofs = (wr * 64 + fr) * 256 + wc * 32 + 8 * fq; asm volatile("" : "+v"(lofs));
#pragma unroll
        for (int ai = 0; ai < 2; ++ai)
#pragma unroll
            for (int m = 0; m < 4; ++m)
#pragma unroll
                for (int bj = 0; bj < 2; ++bj) { const f32x4 v0 = acc[ai][bj][m][0], v1 = acc[ai][bj][m][1];
                    u32x4 w; w.x = cvt_pk_bf16(v0[0], v0[1]); w.y = cvt_pk_bf16(v0[2], v0[3]); w.z = cvt_pk_bf16(v1[0], v1[1]); w.w = cvt_pk_bf16(v1[2], v1[3]);
                    *(u32x4*)(T + lofs + (ai * HALF + m * 16) * 256 + bj * HALF) = w; }
    }
};
struct EpiBranchR {
    static constexpr bool PERM = true, AFTER_DRAIN = false;
    bf16_t* MG; const bf16_t* GM; bf16_t* PS; int nM;
    __device__ __forceinline__ void operator()(const f32x4 (&acc)[2][2][4][2], const Unit& u, int wr, int wc, int fr, int fq) const {
        const int k = (u.pm >= 2 * nM) ? 2 : ((u.pm >= nM) ? 1 : 0), pm = u.pm - k * nM, pn = u.pn - 4 * k;
        const int row0 = pm * BM + wr * 64 + fr, col0 = pn * BM + wc * 32 + 8 * fq;
        int lofs = (wr * 64 + fr) * 256 + wc * 32 + 8 * fq; asm volatile("" : "+v"(lofs));
        int mofs = (wr * 64 + fr) * BK + (wc & 1) * 32 + 8 * fq + (wc >> 1) * (BM * BK); asm volatile("" : "+v"(mofs));
#pragma unroll
        for (int ai = 0; ai < 2; ++ai) {
            u32x4 gw[4][2], ow[4][2];
#pragma unroll
            for (int m = 0; m < 4; ++m)
#pragma unroll
                for (int bj = 0; bj < 2; ++bj) { const size_t row = (size_t)(row0 + ai * HALF + m * 16);
                    gw[m][bj] = *(const u32x4*)(GM + lofs + (ai * HALF + m * 16) * 256 + bj * HALF);
                    ow[m][bj] = (k != 0) ? *(const u32x4*)(PS + lofs + (ai * HALF + m * 16) * 256 + bj * HALF) : (u32x4){0u, 0u, 0u, 0u}; }
#pragma unroll
            for (int m = 0; m < 4; ++m)
#pragma unroll
                for (int bj = 0; bj < 2; ++bj) { const size_t row = (size_t)(row0 + ai * HALF + m * 16);
                    f32x4 v0 = acc[ai][bj][m][0], v1 = acc[ai][bj][m][1]; const u32x4 g = gw[m][bj], o = ow[m][bj];
                    v0[0] = v0[0] * bf_lo(g.x) + bf_lo(o.x); v0[1] = v0[1] * bf_hi(g.x) + bf_hi(o.x); v0[2] = v0[2] * bf_lo(g.y) + bf_lo(o.y); v0[3] = v0[3] * bf_hi(g.y) + bf_hi(o.y);
                    v1[0] = v1[0] * bf_lo(g.z) + bf_lo(o.z); v1[1] = v1[1] * bf_hi(g.z) + bf_hi(o.z); v1[2] = v1[2] * bf_lo(g.w) + bf_lo(o.w); v1[3] = v1[3] * bf_hi(g.w) + bf_hi(o.w);
                    u32x4 w; w.x = cvt_pk_bf16(v0[0], v0[1]); w.y = cvt_pk_bf16(v0[2], v0[3]); w.z = cvt_pk_bf16(v1[0], v1[1]); w.w = cvt_pk_bf16(v1[2], v1[3]);
                    if (k == 2) *(u32x4*)(MG + (size_t)pm * (1024 * BM) + (size_t)(pn * 4 + bj * 2) * (BM * BK) + mofs + (ai * HALF + m * 16) * BK) = w; else *(u32x4*)(PS + lofs + (ai * HALF + m * 16) * 256 + bj * HALF) = w; }
        }
    }
};

struct EpiRes {
    static constexpr bool PERM = false, AFTER_DRAIN = false;
    const float* in; float* out;
    __device__ __forceinline__ void operator()(const f32x4 (&acc)[2][2][4][2], const Unit& u, int wr, int wc, int fr, int fq) const {
        const int row0 = u.pm * BM + wr * 64 + fr, col0 = u.pn * BM + wc * 32 + 4 * fq;
#pragma unroll
        for (int ai = 0; ai < 2; ++ai)
#pragma unroll
            for (int m = 0; m < 4; ++m) { const size_t off = (size_t)(row0 + ai * HALF + m * 16) * 1024 + col0;
#pragma unroll
                for (int bj = 0; bj < 2; ++bj)
#pragma unroll
                    for (int n = 0; n < 2; ++n) { const f32x4 b = *(const f32x4*)(in + off + bj * HALF + n * 16); *(f32x4*)(out + off + bj * HALF + n * 16) = b + acc[ai][bj][m][n]; } }
    }
};

struct EpiPle {
    static constexpr bool PERM = false, AFTER_DRAIN = false;
    float* h; const bf16_t* PP;
    __device__ __forceinline__ void operator()(const f32x4 (&acc)[2][2][4][2], const Unit& u, int wr, int wc, int fr, int fq) const {
        const int row0 = u.pm * BM + wr * 64 + fr, col0 = u.pn * BM + wc * 32 + 4 * fq;
#pragma unroll
        for (int ai = 0; ai < 2; ++ai)
#pragma unroll
            for (int m = 0; m < 4; ++m) { const size_t off = (size_t)(row0 + ai * HALF + m * 16) * 1024 + col0;
#pragma unroll
                for (int bj = 0; bj < 2; ++bj)
#pragma unroll
                    for (int n = 0; n < 2; ++n) { const size_t o = off + bj * HALF + n * 16; const u32x2 pw = *(const u32x2*)(PP + o); const f32x4 b = *(const f32x4*)(h + o); const f32x4 a = acc[ai][bj][m][n];
                        f32x4 r; r[0] = b[0] + sigm(a[0]) * bf_lo(pw.x); r[1] = b[1] + sigm(a[1]) * bf_hi(pw.x); r[2] = b[2] + sigm(a[2]) * bf_lo(pw.y); r[3] = b[3] + sigm(a[3]) * bf_hi(pw.y);
                        *(f32x4*)(h + o) = r; } }
    }
};
struct EpiResN {
    static constexpr bool PERM = false, AFTER_DRAIN = false;
    const float* in; float* out; bf16_t* HB; float* SSQ;
    __device__ __forceinline__ void operator()(const f32x4 (&acc)[2][2][4][2], const Unit& u, int wr, int wc, int fr, int fq) const {
        const int row0 = u.pm * BM + wr * 64 + fr, col0 = u.pn * BM + wc * 32 + 4 * fq;
#pragma unroll
        for (int ai = 0; ai < 2; ++ai) {
            f32x4 iv[4][2][2];
#pragma unroll
            for (int m = 0; m < 4; ++m)
#pragma unroll
                for (int bj = 0; bj < 2; ++bj)
#pragma unroll
                    for (int n = 0; n < 2; ++n) iv[m][bj][n] = *(const f32x4*)(in + (size_t)(row0 + ai * HALF + m * 16) * 1024 + col0 + bj * HALF + n * 16);
#pragma unroll
            for (int m = 0; m < 4; ++m) { const size_t row = (size_t)(row0 + ai * HALF + m * 16); const size_t off = row * 1024 + col0; float ss = 0.f;
#pragma unroll
                for (int bj = 0; bj < 2; ++bj)
#pragma unroll
                    for (int n = 0; n < 2; ++n) { const size_t o = off + bj * HALF + n * 16; const f32x4 v = iv[m][bj][n] + acc[ai][bj][m][n]; *(f32x4*)(out + o) = v;
                        u32x2 w; w.x = cvt_pk_bf16(v[0], v[1]); w.y = cvt_pk_bf16(v[2], v[3]); *(u32x2*)(HB + o) = w;
                        ss += (v[0] * v[0] + v[1] * v[1]) + (v[2] * v[2] + v[3] * v[3]); }
                ss += __shfl_xor(ss, 16); ss += __shfl_xor(ss, 32);
                if (fq == 0) SSQ[row * 16 + u.pn * 4 + wc] = ss; }
        }
    }
};
template <bool NORS> struct EpiRelu2NT {
    static constexpr bool PERM = true, AFTER_DRAIN = false;
    bf16_t* O; int ldc; RstdTab RS;
    __device__ __forceinline__ void operator()(const f32x4 (&acc)[2][2][4][2], const Unit& u, int wr, int wc, int fr, int fq) const {
        const int row0 = u.pm * BM + wr * 64 + fr, col0 = u.pn * BM + wc * 32 + 8 * fq;
#pragma unroll
        for (int ai = 0; ai < 2; ++ai) {
            float rs[4];
#pragma unroll
            for (int m = 0; m < 4; ++m) rs[m] = NORS ? 1.0f : RS.get(u, wr * 64 + fr + ai * HALF + m * 16);
#pragma unroll
            for (int m = 0; m < 4; ++m) { bf16_t* rowp = O + (size_t)u.pm * ((size_t)ldc * BM) + (size_t)(u.pn * 4 + (wc >> 1)) * (BM * BK) + (wr * 64 + fr + ai * HALF + m * 16) * BK + (wc & 1) * 32 + 8 * fq;
#pragma unroll
                for (int bj = 0; bj < 2; ++bj) { f32x4 v0 = acc[ai][bj][m][0] * rs[m], v1 = acc[ai][bj][m][1] * rs[m];
#pragma unroll
                    for (int e = 0; e < 4; ++e) { v0[e] = fmaxf(v0[e], 0.f); v1[e] = fmaxf(v1[e], 0.f); }
                    v0 = v0 * v0; v1 = v1 * v1;
                    u32x4 w; w.x = cvt_pk_bf16(v0[0], v0[1]); w.y = cvt_pk_bf16(v0[2], v0[3]); w.z = cvt_pk_bf16(v1[0], v1[1]); w.w = cvt_pk_bf16(v1[2], v1[3]);
                    *(u32x4*)(rowp + bj * (2 * BM * BK)) = w; } }
        }
    }
};
typedef EpiRelu2NT<false> EpiRelu2N;
struct EpiPleN {
    static constexpr bool PERM = false, AFTER_DRAIN = false;
    float* h; const bf16_t* PP; const float* SSQ;
    __device__ __forceinline__ void operator()(const f32x4 (&acc)[2][2][4][2], const Unit& u, int wr, int wc, int fr, int fq) const {
        const int row0 = u.pm * BM + wr * 64 + fr, col0 = u.pn * BM + wc * 32 + 4 * fq;
#pragma unroll
        for (int ai = 0; ai < 2; ++ai)
#pragma unroll
            for (int mp = 0; mp < 2; ++mp) {
                float rs[2]; f32x4 hv[2][2][2]; u32x2 pw[2][2][2];
#pragma unroll
                for (int mm = 0; mm < 2; ++mm) { const size_t row = (size_t)(row0 + ai * HALF + (2 * mp + mm) * 16); rs[mm] = row_rstd(SSQ, row);
#pragma unroll
                    for (int bj = 0; bj < 2; ++bj)
#pragma unroll
                        for (int n = 0; n < 2; ++n) { const size_t o = row * 1024 + col0 + bj * HALF + n * 16; hv[mm][bj][n] = *(const f32x4*)(h + o); pw[mm][bj][n] = *(const u32x2*)(PP + o); } }
#pragma unroll
                for (int mm = 0; mm < 2; ++mm) { const int m = 2 * mp + mm; const size_t row = (size_t)(row0 + ai * HALF + m * 16);
#pragma unroll
                    for (int bj = 0; bj < 2; ++bj)
#pragma unroll
                        for (int n = 0; n < 2; ++n) { const size_t o = row * 1024 + col0 + bj * HALF + n * 16; const f32x4 a = acc[ai][bj][m][n] * rs[mm], b = hv[mm][bj][n]; const u32x2 p = pw[mm][bj][n];
                            f32x4 r; r[0] = b[0] + sigm(a[0]) * bf_lo(p.x); r[1] = b[1] + sigm(a[1]) * bf_hi(p.x); r[2] = b[2] + sigm(a[2]) * bf_lo(p.y); r[3] = b[3] + sigm(a[3]) * bf_hi(p.y);
                            *(f32x4*)(h + o) = r; } }
            }
    }
};
struct EpiSigN {
    static constexpr bool PERM = true, AFTER_DRAIN = false;
    bf16_t* O; int ldc; RstdTab RS;
    __device__ __forceinline__ void operator()(const f32x4 (&acc)[2][2][4][2], const Unit& u, int wr, int wc, int fr, int fq) const {
        int lofs = (wr * 64 + fr) * 256 + wc * 32 + 8 * fq; asm volatile("" : "+v"(lofs));
#pragma unroll
        for (int ai = 0; ai < 2; ++ai) {
            float rs[4];
#pragma unroll
            for (int m = 0; m < 4; ++m) rs[m] = RS.get(u, wr * 64 + fr + ai * HALF + m * 16) * -1.4426950408889634f;
#pragma unroll
            for (int m = 0; m < 4; ++m) { bf16_t* rowp = O + lofs + (ai * HALF + m * 16) * 256;
#pragma unroll
                for (int bj = 0; bj < 2; ++bj) { f32x4 v0 = acc[ai][bj][m][0] * rs[m], v1 = acc[ai][bj][m][1] * rs[m];
#pragma unroll
                    for (int e = 0; e < 4; ++e) { v0[e] = sigm_l2(v0[e]); v1[e] = sigm_l2(v1[e]); }
                    u32x4 w; w.x = cvt_pk_bf16(v0[0], v0[1]); w.y = cvt_pk_bf16(v0[2], v0[3]); w.z = cvt_pk_bf16(v1[0], v1[1]); w.w = cvt_pk_bf16(v1[2], v1[3]);
                    *(u32x4*)(rowp + bj * HALF) = w; } }
        }
    }
};
template <int MODE, bool MIRROR> struct EpiStream {
    static constexpr bool PERM = true, AFTER_DRAIN = false;
    bf16_t* H; bf16_t* H2; float* SSQo; RstdTab RSi; const bf16_t* PP;
    __device__ __forceinline__ void operator()(const f32x4 (&acc)[2][2][4][2], const Unit& u, int wr, int wc, int fr, int fq) const {
        const int row0 = u.pm * BM + wr * 64 + fr, col0 = u.pn * BM + wc * 32 + 8 * fq;
        int lofs = (wr * 64 + fr) * 256 + wc * 32 + 8 * fq; if (MODE == 1) asm volatile("" : "+v"(lofs));
        constexpr int NB = (MODE == 1) ? 2 : 4;
#pragma unroll
        for (int bt = 0; bt < 8 / NB; ++bt) {
            u32x4 hw[NB][2], pw[NB][2]; float rs[NB];
#pragma unroll
            for (int mm = 0; mm < NB; ++mm) { const int rg = bt * NB + mm, ai = rg >> 2, m = rg & 3; const size_t row = (size_t)(row0 + ai * HALF + m * 16);
                rs[mm] = (MODE == 1) ? RSi.get(u, wr * 64 + fr + ai * HALF + m * 16) * -1.4426950408889634f : 1.0f;
#pragma unroll
                for (int bj = 0; bj < 2; ++bj) { hw[mm][bj] = *(const u32x4*)(H + row * 1024 + col0 + bj * HALF); if (MODE == 1) pw[mm][bj] = *(const u32x4*)(PP + lofs + (ai * HALF + m * 16) * 256 + bj * HALF); } }
#pragma unroll
            for (int mm = 0; mm < NB; ++mm) { const int rg = bt * NB + mm, ai = rg >> 2, m = rg & 3; const size_t row = (size_t)(row0 + ai * HALF + m * 16); float ss = 0.f;
#pragma unroll
                for (int bj = 0; bj < 2; ++bj) { f32x4 v0 = acc[ai][bj][m][0], v1 = acc[ai][bj][m][1]; const u32x4 hh = hw[mm][bj];
                    if (MODE == 1) { const u32x4 p = pw[mm][bj]; v0 = v0 * rs[mm]; v1 = v1 * rs[mm];
                        v0[0] = sigm_l2(v0[0]) * bf_lo(p.x); v0[1] = sigm_l2(v0[1]) * bf_hi(p.x); v0[2] = sigm_l2(v0[2]) * bf_lo(p.y); v0[3] = sigm_l2(v0[3]) * bf_hi(p.y);
                        v1[0] = sigm_l2(v1[0]) * bf_lo(p.z); v1[1] = sigm_l2(v1[1]) * bf_hi(p.z); v1[2] = sigm_l2(v1[2]) * bf_lo(p.w); v1[3] = sigm_l2(v1[3]) * bf_hi(p.w); }
                    v0[0] += bf_lo(hh.x); v0[1] += bf_hi(hh.x); v0[2] += bf_lo(hh.y); v0[3] += bf_hi(hh.y); v1[0] += bf_lo(hh.z); v1[1] += bf_hi(hh.z); v1[2] += bf_lo(hh.w); v1[3] += bf_hi(hh.w);
                    u32x4 w; w.x = cvt_pk_bf16(v0[0], v0[1]); w.y = cvt_pk_bf16(v0[2], v0[3]); w.z = cvt_pk_bf16(v1[0], v1[1]); w.w = cvt_pk_bf16(v1[2], v1[3]);
                    *(u32x4*)((MIRROR ? H2 : H) + row * 1024 + col0 + bj * HALF) = w;
                    const float r0 = bf_lo(w.x), r1 = bf_hi(w.x), r2 = bf_lo(w.y), r3 = bf_hi(w.y), r4 = bf_lo(w.z), r5 = bf_hi(w.z), r6 = bf_lo(w.w), r7 = bf_hi(w.w);
                    ss += ((r0 * r0 + r1 * r1) + (r2 * r2 + r3 * r3)) + ((r4 * r4 + r5 * r5) + (r6 * r6 + r7 * r7)); }
                ss += __shfl_xor(ss, 16); ss += __shfl_xor(ss, 32);
                if (fq == 0) SSQo[row * 16 + u.pn * 4 + wc] = ss; }
        }
    }
};
template <> struct ABlocked<EpiStream<0, true>> { static constexpr bool v = true; };
template <> struct ABlocked<EpiStream<0, false>> { static constexpr bool v = true; };
}
#define GAS __attribute__((address_space(1)))
#define LAS __attribute__((address_space(3)))
typedef unsigned short bf16;
typedef unsigned v4u __attribute__((ext_vector_type(4)));
typedef float f32x4 __attribute__((ext_vector_type(4)));
typedef short bf16x8 __attribute__((ext_vector_type(8)));
typedef GAS unsigned gu32;
typedef GAS unsigned long long gu64;
#define RLX_AGENT __ATOMIC_RELAXED, __HIP_MEMORY_SCOPE_AGENT
#define LDS_WAIT() asm volatile("s_waitcnt lgkmcnt(0)" ::: "memory")
#define VM_WAIT() asm volatile("s_waitcnt vmcnt(0)" ::: "memory")
__device__ __forceinline__ unsigned long long rt() { return __builtin_amdgcn_s_memrealtime(); }
__device__ __forceinline__ unsigned f2bf(float f) { unsigned u = __builtin_bit_cast(unsigned, f); return (u + 0x7fffu + ((u >> 16) & 1u)) >> 16; }
__device__ __forceinline__ unsigned pk2(float lo, float hi) { return f2bf(lo) | (f2bf(hi) << 16); }

#define XB_TMO      128
#define XB_XCNT(j)  (256  + 64 * (j))
#define XB_XSUB(j)  (1280 + 64 * (j))
#define XB_XGEN(j)  (2304 + 64 * (j))
#define XB_TOP      3328
#define XB_TOPGEN   3392
#define XCD_BAR_WORDS 3456
#define XB_SPIN_CAP (1u << 18)

__device__ __forceinline__ unsigned xb_ld(unsigned* p)              { return __hip_atomic_load(p, __ATOMIC_RELAXED, __HIP_MEMORY_SCOPE_AGENT); }
__device__ __forceinline__ unsigned xb_add(unsigned* p, unsigned v) { return __hip_atomic_fetch_add(p, v, __ATOMIC_RELAXED, __HIP_MEMORY_SCOPE_AGENT); }
__device__ __forceinline__ unsigned xb_xcc_id() { return (unsigned)__builtin_amdgcn_s_getreg((3 << 11) | 20) & 0xFu; }
#define XB_SPIN(cond, bar) do { unsigned _sp = 0; while (cond) { __builtin_amdgcn_s_sleep(1); \
    if ((++_sp & 255u) == 0u) { if (xb_ld(&(bar)[XB_TMO])) break; if (_sp > XB_SPIN_CAP) { atomicAdd(&(bar)[XB_TMO], 1u); break; } } } } while (0)

struct XcdBarrier {
    unsigned* bar; unsigned x;
    volatile LAS unsigned* st;
};

__device__ __forceinline__ XcdBarrier xcd_barrier_post(unsigned* bar, volatile LAS unsigned* st) {
    XcdBarrier b; b.bar = bar; b.x = xb_xcc_id(); b.st = st;
    if (threadIdx.x == 0) (void)xb_add(&bar[XB_XCNT(b.x)], 1u);
    return b;
}
__device__ __forceinline__ void xcd_barrier_complete(unsigned* bar, unsigned x, unsigned& nloc, unsigned& nx) {
    const unsigned G = gridDim.x * gridDim.y * gridDim.z;
    unsigned sum, cnt, mine, sp = 0u;
    for (;;) {
        sum = 0u; cnt = 0u; mine = 0u;
#pragma unroll 1
        for (unsigned j = 0; j < 16; ++j) { const unsigned c = xb_ld(&bar[XB_XCNT(j)]); sum += c; cnt += (c > 0u) ? 1u : 0u; mine = (j == x) ? c : mine; }
        if (sum == G) break;
        __builtin_amdgcn_s_sleep(1);
        if ((++sp & 255u) == 0u) { if (xb_ld(&bar[XB_TMO])) break; if (sp > XB_SPIN_CAP) { atomicAdd(&bar[XB_TMO], 1u); break; } }
    }
    nloc = mine > 0u ? mine : 1u; nx = cnt > 0u ? cnt : 1u;
}

__device__ __forceinline__ void xcd_barrier(const XcdBarrier& b) {
    asm volatile("s_waitcnt vmcnt(0)" ::: "memory");
    __syncthreads();
    if (threadIdx.x == 0) {
        unsigned* bar = b.bar;
        __builtin_amdgcn_s_waitcnt(0);
        unsigned nloc = b.st[0], nx = b.st[1];
        if (nloc == 0u) { xcd_barrier_complete(bar, b.x, nloc, nx); b.st[0] = nloc; b.st[1] = nx; }
        const unsigned old = xb_add(&bar[XB_XSUB(b.x)], 1u);
        const unsigned gen = old / nloc;
        if (old + 1u == (gen + 1u) * nloc) {
            __builtin_amdgcn_fence(__ATOMIC_RELEASE, "agent");
            asm volatile("s_waitcnt vmcnt(0)" ::: "memory");
            const unsigned og = xb_add(&bar[XB_TOP], 1u);
            const unsigned tg = og / nx, want = (tg + 1u) * nx;
            if (og + 1u != want) XB_SPIN(xb_ld(&bar[XB_TOP]) < want, bar);
            __builtin_amdgcn_fence(__ATOMIC_ACQUIRE, "agent");
            xb_add(&bar[XB_XGEN(b.x)], 1u);
            asm volatile("s_waitcnt vmcnt(0)" ::: "memory");
        } else {
            XB_SPIN(xb_ld(&bar[XB_XGEN(b.x)]) == gen, bar);
            __builtin_amdgcn_fence(__ATOMIC_ACQUIRE, "agent");
            asm volatile("s_waitcnt vmcnt(0)" ::: "memory");
        }
    }
    __syncthreads();
}
constexpr int NWAVES = 8;
constexpr int BATCH = 2, SEQ = 16384, M = BATCH * SEQ, D = 1024, DEPTH = 2;
constexpr int INW = 6440;
constexpr int NIN = 3584;
constexpr int NGM = 3072, FF = 4096, PLE = 256;
constexpr int NCMP = 1023;
constexpr float EPS = 1e-6f;
#define DI __device__ __forceinline__

constexpr size_t MiB = 1u << 20;
constexpr size_t WS_CTL = 0, CTL_ZERO_BYTES = 1 * MiB;
constexpr size_t WS_ROPE = 1 * MiB;
constexpr size_t WS_KCMP = 3 * MiB, WS_VCMP = 3 * MiB + 512 * 1024;
constexpr size_t WS_DECAY = 4 * MiB;
constexpr size_t WS_W = 8 * MiB;
constexpr size_t W_IN = 0, W_GM = 7 * MiB, W_BR = 13 * MiB, W_O = 16 * MiB, W_1 = 18 * MiB, W_2 = 26 * MiB, W_PG = 34 * MiB, W_PP = 36 * MiB, W_LAYER = 36 * MiB + 512 * 1024;
constexpr size_t WS_A16 = 88 * MiB;
constexpr size_t WS_SMALL = 152 * MiB;
constexpr size_t WS_POOLED = 160 * MiB;
constexpr size_t WS_Q = 192 * MiB;
constexpr size_t WS_RG = 224 * MiB;
constexpr size_t WS_U = 256 * MiB, WS_KV = 288 * MiB, WS_QKG = 336 * MiB, WS_VG = 368 * MiB, WS_GLA = 400 * MiB;
constexpr size_t WS_GM = 256 * MiB;
constexpr size_t WS_HID = 160 * MiB;
constexpr size_t WS_VST = 496 * MiB, WS_VWT = 504 * MiB, WS_VCT = 5 * MiB;
constexpr size_t WS_YP = 464 * MiB;
constexpr size_t WS_WCT = 81 * MiB;
constexpr size_t WS_CPOS = 82 * MiB;
constexpr size_t WS_SSQ0 = 6 * MiB, WS_SSQ1 = 83 * MiB, WS_SSQ2 = 85 * MiB;
constexpr size_t WS_MG = 448 * MiB;
constexpr size_t WS_HB2 = WS_MG;
constexpr size_t WS_PP = 160 * MiB;
constexpr size_t WS_P16 = 416 * MiB;
constexpr size_t WS_END = 512 * MiB;
static_assert(WS_W + 2 * W_LAYER <= WS_A16 && WS_GLA + (size_t)2048 * 8192 * 4 <= WS_END && WS_GM + (size_t)M * NGM * 2 <= WS_HB2 && WS_HID + (size_t)M * FF * 2 <= WS_HB2 && WS_PP + (size_t)M * D * 2 <= WS_END && WS_HB2 + (size_t)M * D * 2 <= WS_END, "d_ws map");
constexpr int CW_BAR = 4096;

constexpr int LDS_BYTES = 147456;
constexpr int LDSCTL_OFF = 0, MISC_OFF = LDSCTL_OFF + 320;
constexpr int RING_OFF = 1024, RING_BYTES = LDS_BYTES - RING_OFF;
static_assert(MISC_OFF + 128 <= RING_OFF && RING_BYTES >= 131072, "LDS map");

typedef const void* __attribute__((address_space(4))) kaptr_t;
DI const void* ka_in(int i) { const kaptr_t* ka = (const kaptr_t*)__builtin_amdgcn_kernarg_segment_ptr(); return (const void*)*(volatile const kaptr_t*)(ka + i); }
#define IN_x ((const float*)ka_in(0))
#define IN_p ((const float*)ka_in(1))
#define IN_positions ((const int*)ka_in(2))
#define IN_norm_mix ((const float*)ka_in(3))
#define IN_w_in ((const float*)ka_in(4))
#define IN_pool_w ((const float*)ka_in(5))
#define IN_pool_scale ((const float*)ka_in(6))
#define IN_cmp_pos_k ((const float*)ka_in(7))
#define IN_cmp_w_k ((const float*)ka_in(8))
#define IN_cmp_pos_v ((const float*)ka_in(9))
#define IN_cmp_w_v ((const float*)ka_in(10))
#define IN_gla_w_gate ((const float*)ka_in(11))
#define IN_gla_b_gate ((const float*)ka_in(12))
#define IN_gla_norm ((const float*)ka_in(13))
#define IN_w_branch ((const float*)ka_in(14))
#define IN_w_out ((const float*)ka_in(15))
#define IN_norm_ffn ((const float*)ka_in(16))
#define IN_w_ff1 ((const float*)ka_in(17))
#define IN_w_ff2 ((const float*)ka_in(18))
#define IN_norm_ple ((const float*)ka_in(19))
#define IN_w_ple_gate ((const float*)ka_in(20))
#define IN_w_ple_proj ((const float*)ka_in(21))
#define IN_norm_final ((const float*)ka_in(22))
DI unsigned char* ws_opaque() { return (unsigned char*)ka_in(24); }
#define OUTP ((float*)ka_in(23))
struct Frame {
    LAS unsigned char* lds;
    volatile LAS unsigned* MISC;
    gu32* ctl;
    int tid, lane, wave, G, bid;
};
DI bf16* wptr_(unsigned char* wsq, int l, size_t off) { return (bf16*)(wsq + WS_W + (size_t)l * W_LAYER + off); }
#define wptr(F, l, off) wptr_(wsq, l, off)
DI float bf2f(bf16 b) { return __builtin_bit_cast(float, (unsigned)b << 16); }
DI void unpack8(const v4u w, float (&f)[8]) { f[0] = pg8::bf_lo(w.x); f[1] = pg8::bf_hi(w.x); f[2] = pg8::bf_lo(w.y); f[3] = pg8::bf_hi(w.y); f[4] = pg8::bf_lo(w.z); f[5] = pg8::bf_hi(w.z); f[6] = pg8::bf_lo(w.w); f[7] = pg8::bf_hi(w.w); }
DI float wave_sum(float v) {
#pragma unroll
    for (int o = 1; o < 64; o <<= 1) v += __shfl_xor(v, o);
    return v;
}
DI float wave_max(float v) {
#pragma unroll
    for (int o = 1; o < 64; o <<= 1) v = fmaxf(v, __shfl_xor(v, o));
    return v;
}

struct TrDesc { const float* W; const float* gain; bf16* WT; int ld, K, Ndst, mapoff; };
DI int map_win(int n) {
    if (n < 1792) return n;
    if (n < 2816) return n + 24;
    if (n < 3328) return n + 40;
    if (n < 3352) return n - 3328 + 1792;
    if (n < 3368) return n - 3352 + 2840;
    return -1;
}
DI void tr_load(const TrDesc& d, int it, int lane, float (&wv)[32]) {
    const int nblk = d.Ndst / 32, kb = it / nblk, nb = it % nblk, k0 = 64 * kb, n0 = 32 * nb;
    const int n = n0 + (lane & 31), sc = d.mapoff < 0 ? map_win(n) : n + d.mapoff;
#pragma unroll
    for (int i = 0; i < 32; ++i) { const int kk = 2 * i + (lane >> 5); wv[i] = sc >= 0 ? d.W[(size_t)(k0 + kk) * d.ld + sc] : 0.f; }
}
DI void tr_store(const TrDesc& d, int it, LAS float* scr, int lane, const float (&wv)[32]) {
    const int nblk = d.Ndst / 32, kb = it / nblk, nb = it % nblk, k0 = 64 * kb, n0 = 32 * nb;
#pragma unroll
    for (int i = 0; i < 32; ++i) { const int kk = 2 * i + (lane >> 5); const float gk = d.gain ? d.gain[k0 + kk] : 1.0f; scr[kk * 33 + (lane & 31)] = wv[i] * gk; }
    LDS_WAIT(); asm volatile("" ::: "memory");
    const int c = lane & 7;
#pragma unroll
    for (int j = 0; j < 4; ++j) { const int nn = (lane >> 3) + 8 * j; const LAS float* s = scr + (8 * c) * 33 + nn;
        v4u o; o.x = pk2(s[0 * 33], s[1 * 33]); o.y = pk2(s[2 * 33], s[3 * 33]); o.z = pk2(s[4 * 33], s[5 * 33]); o.w = pk2(s[6 * 33], s[7 * 33]);
        *(v4u*)(d.WT + (size_t)(n0 + nn) * d.K + k0 + 8 * c) = o; }
    LDS_WAIT(); asm volatile("" ::: "memory");
}
DI void p0_prologue(Frame& F) {
    unsigned char* const wsq = ws_opaque();
    { constexpr int I_IN = 16 * 112, I_GM = 16 * 96, I_BR = 8 * 32, I_O = 16 * 32, I_1 = 16 * 128, I_2 = 64 * 32, I_PG = 16 * 32, I_PP = 4 * 32, I_CT = 32 * 2;
      constexpr int PER_LAYER = I_IN + I_GM + 2 * I_BR + I_O + I_1 + I_2 + I_PG + I_PP + 2 * I_CT;
      LAS float* scr = (LAS float*)(F.lds + RING_OFF + F.wave * 16384);
      const int gw = F.bid * NWAVES + F.wave, NGW = F.G * NWAVES, lane = F.lane;
      auto desc = [&](int gi, TrDesc& dout, int& rout) {
          const int l = gi / PER_LAYER; int r = gi % PER_LAYER; TrDesc d;
          if (r < I_IN) d = TrDesc{IN_w_in + (size_t)l * D * INW, IN_norm_mix + (size_t)l * D, wptr(F, l, W_IN), INW, D, NIN, -1};
          else if ((r -= I_IN) < I_GM) d = TrDesc{IN_w_in + (size_t)l * D * INW, IN_norm_mix + (size_t)l * D, wptr(F, l, W_GM), INW, D, NGM, 3368};
          else if ((r -= I_GM) < I_BR) d = TrDesc{IN_w_branch + ((size_t)l * 3 + 1) * 512 * D, nullptr, wptr(F, l, W_BR) + (size_t)1 * D * 512, D, 512, D, 0};
          else if ((r -= I_BR) < I_BR) d = TrDesc{IN_w_branch + ((size_t)l * 3 + 2) * 512 * D, nullptr, wptr(F, l, W_BR) + (size_t)2 * D * 512, D, 512, D, 0};
          else if ((r -= I_BR) < I_O) d = TrDesc{IN_w_out + (size_t)l * D * D, nullptr, wptr(F, l, W_O), D, D, D, 0};
          else if ((r -= I_O) < I_1) d = TrDesc{IN_w_ff1 + (size_t)l * D * FF, IN_norm_ffn + (size_t)l * D, wptr(F, l, W_1), FF, D, FF, 0};
          else if ((r -= I_1) < I_2) d = TrDesc{IN_w_ff2 + (size_t)l * FF * D, nullptr, wptr(F, l, W_2), D, FF, D, 0};
          else if ((r -= I_2) < I_PG) d = TrDesc{IN_w_ple_gate + (size_t)l * D * D, IN_norm_ple + (size_t)l * D, wptr(F, l, W_PG), D, D, D, 0};
          else if ((r -= I_PG) < I_PP) d = TrDesc{IN_w_ple_proj + (size_t)l * PLE * D, nullptr, wptr(F, l, W_PP), D, PLE, D, 0};
          else if ((r -= I_PP) < I_CT) d = TrDesc{IN_cmp_w_k + (size_t)l * 2048 * 64, nullptr, ((bf16*)(wsq + WS_WCT)) + (size_t)(l * 2 + 0) * 64 * 2048, 64, 2048, 64, 0};
          else { r -= I_CT; d = TrDesc{IN_cmp_w_v + (size_t)l * 2048 * 64, nullptr, ((bf16*)(wsq + WS_WCT)) + (size_t)(l * 2 + 1) * 64 * 2048, 64, 2048, 64, 0}; }
          dout = d; rout = r;
      };
      float wvA[32], wvB[32]; TrDesc dA, dB; int rA = 0, rB = 0;
      int gi = gw;
      if (gi < DEPTH * PER_LAYER) { desc(gi, dA, rA); tr_load(dA, rA, lane, wvA); }
      for (; gi < DEPTH * PER_LAYER; gi += 2 * NGW) {
          const bool hasB = gi + NGW < DEPTH * PER_LAYER, hasA2 = gi + 2 * NGW < DEPTH * PER_LAYER;
          if (hasB) { desc(gi + NGW, dB, rB); tr_load(dB, rB, lane, wvB); }
          tr_store(dA, rA, scr, lane, wvA);
          if (hasA2) { desc(gi + 2 * NGW, dA, rA); tr_load(dA, rA, lane, wvA); }
          if (hasB) tr_store(dB, rB, scr, lane, wvB);
      } }
    for (int it = F.bid; it < DEPTH * 4 * 16 * 2; it += F.G) {
        const int l = it >> 7, g = (it >> 5) & 3, nb = (it >> 1) & 15, c0 = ((it & 1) * 8 + F.wave) * 8, n = nb * 64 + F.lane;
        const float* pw = IN_pool_w + (((size_t)l * 4 + g) * 128 + c0) * 128; const float* psc = IN_pool_scale + (size_t)l * 512 + g * 128;
        const float* wb = IN_w_branch + (size_t)l * 3 * 512 * D + (size_t)(g * 128) * D + n;
        LAS float* sp = (LAS float*)(F.lds + RING_OFF + F.wave * 16384);
#pragma unroll
        for (int j = 0; j < 4; ++j) ((LAS pg8::f32x4*)sp)[F.lane + 64 * j] = ((const pg8::f32x4*)pw)[F.lane + 64 * j];
        float a[8];
#pragma unroll
        for (int c = 0; c < 8; ++c) a[c] = 0.f;
#pragma unroll 1
        for (int dh = 0; dh < 128; dh += 32) {
            float wv[32];
#pragma unroll
            for (int d = 0; d < 32; ++d) wv[d] = wb[(size_t)(dh + d) * D];
#pragma unroll
            for (int d = 0; d < 32; ++d) wv[d] *= psc[dh + d];
            LDS_WAIT(); asm volatile("" ::: "memory");
#pragma unroll
            for (int d = 0; d < 32; d += 4)
#pragma unroll
                for (int c = 0; c < 8; ++c) { const pg8::f32x4 pv = *(const LAS pg8::f32x4*)(sp + c * 128 + dh + d); a[c] += (pv[0] * wv[d] + pv[1] * wv[d + 1]) + (pv[2] * wv[d + 2] + pv[3] * wv[d + 3]); }
        }
        v4u o; o.x = pk2(a[0], a[1]); o.y = pk2(a[2], a[3]); o.z = pk2(a[4], a[5]); o.w = pk2(a[6], a[7]);
        *(v4u*)(wptr(F, l, W_BR) + (size_t)n * 512 + g * 128 + c0) = o;
        LDS_WAIT(); asm volatile("" ::: "memory");
    }
    for (int o = F.bid; o < 2 * DEPTH * 64; o += F.G) {
        const int l = o >> 7, which = (o >> 6) & 1, e = o & 63;
        const float* Wc = (which ? IN_cmp_w_v : IN_cmp_w_k) + (size_t)l * 2048 * 64; const float* Pc = (which ? IN_cmp_pos_v : IN_cmp_pos_k) + (size_t)l * 2048;
        float a = 0.f;
#pragma unroll
        for (int j = 0; j < 4; ++j) { const int f = F.tid + 512 * j; a += Pc[f] * Wc[(size_t)f * 64 + e]; }
        a = wave_sum(a);
        LAS float* red = (LAS float*)(F.lds + RING_OFF + 131072);
        if (F.lane == 0) red[F.wave] = a;
        __syncthreads();
        if (F.tid == 0) { float t = 0.f;
#pragma unroll
            for (int p = 0; p < 8; ++p) t += red[p];
            ((float*)(wsq + WS_CPOS))[o] = t; }
        __syncthreads();
    }
    for (int it = F.bid * 512 + F.tid; it < M * 8; it += F.G * 512) {
        const int m = it >> 3, i = it & 7;
        const float pos = (float)IN_positions[m];
        const float inv = (float)exp(-(double)i * 0.125 * 13.122363377404328);
        const float ang = pos * inv; double sn, cs; sincos((double)ang, &sn, &cs);
        ((float*)(wsq + WS_ROPE))[(size_t)m * 16 + i] = (float)cs; ((float*)(wsq + WS_ROPE))[(size_t)m * 16 + 8 + i] = (float)sn;
    }
}

DI void cast_rows_bf16(Frame& F, const float* x, bf16* h16, float* ssq) {
    const int gw = F.bid * NWAVES + F.wave, NGW = F.G * NWAVES;
    for (int m0 = gw; m0 < M; m0 += 2 * NGW) {
        f32x4 v[2][4];
#pragma unroll
        for (int rr = 0; rr < 2; ++rr) { const int m = m0 + rr * NGW < M ? m0 + rr * NGW : m0;
#pragma unroll
            for (int j = 0; j < 4; ++j) v[rr][j] = *((const f32x4*)(x + (size_t)m * D) + F.lane + 64 * j); }
#pragma unroll
        for (int rr = 0; rr < 2; ++rr) { const int m = m0 + rr * NGW; if (m >= M) break;
            unsigned long long* o8 = (unsigned long long*)(h16 + (size_t)m * D) + F.lane; float s = 0.f;
#pragma unroll
            for (int j = 0; j < 4; ++j) { const unsigned lo = pk2(v[rr][j].x, v[rr][j].y), hi = pk2(v[rr][j].z, v[rr][j].w); o8[64 * j] = (unsigned long long)lo | ((unsigned long long)hi << 32);
                const float a = pg8::bf_lo(lo), b = pg8::bf_hi(lo), c = pg8::bf_lo(hi), d = pg8::bf_hi(hi); s += (a * a + b * b) + (c * c + d * d); }
            s = wave_sum(s);
            if (F.lane < 16) ssq[(size_t)m * 16 + F.lane] = (F.lane == 0) ? s : 0.f; }
    }
}
DI void final_norm(Frame& F, const bf16* h16, const float* ssq, const float* gain, float* out) {
    const int gw = F.bid * NWAVES + F.wave, NGW = F.G * NWAVES;
    f32x4 gv[4];
#pragma unroll
    for (int j = 0; j < 4; ++j) gv[j] = *((const f32x4*)gain + F.lane + 64 * j);
    for (int m0 = gw; m0 < M; m0 += 2 * NGW) {
        unsigned long long hw[2][4]; float rs[2];
#pragma unroll
        for (int rr = 0; rr < 2; ++rr) { const int m = m0 + rr * NGW < M ? m0 + rr * NGW : m0; rs[rr] = pg8::row_rstd(ssq, (size_t)m);
#pragma unroll
            for (int j = 0; j < 4; ++j) hw[rr][j] = *((const unsigned long long*)(h16 + (size_t)m * D) + F.lane + 64 * j); }
#pragma unroll
        for (int rr = 0; rr < 2; ++rr) { const int m = m0 + rr * NGW; if (m >= M) break;
            f32x4* o = (f32x4*)(out + (size_t)m * D) + F.lane;
#pragma unroll
            for (int j = 0; j < 4; ++j) { const unsigned lo = (unsigned)hw[rr][j], hi = (unsigned)(hw[rr][j] >> 32);
                f32x4 v; v.x = pg8::bf_lo(lo); v.y = pg8::bf_hi(lo); v.z = pg8::bf_lo(hi); v.w = pg8::bf_hi(hi); o[64 * j] = v * rs[rr] * gv[j]; } }
    }
}
DI void cvt_p16(Frame& F, int l) {
    unsigned char* const wsq = ws_opaque();
    const f32x4* src = (const f32x4*)(IN_p + (size_t)l * M * PLE); unsigned long long* dst = (unsigned long long*)((bf16*)(wsq + WS_P16));
    constexpr int n = M * PLE / 4; const int st = F.G * 512;
    for (int i = F.bid * 512 + F.tid; i < n; i += 4 * st) {
        f32x4 v[4];
#pragma unroll
        for (int k = 0; k < 4; ++k) { const int ii = i + k * st; v[k] = ii < n ? src[ii] : (f32x4){0.f, 0.f, 0.f, 0.f}; }
#pragma unroll
        for (int k = 0; k < 4; ++k) { const int ii = i + k * st; if (ii < n) dst[ii] = (unsigned long long)pk2(v[k].x, v[k].y) | ((unsigned long long)pk2(v[k].z, v[k].w) << 32); }
    }
}

template <int W, int T> DI void pool_item(const bf16* U, bf16* P, int m0, int col8) {
    const int tl0 = m0 & (SEQ - 1);
    v4u pre[W - 1], cur[T];
#pragma unroll
    for (int k = 1; k < W; ++k) pre[k - 1] = (tl0 - k >= 0) ? *(const v4u*)(U + (size_t)(m0 - k) * 512 + col8) : (v4u){0u, 0u, 0u, 0u};
#pragma unroll
    for (int t = 0; t < T; ++t) cur[t] = *(const v4u*)(U + (size_t)(m0 + t) * 512 + col8);
    float s[8];
#pragma unroll
    for (int e = 0; e < 8; ++e) s[e] = 0.f;
#pragma unroll
    for (int k = 1; k < W; ++k) { float f[8]; unpack8(pre[k - 1], f);
#pragma unroll
        for (int e = 0; e < 8; ++e) s[e] += f[e]; }
#pragma unroll
    for (int t = 0; t < T; ++t) {
        const int tl = tl0 + t; float c[8]; unpack8(cur[t], c);
#pragma unroll
        for (int e = 0; e < 8; ++e) s[e] += c[e];
        const float ic = 1.0f / (float)((tl + 1 < W) ? tl + 1 : W);
        v4u o; o.x = pk2(s[0] * ic - c[0], s[1] * ic - c[1]); o.y = pk2(s[2] * ic - c[2], s[3] * ic - c[3]); o.z = pk2(s[4] * ic - c[4], s[5] * ic - c[5]); o.w = pk2(s[6] * ic - c[6], s[7] * ic - c[7]);
        *(v4u*)(P + (size_t)(m0 + t) * 512 + col8) = o;
        float d[8]; unpack8((t - W + 1 >= 0) ? cur[(t - W + 1 >= 0) ? t - W + 1 : 0] : pre[(t - W + 1 >= 0) ? 0 : W - 2 - t], d);
#pragma unroll
        for (int e = 0; e < 8; ++e) s[e] -= d[e];
    }
}
DI void pool_phase(Frame& F) {
    unsigned char* const wsq = ws_opaque();
    const bf16* U = (const bf16*)(wsq + WS_U); bf16* P = (bf16*)(wsq + WS_POOLED);
    const int g = F.wave & 3, cvl = F.lane & 15, tq = F.lane >> 4;
    for (int cg = F.bid * 2 + (F.wave >> 2); cg < M / 64; cg += F.G * 2) {
        const int m0 = (cg * 4 + tq) * 16, col8 = (g * 16 + cvl) * 8;
#pragma unroll 1
        for (int hf = 0; hf < 2; ++hf) {
            if (g == 0) pool_item<2, 8>(U, P, m0 + 8 * hf, col8); else if (g == 1) pool_item<4, 8>(U, P, m0 + 8 * hf, col8); else if (g == 2) pool_item<8, 8>(U, P, m0 + 8 * hf, col8); else pool_item<16, 8>(U, P, m0 + 8 * hf, col8); }
    }
}

typedef float f32x16 __attribute__((ext_vector_type(16)));
typedef float f32x2_t __attribute__((ext_vector_type(2)));
typedef __bf16 bf16x2_t __attribute__((ext_vector_type(2)));
typedef unsigned u32x2_t __attribute__((ext_vector_type(2)));
#define MFMA32(a, b, c) __builtin_amdgcn_mfma_f32_32x32x16_bf16((a), (b), (c), 0, 0, 0)
DI unsigned cvtpk(float lo, float hi) { const f32x2_t v = {lo, hi}; const bf16x2_t b = __builtin_convertvector(v, bf16x2_t); return __builtin_bit_cast(unsigned, b); }
DI int crow(int i, int h) { return (i & 3) + 8 * (i >> 2) + 4 * h; }
DI float ex2(float x) { return __builtin_amdgcn_exp2f(x); }
#define MAX_TAIL "\n\tv_max3_f32 %0, %0, %4, %5\n\tv_max3_f32 %0, %0, %6, %7\n\tv_max3_f32 %0, %0, %8, %9\n\tv_max3_f32 %0, %0, %10, %11\n\tv_max3_f32 %0, %0, %12, %13\n\tv_max3_f32 %0, %0, %14, %15"
DI float max16_x4(const f32x4 (&S)[4]) {
    float m;
    asm("s_nop 7\n\tv_max3_f32 %0, %1, %2, %3" MAX_TAIL "\n\tv_max_f32 %0, %0, %16" : "=&v"(m)
        : "v"(S[0][0]), "v"(S[0][1]), "v"(S[0][2]), "v"(S[0][3]), "v"(S[1][0]), "v"(S[1][1]), "v"(S[1][2]), "v"(S[1][3]), "v"(S[2][0]), "v"(S[2][1]), "v"(S[2][2]), "v"(S[2][3]), "v"(S[3][0]), "v"(S[3][1]), "v"(S[3][2]), "v"(S[3][3]));
    return m;
}
DI float max16_x16(const f32x16& S) {
    float m;
    asm("s_nop 11\n\tv_max3_f32 %0, %1, %2, %3" MAX_TAIL "\n\tv_max_f32 %0, %0, %16" : "=&v"(m)
        : "v"(S[0]), "v"(S[1]), "v"(S[2]), "v"(S[3]), "v"(S[4]), "v"(S[5]), "v"(S[6]), "v"(S[7]), "v"(S[8]), "v"(S[9]), "v"(S[10]), "v"(S[11]), "v"(S[12]), "v"(S[13]), "v"(S[14]), "v"(S[15]));
    return m;
}
DI float max17_x16(float seed, const f32x16& S) {
    float m;
    asm("s_nop 11\n\tv_max3_f32 %0, %17, %1, %2\n\tv_max3_f32 %0, %0, %3, %4" "\n\tv_max3_f32 %0, %0, %5, %6\n\tv_max3_f32 %0, %0, %7, %8\n\tv_max3_f32 %0, %0, %9, %10\n\tv_max3_f32 %0, %0, %11, %12\n\tv_max3_f32 %0, %0, %13, %14\n\tv_max3_f32 %0, %0, %15, %16" : "=&v"(m)
        : "v"(S[0]), "v"(S[1]), "v"(S[2]), "v"(S[3]), "v"(S[4]), "v"(S[5]), "v"(S[6]), "v"(S[7]), "v"(S[8]), "v"(S[9]), "v"(S[10]), "v"(S[11]), "v"(S[12]), "v"(S[13]), "v"(S[14]), "v"(S[15]), "v"(seed));
    return m;
}
constexpr int NSA_KB = 8192, NSA_BLK = 16384, NSA_STAGE = 2 * NSA_BLK;
constexpr int NSA_OFF_IMP = 2 * NSA_STAGE, NSA_OFF_SELB = 4 * NSA_STAGE, NSA_LDS_END = NSA_OFF_SELB + 2 * 2048;
static_assert(NSA_LDS_END <= RING_BYTES && NSA_OFF_IMP + 65536 <= NSA_OFF_SELB, "NSA LDS map");
DI int swz(int row, int g) { return row * 128 + ((g ^ ((row >> 1) & 7)) << 4); }
enum { MODE_CMP1 = 0, MODE_CMP2 = 1, MODE_SEL = 2, MODE_WIN = 3 };
#define LDS_BARRIER() asm volatile("s_waitcnt lgkmcnt(0)\n\ts_barrier" ::: "memory")

struct NsaCol {
    int tcol, cnt;
    float m, l;
};
DI void qk_tile(const LAS unsigned char* kb, const bf16x8 (&qf)[4], int lane, float cinit, f32x16& S0, f32x16& S1) {
    const int r = lane & 31, h = lane >> 5;
#pragma unroll
    for (int i = 0; i < 16; ++i) { S0[i] = cinit; S1[i] = cinit; }
#pragma unroll
    for (int ks = 0; ks < 4; ++ks) {
        const bf16x8 a0 = *(const LAS bf16x8*)(kb + swz(r, 2 * ks + h));
        const bf16x8 a1 = *(const LAS bf16x8*)(kb + swz(32 + r, 2 * ks + h));
        S0 = MFMA32(a0, qf[ks], S0); S1 = MFMA32(a1, qf[ks], S1);
    }
}
template <int S> DI bf16x8 pack8(const f32x16& x) {
    v4u p; p.x = cvtpk(x[8 * S + 0], x[8 * S + 1]); p.y = cvtpk(x[8 * S + 2], x[8 * S + 3]); p.z = cvtpk(x[8 * S + 4], x[8 * S + 5]); p.w = cvtpk(x[8 * S + 6], x[8 * S + 7]);
    return __builtin_bit_cast(bf16x8, p);
}
template <int KS> DI void pv_step(const LAS unsigned char* vb, const bf16x8 pf, int r, int h, f32x16& O0, f32x16& O1) {
#pragma unroll
    for (int dh = 0; dh < 2; ++dh) {
        const u32x2_t lo = *(const LAS u32x2_t*)(vb + swz(32 * dh + r, 2 * KS) + 8 * h), hi = *(const LAS u32x2_t*)(vb + swz(32 * dh + r, 2 * KS + 1) + 8 * h);
        const v4u av = {lo.x, lo.y, hi.x, hi.y};
        const bf16x8 a = __builtin_bit_cast(bf16x8, av);
        if (dh == 0) O0 = MFMA32(a, pf, O0); else O1 = MFMA32(a, pf, O1);
    }
}
DI void pv_tile(const LAS unsigned char* vb, const f32x16& P0, const f32x16& P1, int lane, f32x16& O0, f32x16& O1) {
    const int r = lane & 31, h = lane >> 5;
    pv_step<0>(vb, pack8<0>(P0), r, h, O0, O1); pv_step<1>(vb, pack8<1>(P0), r, h, O0, O1);
    pv_step<2>(vb, pack8<0>(P1), r, h, O0, O1); pv_step<3>(vb, pack8<1>(P1), r, h, O0, O1);
}

template <int MODE>
DI void nsa_block(const LAS unsigned char* kb, int lane, int i, int c, int rowbase, bool mybit, const bf16x8 (&qf)[4], NsaCol& col, float inv_l, float& carry, f32x16& O0, f32x16& O1, LAS float* impw) {
    const int h = lane >> 5, hh = lane & 3;
    const LAS unsigned char* vb = kb + NSA_KB;
    const float ms0 = (MODE == MODE_SEL && !mybit) ? INFINITY : ((col.m == -INFINITY) ? 0.f : col.m);
    f32x16 S0, S1; qk_tile(kb, qf, lane, -ms0, S0, S1);
    const int kbase = (MODE == MODE_WIN) ? (rowbase + 64 * i) : 64 * i;
    bool masked;
    if (MODE == MODE_CMP1 || MODE == MODE_CMP2) masked = (kbase + 63 >= 4 * c - 1);
    else if (MODE == MODE_SEL) masked = (i == c);
    else masked = !((kbase + 63 <= 64 * c) && (kbase > 64 * c + 63 - 512));
    if (masked) {
#pragma unroll
        for (int r = 0; r < 16; ++r) {
            const int k0 = kbase + crow(r, h), k1 = k0 + 32;
            bool v0, v1;
            if (MODE == MODE_CMP1 || MODE == MODE_CMP2) { v0 = k0 < col.cnt; v1 = k1 < col.cnt; }
            else if (MODE == MODE_SEL) { v0 = k0 <= col.tcol; v1 = k1 <= col.tcol; }
            else { v0 = (k0 <= col.tcol) && (k0 > col.tcol - 512); v1 = (k1 <= col.tcol) && (k1 > col.tcol - 512); }
            S0[r] = v0 ? S0[r] : -INFINITY; S1[r] = v1 ? S1[r] : -INFINITY;
        }
    }
    if (MODE == MODE_CMP2) {
#pragma unroll
        for (int r = 0; r < 16; ++r) { S0[r] = ex2(S0[r]) * inv_l; S1[r] = ex2(S1[r]) * inv_l; }
#pragma unroll
        for (int u = 0; u < 8; ++u) {
            float G, L;
            if (u < 4) { G = (S0[4 * u] + S0[4 * u + 1]) + (S0[4 * u + 2] + S0[4 * u + 3]); L = S0[4 * u + 3]; }
            else { G = (S1[4 * (u - 4)] + S1[4 * (u - 4) + 1]) + (S1[4 * (u - 4) + 2] + S1[4 * (u - 4) + 3]); L = S1[4 * (u - 4) + 3]; }
            G += __shfl_xor(G, 1); G += __shfl_xor(G, 2); L += __shfl_xor(L, 1); L += __shfl_xor(L, 2);
            const float Lx = __shfl_xor(L, 32);
            const float prev = (h == 1) ? Lx : carry;
            if (hh == 0) impw[((lane & 31) >> 2) * 256 + 16 * i + 2 * u + h] = G + prev;
            carry = Lx;
        }
        pv_tile(vb, S0, S1, lane, O0, O1);
    } else {
        float mx = max17_x16(max16_x16(S0), S1);
        f32x16 P0, P1;
#pragma unroll
        for (int r = 0; r < 16; ++r) { P0[r] = ex2(S0[r]); P1[r] = ex2(S1[r]); }
        const bool fresh = (col.m == -INFINITY);
        const float thr = fresh ? -INFINITY : 8.0f;
        if (__any(mx > thr)) {
            mx = fmaxf(mx, __shfl_xor(mx, 32));
            const bool need = mx > thr;
            const float dm = need ? mx : 0.f;
            const float alpha = need ? (fresh ? 0.f : ex2(-mx)) : 1.0f;
            col.l *= alpha; if (need) col.m = ms0 + mx;
#pragma unroll
            for (int r = 0; r < 16; ++r) { P0[r] = ex2(S0[r] - dm); P1[r] = ex2(S1[r] - dm); }
            if (MODE != MODE_CMP1) {
#pragma unroll
                for (int r = 0; r < 16; ++r) { O0[r] *= alpha; O1[r] *= alpha; }
            }
        }
        float ls = 0.f;
#pragma unroll
        for (int r = 0; r < 16; ++r) { S0[r] = P0[r]; S1[r] = P1[r]; ls += P0[r] + P1[r]; }
        col.l += ls;
        if (MODE != MODE_CMP1) pv_tile(vb, S0, S1, lane, O0, O1);
    }
}

struct NsaSrc { const bf16* Kth; const bf16* Vth; size_t kstep, vstep; int nt; };
DI void nsa_src_init(NsaSrc& S, const bf16* Krow0, size_t kpitch, const bf16* Vblk0, int nt, int tid) {
    const int row = tid >> 3, k = (tid & 7) ^ ((row >> 1) & 7);
    S.Kth = Krow0 + (size_t)row * kpitch + k * 8; S.kstep = 64 * kpitch; S.Vth = Vblk0 + row * 64 + k * 8; S.vstep = 4096; S.nt = nt;
}
template <bool NEEDV> DI void nsa_dma(const NsaSrc& S, int i, LAS unsigned char* blk, int w) {
    const int ic = i < S.nt ? i : S.nt - 1;
    __builtin_amdgcn_global_load_lds((const unsigned*)(S.Kth + (size_t)ic * S.kstep), (LAS unsigned*)(blk + w * 1024), 16, 0, 0);
    if (NEEDV) __builtin_amdgcn_global_load_lds((const unsigned*)(S.Vth + (size_t)ic * S.vstep), (LAS unsigned*)(blk + NSA_KB + w * 1024), 16, 0, 0);
}
template <int MODE, bool CHAIN_OUT = false, bool CHAIN_IN = false>
DI void nsa_tiles(Frame& F, unsigned char* wsq, int b, int g, int c, int nt, int i0, const bf16x8 (&qf)[4], NsaCol& col, float inv_l, f32x16& O0, f32x16& O1, LAS float* impw) {
    const int tid = F.tid, lane = F.lane, w = F.wave;
    constexpr bool NEEDV = (MODE != MODE_CMP1);
    NsaSrc S; int rowbase = 0;
    if (MODE == MODE_CMP1 || MODE == MODE_CMP2)
        nsa_src_init(S, ((const bf16*)(wsq + WS_KCMP)) + ((size_t)b * 1024 * 2 + g) * 64, 128, ((const bf16*)(wsq + WS_VCT)) + (size_t)((b * 2 + g) * 16) * 4096, nt, tid);
    else { rowbase = 64 * (c - 8 + i0);
        nsa_src_init(S, ((const bf16*)(wsq + WS_KV)) + ((size_t)(4 * 2 + g) * M + (size_t)b * SEQ + rowbase) * 64, 64, ((const bf16*)(wsq + WS_VWT)) + (size_t)((b * 2 + g) * 256 + (c - 8 + i0)) * 4096, nt, tid); }
    LAS unsigned char* ring = F.lds + RING_OFF;
    const int nst = (nt + 1) >> 1;
    const int par = CHAIN_IN ? (nst & 1) : 0;
    if (!CHAIN_IN) { nsa_dma<NEEDV>(S, 0, ring, w); nsa_dma<NEEDV>(S, 1, ring + NSA_BLK, w);
        asm volatile("s_waitcnt vmcnt(0)\n\ts_barrier" ::: "memory"); }
    float carry = 0.f;
    for (int s = 0; s < nst; ++s) {
        const int pb = (s + par) & 1;
        if (s + 1 < nst) { nsa_dma<NEEDV>(S, 2 * s + 2, ring + (pb ^ 1) * NSA_STAGE, w); nsa_dma<NEEDV>(S, 2 * s + 3, ring + (pb ^ 1) * NSA_STAGE + NSA_BLK, w); }
        else if (CHAIN_OUT) { nsa_dma<true>(S, 0, ring + (pb ^ 1) * NSA_STAGE, w); nsa_dma<true>(S, 1, ring + (pb ^ 1) * NSA_STAGE + NSA_BLK, w); }
#pragma unroll
        for (int bb = 0; bb < 2; ++bb) {
            const int i = 2 * s + bb;
            if (i < nt) nsa_block<MODE>(ring + pb * NSA_STAGE + bb * NSA_BLK, lane, i, c, rowbase, true, qf, col, inv_l, carry, O0, O1, impw);
        }
        asm volatile("s_waitcnt vmcnt(0) lgkmcnt(0)\n\ts_barrier" ::: "memory");
    }
}

#define MFMA16(a, b, c) __builtin_amdgcn_mfma_f32_16x16x32_bf16((a), (b), (c), 0, 0, 0)
struct Sel16 { float m, l; int tcol; f32x4 O0, O1, O2, O3; bf16x8 q0, q1; };
DI void sel16_qk(Sel16& G, bool bit, const bf16x8 (&kf)[4][2], int q4, int i, int c, f32x4 (&S)[4]) {
    const float ms0 = !bit ? INFINITY : ((G.m == -INFINITY) ? 0.f : G.m);
    const bf16x8 q0 = G.q0, q1 = G.q1;
#pragma unroll
    for (int t = 0; t < 4; ++t) { S[t] = (f32x4){-ms0, -ms0, -ms0, -ms0}; S[t] = MFMA16(kf[t][0], q0, S[t]); S[t] = MFMA16(kf[t][1], q1, S[t]); }
    if (i == c) {
#pragma unroll
        for (int t = 0; t < 4; ++t)
#pragma unroll
            for (int e = 0; e < 4; ++e) S[t][e] = (64 * c + 16 * t + 4 * q4 + e <= G.tcol) ? S[t][e] : -INFINITY;
    }
    float mx = max16_x4(S);
    f32x4 P[4];
#pragma unroll
    for (int t = 0; t < 4; ++t) { P[t][0] = ex2(S[t][0]); P[t][1] = ex2(S[t][1]); P[t][2] = ex2(S[t][2]); P[t][3] = ex2(S[t][3]); }
    const bool fresh = (G.m == -INFINITY);
    const float thr = fresh ? -INFINITY : 8.0f;
    if (__any(mx > thr)) {
        mx = fmaxf(mx, __shfl_xor(mx, 16)); mx = fmaxf(mx, __shfl_xor(mx, 32));
        const bool need = mx > thr;
        const float dm = need ? mx : 0.f, alpha = need ? (fresh ? 0.f : ex2(-mx)) : 1.0f;
        G.l *= alpha; if (need) G.m = ms0 + mx;
#pragma unroll
        for (int t = 0; t < 4; ++t) { P[t][0] = ex2(S[t][0] - dm); P[t][1] = ex2(S[t][1] - dm); P[t][2] = ex2(S[t][2] - dm); P[t][3] = ex2(S[t][3] - dm); }
        G.O0 *= alpha; G.O1 *= alpha; G.O2 *= alpha; G.O3 *= alpha;
    }
    float ls = 0.f;
#pragma unroll
    for (int t = 0; t < 4; ++t) { S[t] = P[t]; ls += (P[t][0] + P[t][1]) + (P[t][2] + P[t][3]); }
    G.l += ls;
}
DI void sel16_pv(Sel16& G, const bf16x8 (&vf)[4][2], const f32x4 (&S)[4]) {
#pragma unroll
    for (int ks2 = 0; ks2 < 2; ++ks2) {
        v4u pw; pw.x = cvtpk(S[2 * ks2][0], S[2 * ks2][1]); pw.y = cvtpk(S[2 * ks2][2], S[2 * ks2][3]); pw.z = cvtpk(S[2 * ks2 + 1][0], S[2 * ks2 + 1][1]); pw.w = cvtpk(S[2 * ks2 + 1][2], S[2 * ks2 + 1][3]);
        const bf16x8 pf = __builtin_bit_cast(bf16x8, pw);
        G.O0 = MFMA16(vf[0][ks2], pf, G.O0); G.O1 = MFMA16(vf[1][ks2], pf, G.O1); G.O2 = MFMA16(vf[2][ks2], pf, G.O2); G.O3 = MFMA16(vf[3][ks2], pf, G.O3);
    }
}
struct SelBits { bool bit, act; };
DI SelBits sel_bits(Sel16& G, const LAS unsigned* selw, int i) { const unsigned wd = selw[i >> 5]; SelBits r; r.bit = (wd >> (i & 31)) & 1u;
    r.act = __ballot(r.bit) != 0ull; return r; }
DI void sel16_block(const LAS unsigned char* kb, int c16, int q4, int i, int c0, Sel16& GA, const SelBits sA, Sel16& GB, const SelBits sB, Sel16& GC, const SelBits sC, Sel16& GD, const SelBits sD) {
    if (!(sA.act || sB.act || sC.act || sD.act)) return;
    const LAS unsigned char* vb = kb + NSA_KB;
    f32x4 SA[4], SB[4], SC[4], SD[4];
    { bf16x8 kf[4][2];
#pragma unroll
      for (int t = 0; t < 4; ++t)
#pragma unroll
          for (int ks = 0; ks < 2; ++ks) kf[t][ks] = *(const LAS bf16x8*)(kb + swz(16 * t + c16, 4 * ks + q4));
      if (sA.act) sel16_qk(GA, sA.bit, kf, q4, i, c0, SA);
      if (sB.act) sel16_qk(GB, sB.bit, kf, q4, i, c0, SB);
      if (sC.act) sel16_qk(GC, sC.bit, kf, q4, i, c0 + 1, SC);
      if (sD.act) sel16_qk(GD, sD.bit, kf, q4, i, c0 + 1, SD); }
    asm volatile("" ::: "memory");
    { bf16x8 vf[4][2];
#pragma unroll
      for (int dt = 0; dt < 4; ++dt)
#pragma unroll
          for (int ks2 = 0; ks2 < 2; ++ks2) { const int row = 16 * dt + c16;
              const u32x2_t lo = *(const LAS u32x2_t*)(vb + swz(row, 4 * ks2 + (q4 >> 1)) + 8 * (q4 & 1)), hi = *(const LAS u32x2_t*)(vb + swz(row, 4 * ks2 + 2 + (q4 >> 1)) + 8 * (q4 & 1));
              const v4u av = {lo.x, lo.y, hi.x, hi.y}; vf[dt][ks2] = __builtin_bit_cast(bf16x8, av); }
      if (sA.act) sel16_pv(GA, vf, SA);
      if (sB.act) sel16_pv(GB, vf, SB);
      if (sC.act) sel16_pv(GC, vf, SC);
      if (sD.act) sel16_pv(GD, vf, SD); }
    asm volatile("" ::: "memory");
}
constexpr int SEL_STAGE = 4 * NSA_BLK;
DI void nsa_stage_sel16(Frame& F, const NsaSrc& S, int s, int nst, int c0, Sel16& GA, Sel16& GB, Sel16& GC, Sel16& GD, const LAS unsigned* sel0, const LAS unsigned* sel1) {
    LAS unsigned char* ring = F.lds + RING_OFF;
    const int lane = F.lane, c16 = lane & 15, q4 = lane >> 4, w = F.wave;
    if (s + 1 < nst) { LAS unsigned char* nb = ring + ((s + 1) & 1) * SEL_STAGE;
#pragma unroll
        for (int bb = 0; bb < 4; ++bb) nsa_dma<true>(S, 4 * s + 4 + bb, nb + bb * NSA_BLK, w); }
#pragma unroll 1
    for (int bb = 0; bb < 4; ++bb) {
        const int i = 4 * s + bb;
        if (i < S.nt) {
            const LAS unsigned char* kb = ring + (s & 1) * SEL_STAGE + bb * NSA_BLK;
            const SelBits sA = sel_bits(GA, sel0 + (c16 >> 2) * 8, i), sB = sel_bits(GB, sel0 + (4 + (c16 >> 2)) * 8, i);
            const SelBits sC = sel_bits(GC, sel1 + (c16 >> 2) * 8, i), sD = sel_bits(GD, sel1 + (4 + (c16 >> 2)) * 8, i);
            sel16_block(kb, c16, q4, i, c0, GA, sA, GB, sB, GC, sC, GD, sD);
        }
    }
    asm volatile("s_waitcnt vmcnt(0) lgkmcnt(0)\n\ts_barrier" ::: "memory");
}
DI void sel16_init(Sel16& G, unsigned char* wsq, int b, int g, int tcol, int hh, int q4) {
    G.tcol = tcol; const size_t mr = (size_t)b * SEQ + tcol;
    const bf16* Qr = ((const bf16*)(wsq + WS_Q)) + mr * 512 + (g * 4 + hh) * 64 + 8 * q4;
    G.q0 = *(const bf16x8*)Qr; G.q1 = *(const bf16x8*)(Qr + 32);
    G.m = -INFINITY; G.l = 0.f; const f32x4 z = {0.f, 0.f, 0.f, 0.f}; G.O0 = z; G.O1 = z; G.O2 = z; G.O3 = z;
}
DI void sel16_finish(Sel16& G, unsigned char* wsq, int b, int g, int hh, int q4, size_t out_off) {
    float l = G.l; l += __shfl_xor(l, 16); l += __shfl_xor(l, 32);
    const float g1 = pg8::sigm(((const float*)(wsq + WS_SMALL))[((size_t)b * SEQ + G.tcol) * 64 + (g * 4 + hh) * 3 + 1]);
    const float il = l > 0.f ? g1 / l : 0.f;
    const size_t base = ((size_t)b * SEQ + G.tcol) * 512 + (g * 4 + hh) * 64 + 4 * q4;
    const bf16* yp = ((const bf16*)(wsq + WS_YP)) + base; bf16* op = ((bf16*)(wsq + out_off)) + base;
    u32x2_t y[4];
#pragma unroll
    for (int dt = 0; dt < 4; ++dt) y[dt] = *(const u32x2_t*)(yp + 16 * dt);
    const f32x4 o[4] = {G.O0, G.O1, G.O2, G.O3};
#pragma unroll
    for (int dt = 0; dt < 4; ++dt) { u32x2_t w; w.x = cvtpk(pg8::bf_lo(y[dt].x) + il * o[dt][0], pg8::bf_hi(y[dt].x) + il * o[dt][1]); w.y = cvtpk(pg8::bf_lo(y[dt].y) + il * o[dt][2], pg8::bf_hi(y[dt].y) + il * o[dt][3]);
        *(u32x2_t*)(op + 16 * dt) = w; }
}
DI void nsa_selpair(Frame& F, unsigned char* wsq, int b, int g, int c0, size_t out_off) {
    const int tid = F.tid, lane = F.lane, w = F.wave, c16 = lane & 15, q4 = lane >> 4, hh = c16 & 3;
    NsaSrc S;
    nsa_src_init(S, ((const bf16*)(wsq + WS_KV)) + ((size_t)(2 * 2 + g) * M + (size_t)b * SEQ) * 64, 64, ((const bf16*)(wsq + WS_VST)) + (size_t)((b * 2 + g) * 256) * 4096, c0 + 2, tid);
    Sel16 GA, GB, GC, GD;
    sel16_init(GA, wsq, b, g, 64 * c0 + 8 * w + (c16 >> 2), hh, q4); sel16_init(GB, wsq, b, g, 64 * c0 + 8 * w + 4 + (c16 >> 2), hh, q4);
    sel16_init(GC, wsq, b, g, 64 * (c0 + 1) + 8 * w + (c16 >> 2), hh, q4); sel16_init(GD, wsq, b, g, 64 * (c0 + 1) + 8 * w + 4 + (c16 >> 2), hh, q4);
    asm volatile("s_waitcnt vmcnt(0)" ::: "memory");
    const LAS unsigned* sel0 = (const LAS unsigned*)(F.lds + RING_OFF + NSA_OFF_SELB) + w * 64; const LAS unsigned* sel1 = sel0 + 512;
    const int nst = (S.nt + 3) >> 2;
    { LAS unsigned char* ring = F.lds + RING_OFF;
#pragma unroll
      for (int bb = 0; bb < 4; ++bb) nsa_dma<true>(S, bb, ring + bb * NSA_BLK, w); }
    asm volatile("s_waitcnt vmcnt(0)\n\ts_barrier" ::: "memory");
    for (int s = 0; s < nst; ++s) nsa_stage_sel16(F, S, s, nst, c0, GA, GB, GC, GD, sel0, sel1);
    unsigned char* const w2 = ws_opaque();
    sel16_finish(GA, w2, b, g, hh, q4, out_off); sel16_finish(GB, w2, b, g, hh, q4, out_off);
    sel16_finish(GC, w2, b, g, hh, q4, out_off); sel16_finish(GD, w2, b, g, hh, q4, out_off);
}

DI void nsa_pre(Frame& F, unsigned char* wsq, int b, int g, int c, int slot) {
    const int lane = F.lane, w = F.wave, h = lane >> 5, colx = lane & 31, qi = colx >> 2, hh = colx & 3;
    NsaCol col; col.tcol = 64 * c + 8 * w + qi; col.cnt = col.tcol >= 31 ? ((col.tcol - 31) >> 4) + 1 : 0;
#define NSA_GATE(k) pg8::sigm(((const float*)(ws_opaque() + WS_SMALL))[((size_t)b * SEQ + col.tcol) * 64 + (g * 4 + hh) * 3 + (k)])
    LAS float* impw = (LAS float*)(F.lds + RING_OFF + NSA_OFF_IMP) + w * 2048;
    LAS unsigned* selb = (LAS unsigned*)(F.lds + RING_OFF + NSA_OFF_SELB) + slot * 512 + w * 64;
    LAS float* rpark = (LAS float*)(F.lds + RING_OFF) + w * 2048;
    { f32x16 O0, O1;
#pragma unroll
      for (int r = 0; r < 16; ++r) { O0[r] = 0.f; O1[r] = 0.f; }
      const int ntc = (4 * c + 3 + 63) >> 6;
      const bf16* Qp = ((const bf16*)(ws_opaque() + WS_Q)) + ((size_t)b * SEQ + col.tcol) * 512 + (g * 4 + hh) * 64;
      bf16x8 qf[4];
#pragma unroll
      for (int ks = 0; ks < 4; ++ks) qf[ks] = *(const bf16x8*)(Qp + 16 * ks + 8 * h);
      col.m = -INFINITY; col.l = 0.f;
      nsa_tiles<MODE_CMP1, true, false>(F, ws_opaque(), b, g, c, ntc, 0, qf, col, 0.f, O0, O1, impw);
      col.l += __shfl_xor(col.l, 32);
      const float inv_l = col.l > 0.f ? 1.0f / col.l : 0.f;
      nsa_tiles<MODE_CMP2, false, true>(F, ws_opaque(), b, g, c, ntc, 0, qf, col, inv_l, O0, O1, impw);
      const float g0 = NSA_GATE(0);
#pragma unroll
      for (int r = 0; r < 16; ++r) { rpark[r * 64 + lane] = g0 * O0[r]; rpark[(16 + r) * 64 + lane] = g0 * O1[r]; } }
    asm volatile("s_waitcnt lgkmcnt(0)" ::: "memory");
    { const int nforced = c >= 2 ? 3 : c + 1, K = 16 - nforced, ncand = c + 1 - nforced;
      constexpr int TKQ = 4;
      for (int q0 = 0; q0 < 8; q0 += TKQ) {
      unsigned kx[TKQ][4]; unsigned T[TKQ];
#pragma unroll
      for (int q = 0; q < TKQ; ++q) {
#pragma unroll
          for (int jj = 0; jj < 4; ++jj) { const int j = lane + 64 * jj; const bool cd = (j <= c) && !((j == 0) || (j == c) || (j == c - 1));
              kx[q][jj] = cd ? (__float_as_uint(impw[(q0 + q) * 256 + j]) + 1u) : 0u; }
          T[q] = 1u; }
      if (ncand > K) {
#pragma unroll
          for (int q = 0; q < TKQ; ++q) T[q] = 0u;
          int cntT[TKQ];
#pragma unroll
          for (int q = 0; q < TKQ; ++q) cntT[q] = 256;
          for (int bit = 30; bit >= 0; --bit) {
              bool alldone = true;
#pragma unroll
              for (int q = 0; q < TKQ; ++q) {
                  if (cntT[q] != K) {
                      const unsigned cand = T[q] | (1u << bit);
                      int cnt = __popcll(__ballot(kx[q][0] >= cand));
                      if (c >= 64) cnt += __popcll(__ballot(kx[q][1] >= cand));
                      if (c >= 128) cnt += __popcll(__ballot(kx[q][2] >= cand)) + ((c >= 192) ? __popcll(__ballot(kx[q][3] >= cand)) : 0);
                      if (cnt >= K) { T[q] = cand; cntT[q] = cnt; }
                  }
                  alldone = alldone && (cntT[q] == K);
              }
              if (alldone) break;
          }
      }
#pragma unroll
      for (int q = 0; q < TKQ; ++q) {
          int quota = 1 << 20;
          if (ncand > K) quota = K - (__popcll(__ballot(kx[q][0] > T[q])) + __popcll(__ballot(kx[q][1] > T[q])) + __popcll(__ballot(kx[q][2] > T[q])) + __popcll(__ballot(kx[q][3] > T[q])));
          int base = 0;
#pragma unroll
          for (int jj = 0; jj < 4; ++jj) {
              const int j = lane + 64 * jj; const bool fr = (j <= c) && ((j == 0) || (j == c) || (j == c - 1)), cd = kx[q][jj] != 0u;
              const unsigned long long eqm = __ballot(cd && kx[q][jj] == T[q]);
              const int rank = base + (int)__builtin_amdgcn_mbcnt_hi((unsigned)(eqm >> 32), __builtin_amdgcn_mbcnt_lo((unsigned)eqm, 0u));
              const bool sel = fr || (cd && (kx[q][jj] > T[q] || (kx[q][jj] == T[q] && rank < quota)));
              const unsigned long long sm = __ballot(sel);
              if (lane == 0) { selb[(q0 + q) * 8 + 2 * jj] = (unsigned)sm; selb[(q0 + q) * 8 + 2 * jj + 1] = (unsigned)(sm >> 32); }
              base += __popcll(eqm);
          }
      } } }
    asm volatile("s_waitcnt lgkmcnt(0)" ::: "memory");
#pragma unroll
    for (int r = 0; r < 32; ++r) impw[r * 64 + lane] = rpark[r * 64 + lane];
    asm volatile("s_waitcnt lgkmcnt(0)" ::: "memory");
    __syncthreads();
    f32x16 O0, O1;
#pragma unroll
    for (int r = 0; r < 16; ++r) { O0[r] = 0.f; O1[r] = 0.f; }
    col.m = -INFINITY; col.l = 0.f;
    { const int i0 = c < 8 ? 8 - c : 0;
      const bf16* Qp = ((const bf16*)(ws_opaque() + WS_Q)) + ((size_t)b * SEQ + col.tcol) * 512 + (g * 4 + hh) * 64;
      bf16x8 qf[4];
#pragma unroll
      for (int ks = 0; ks < 4; ++ks) qf[ks] = *(const bf16x8*)(Qp + 16 * ks + 8 * h);
      nsa_tiles<MODE_WIN>(F, ws_opaque(), b, g, c, 9 - i0, i0, qf, col, 0.f, O0, O1, impw); }
    col.l += __shfl_xor(col.l, 32);
    const float il = col.l > 0.f ? NSA_GATE(2) / col.l : 0.f;
    bf16* Op = ((bf16*)(ws_opaque() + WS_YP)) + ((size_t)b * SEQ + col.tcol) * 512 + (g * 4 + hh) * 64;
#pragma unroll
    for (int u = 0; u < 4; ++u) {
        float y0[4], y1[4];
#pragma unroll
        for (int e = 0; e < 4; ++e) { y0[e] = impw[(4 * u + e) * 64 + lane] + il * O0[4 * u + e]; y1[e] = impw[(16 + 4 * u + e) * 64 + lane] + il * O1[4 * u + e]; }
        u32x2_t w0; w0.x = cvtpk(y0[0], y0[1]); w0.y = cvtpk(y0[2], y0[3]);
        u32x2_t w1; w1.x = cvtpk(y1[0], y1[1]); w1.y = cvtpk(y1[2], y1[3]);
        *(u32x2_t*)(Op + 8 * u + 4 * h) = w0; *(u32x2_t*)(Op + 32 + 8 * u + 4 * h) = w1;
    }
}
DI void nsa_phase(Frame& F, size_t out_off) {
    unsigned char* const wsq = ws_opaque();
    const bool xcd = (F.G == 256);
    const int nit = xcd ? 2 : (512 + F.G - 1) / F.G;
    for (int it = 0; it < nit; ++it) {
        int C, bg;
        if (xcd) { const int x = F.bid & 7, q = F.bid >> 3, k = q * 2 + (x & 1); bg = x >> 1; C = (it == 0) ? 127 - k : k; }
        else { const int idx = it * F.G + ((it & 1) ? (F.G - 1 - F.bid) : F.bid); if (idx >= 512) continue; C = 127 - (idx >> 2); bg = idx & 3; }
        asm volatile("" : "+v"(F.tid)); F.lane = F.tid & 63;
        for (int hf_ = 0; hf_ < 2; ++hf_) nsa_pre(F, wsq, bg >> 1, bg & 1, 2 * C + hf_, hf_);
        asm volatile("s_waitcnt vmcnt(0)" ::: "memory"); __syncthreads();
        asm volatile("" : "+v"(F.tid)); F.lane = F.tid & 63;
        nsa_selpair(F, ws_opaque(), bg >> 1, bg & 1, 2 * C, out_off);
        F.lane = (int)__builtin_amdgcn_mbcnt_hi(~0u, __builtin_amdgcn_mbcnt_lo(~0u, 0u)); F.tid = F.wave * 64 + F.lane;
    }
}

DI void compress_phase(Frame& F, int l) {
    unsigned char* const wsq = ws_opaque();
    constexpr int XP = 144;
    LAS unsigned char* xt = F.lds + RING_OFF; LAS float* red = (LAS float*)(F.lds + RING_OFF + 528 * XP);
    static_assert(528 * 144 + 65536 <= RING_BYTES, "compress LDS map");
    const int w = F.wave, lane = F.lane, tid = F.tid, r = lane & 31, hf = lane >> 5;
    for (int u = F.bid; u < 256; u += F.G) {
        const int which = u & 1, rest = u >> 1, nb = rest & 31, g = (rest >> 5) & 1, b = rest >> 6, n0 = nb * 32;
        const bf16* src = ((const bf16*)(wsq + WS_KV)) + ((size_t)(which * 2 + g) * M + (size_t)b * SEQ) * 64;
        { v4u xv[9];
#pragma unroll
          for (int k = 0; k < 9; ++k) { const int p = tid + 512 * k, tk = (p < 528 * 8 ? p : 0) >> 3, cc = p & 7; int tok = 16 * n0 + tk; tok = tok < SEQ ? tok : SEQ - 1; xv[k] = *(const v4u*)(src + (size_t)tok * 64 + cc * 8); }
#pragma unroll
          for (int k = 0; k < 9; ++k) { const int p = tid + 512 * k; if (p < 528 * 8) *(LAS v4u*)(xt + (p >> 3) * XP + (p & 7) * 16) = xv[k]; } }
        __syncthreads();
        const bf16* WT = ((const bf16*)(wsq + WS_WCT)) + (size_t)(l * 2 + which) * 64 * 2048;
        f32x16 a0, a1;
#pragma unroll
        for (int i = 0; i < 16; ++i) { a0[i] = 0.f; a1[i] = 0.f; }
#pragma unroll 4
        for (int kk = 0; kk < 16; ++kk) { const int ks = 16 * w + kk, li = ks >> 2;
            const bf16x8 af = *(const LAS bf16x8*)(xt + (16 * r + li) * XP + ((ks & 3) * 16 + 8 * hf) * 2);
            const bf16x8 b0 = *(const bf16x8*)(WT + (size_t)r * 2048 + 16 * ks + 8 * hf), b1 = *(const bf16x8*)(WT + (size_t)(32 + r) * 2048 + 16 * ks + 8 * hf);
            a0 = MFMA32(af, b0, a0); a1 = MFMA32(af, b1, a1); }
#pragma unroll
        for (int i = 0; i < 16; ++i) { red[(w * 32 + crow(i, hf)) * 64 + r] = a0[i]; red[(w * 32 + crow(i, hf)) * 64 + 32 + r] = a1[i]; }
        __syncthreads();
        const float* cp = ((const float*)(wsq + WS_CPOS)) + (l * 2 + which) * 64;
#pragma unroll
        for (int q = 0; q < 4; ++q) { const int o = tid + 512 * q, nl = o >> 6, e = o & 63; float s = cp[e];
#pragma unroll
            for (int ww = 0; ww < 8; ++ww) s += red[(ww * 32 + nl) * 64 + e];
            const int n = n0 + nl; const bf16 val = (n < NCMP) ? (bf16)f2bf(s) : (bf16)0;
            if (which) ((bf16*)(wsq + WS_VCT))[(size_t)((b * 2 + g) * 16 + (n >> 6)) * 4096 + e * 64 + (n & 63)] = val;
            else ((bf16*)(wsq + WS_KCMP))[((size_t)(b * 1024 + n) * 2 + g) * 64 + e] = val; }
        __syncthreads();
    }
}

DI void vtrans_phase(Frame& F) {
    unsigned char* const wsq = ws_opaque();
    const int tid = F.tid, row = tid >> 3, cc = tid & 7;
    for (int u0 = F.bid; u0 < 2048; u0 += 4 * F.G) {
        v4u r[4];
#pragma unroll
        for (int q = 0; q < 4; ++q) { const int u = u0 + q * F.G; const int uu = u < 2048 ? u : u0; const int j = uu & 255, g = (uu >> 8) & 1, b = (uu >> 9) & 1, kind = uu >> 10;
            r[q] = *(const v4u*)(((const bf16*)(wsq + WS_KV)) + ((size_t)((kind ? 5 : 3) * 2 + g) * M + (size_t)b * SEQ + 64 * j + row) * 64 + cc * 8); }
#pragma unroll
        for (int q = 0; q < 4; ++q) { LAS unsigned short* tp = (LAS unsigned short*)(F.lds + RING_OFF) + q * (64 * 72) + (8 * cc) * 72 + row;
            tp[0 * 72] = (unsigned short)(r[q].x & 0xffffu); tp[1 * 72] = (unsigned short)(r[q].x >> 16); tp[2 * 72] = (unsigned short)(r[q].y & 0xffffu); tp[3 * 72] = (unsigned short)(r[q].y >> 16);
            tp[4 * 72] = (unsigned short)(r[q].z & 0xffffu); tp[5 * 72] = (unsigned short)(r[q].z >> 16); tp[6 * 72] = (unsigned short)(r[q].w & 0xffffu); tp[7 * 72] = (unsigned short)(r[q].w >> 16); }
        __syncthreads();
#pragma unroll
        for (int q = 0; q < 4; ++q) { const int u = u0 + q * F.G;
            if (u < 2048) { const int j = u & 255, g = (u >> 8) & 1, b = (u >> 9) & 1, kind = u >> 10;
                const v4u o = *(const LAS v4u*)((LAS unsigned short*)(F.lds + RING_OFF) + q * (64 * 72) + row * 72 + cc * 8);
                *(v4u*)(((bf16*)(wsq + (kind ? WS_VWT : WS_VST))) + (size_t)((b * 2 + g) * 256 + j) * 4096 + row * 64 + cc * 8) = o; } }
        __syncthreads();
    }
}

DI float logsig(float z) { return fminf(z, 0.f) - 0.6931471805599453f * __builtin_amdgcn_logf(1.0f + __builtin_amdgcn_exp2f(-1.4426950408889634f * fabsf(z))); }
DI float fexp(float x) { return __builtin_amdgcn_exp2f(1.4426950408889634f * x); }
constexpr int GLP = 144;
template <int CTRL, int ROWS> DI float dpp_or0(float x) { return __builtin_bit_cast(float, __builtin_amdgcn_update_dpp(0, __builtin_bit_cast(int, x), CTRL, ROWS, 0xF, true)); }
DI float wave_scan_incl(float x) {
    x += dpp_or0<0x111, 0xF>(x); x += dpp_or0<0x112, 0xF>(x); x += dpp_or0<0x114, 0xF>(x); x += dpp_or0<0x118, 0xF>(x);
    x += dpp_or0<0x142, 0xA>(x); x += dpp_or0<0x143, 0xC>(x);
    return x;
}
constexpr int GLA_WG_OFF = RING_OFF + 98304;
static_assert(GLA_WG_OFF + 17 * 1024 <= LDS_BYTES, "gate weights in LDS");
DI void gla_stage_wg(Frame& F, int l) {
    LAS float* wgl = (LAS float*)(F.lds + GLA_WG_OFF);
    const float* wg = IN_gla_w_gate + (size_t)l * 16 * 256; const float* bg = IN_gla_b_gate + (size_t)l * 256;
#pragma unroll
    for (int k = 0; k < 2; ++k) ((LAS f32x4*)wgl)[F.tid + 512 * k] = ((const f32x4*)wg)[F.tid + 512 * k];
    if (F.tid < 64) ((LAS f32x4*)wgl)[1024 + F.tid] = ((const f32x4*)bg)[F.tid];
    __syncthreads();
}
DI void gla_gates_c(Frame& F, const f32x4 (&gl4)[4], int h, int w, int lane, float (&bcv)[8], float (&blv)[8]) {
    const LAS float* wgl = (const LAS float*)(F.lds + GLA_WG_OFF) + h * 64 + 8 * w;
    float glr[16];
#pragma unroll
    for (int r4 = 0; r4 < 4; ++r4) { glr[4 * r4] = gl4[r4].x; glr[4 * r4 + 1] = gl4[r4].y; glr[4 * r4 + 2] = gl4[r4].z; glr[4 * r4 + 3] = gl4[r4].w; }
    { const f32x4 b0 = *(const LAS f32x4*)(wgl + 4096), b1 = *(const LAS f32x4*)(wgl + 4096 + 4);
      float z[8] = {b0.x, b0.y, b0.z, b0.w, b1.x, b1.y, b1.z, b1.w};
#pragma unroll
      for (int r = 0; r < 16; ++r) { const f32x4 w0 = *(const LAS f32x4*)(wgl + r * 256), w1 = *(const LAS f32x4*)(wgl + r * 256 + 4);
          z[0] += glr[r] * w0.x; z[1] += glr[r] * w0.y; z[2] += glr[r] * w0.z; z[3] += glr[r] * w0.w; z[4] += glr[r] * w1.x; z[5] += glr[r] * w1.y; z[6] += glr[r] * w1.z; z[7] += glr[r] * w1.w; }
#pragma unroll
      for (int e = 0; e < 8; ++e) bcv[e] = logsig(z[e]) * (1.0f / 16.0f); }
#pragma unroll
    for (int e = 0; e < 8; ++e) bcv[e] = wave_scan_incl(bcv[e]);
#pragma unroll
    for (int e = 0; e < 8; ++e) blv[e] = __builtin_bit_cast(float, __builtin_amdgcn_readlane(__builtin_bit_cast(int, bcv[e]), 63));
}
DI void gla_gates_ld(unsigned char* wsq, size_t m0, int lane, f32x4 (&gl4)[4]) {
#pragma unroll
    for (int r4 = 0; r4 < 4; ++r4) gl4[r4] = *(const f32x4*)(((const float*)(wsq + WS_SMALL)) + (m0 + lane) * 64 + 24 + 4 * r4);
}
DI void gla_gates(Frame& F, unsigned char* wsq, int l, size_t m0, int h, int w, int lane, float (&bcv)[8], float (&blv)[8]) {
    f32x4 gl4[4]; gla_gates_ld(wsq, m0, lane, gl4); gla_gates_c(F, gl4, h, w, lane, bcv, blv);
}
DI void gla_vt_ld(unsigned char* wsq, size_t m0, int h, int w, int lane, v4u (&vr)[2]) {
#pragma unroll
    for (int pp = 0; pp < 2; ++pp) vr[pp] = *(const v4u*)(((const bf16*)(wsq + WS_VG)) + (m0 + lane) * 512 + h * 128 + 8 * (2 * w + pp));
}
DI void gla_vt_st(const v4u (&vr)[2], int w, int lane, LAS unsigned char* VT) {
#pragma unroll
    for (int pp = 0; pp < 2; ++pp) { const int cc = 2 * w + pp; const v4u r = vr[pp];
        LAS unsigned short* tp = (LAS unsigned short*)(VT + (8 * cc) * GLP) + lane;
        tp[0 * (GLP / 2)] = (unsigned short)(r.x & 0xffffu); tp[1 * (GLP / 2)] = (unsigned short)(r.x >> 16); tp[2 * (GLP / 2)] = (unsigned short)(r.y & 0xffffu); tp[3 * (GLP / 2)] = (unsigned short)(r.y >> 16);
        tp[4 * (GLP / 2)] = (unsigned short)(r.z & 0xffffu); tp[5 * (GLP / 2)] = (unsigned short)(r.z >> 16); tp[6 * (GLP / 2)] = (unsigned short)(r.w & 0xffffu); tp[7 * (GLP / 2)] = (unsigned short)(r.w >> 16); }
}
DI void gla_stage_vt(unsigned char* wsq, size_t m0, int h, int w, int lane, LAS unsigned char* VT) { v4u vr[2]; gla_vt_ld(wsq, m0, h, w, lane, vr); gla_vt_st(vr, w, lane, VT); }
DI void gla_g1(Frame& F, int l) {
    unsigned char* const wsq = ws_opaque();
    gla_stage_wg(F, l);
    constexpr int UB = 64 * GLP + 128 * GLP;
    const int w = F.wave, lane = F.lane, r = lane & 31, hf = lane >> 5;
    for (int u0 = F.bid; u0 < 2048; u0 += 2 * F.G) {
#pragma unroll
        for (int p = 0; p < 2; ++p) {
            const int u = (p == 0 || u0 + F.G < 2048) ? u0 + p * F.G : u0;
            LAS unsigned char* KTT = F.lds + RING_OFF + p * UB; LAS unsigned char* VT = KTT + 64 * GLP;
            const int h = u & 3, n = (u >> 2) & 255, b = u >> 10; const size_t m0 = (size_t)b * SEQ + n * 64;
            float bcv[8], blv[8]; gla_gates(F, wsq, l, m0, h, w, lane, bcv, blv);
            { float kf[8]; unpack8(*(const v4u*)(((const bf16*)(wsq + WS_QKG)) + (m0 + lane) * 512 + 256 + h * 64 + 8 * w), kf);
#pragma unroll
              for (int e = 0; e < 8; ++e) ((LAS unsigned short*)(KTT + (8 * w + e) * GLP))[lane] = (unsigned short)f2bf(kf[e] * fexp(blv[e] - bcv[e]));
              if (lane == 0) {
#pragma unroll
                  for (int e = 0; e < 8; ++e) ((float*)(wsq + WS_DECAY))[u * 64 + 8 * w + e] = fexp(blv[e]); } }
            gla_stage_vt(wsq, m0, h, w, lane, VT);
        }
        __syncthreads();
        const int et = w >> 1, dt = w & 1;
#pragma unroll
        for (int p = 0; p < 2; ++p) {
            const int u = (p == 0 || u0 + F.G < 2048) ? u0 + p * F.G : u0;
            const LAS unsigned char* KTT = F.lds + RING_OFF + p * UB; const LAS unsigned char* VT = KTT + 64 * GLP;
            f32x16 acc;
#pragma unroll
            for (int i = 0; i < 16; ++i) acc[i] = 0.f;
#pragma unroll
            for (int ks = 0; ks < 4; ++ks) {
                const bf16x8 a = *(const LAS bf16x8*)(VT + (32 * et + r) * GLP + ks * 32 + hf * 16);
                const bf16x8 bq = *(const LAS bf16x8*)(KTT + (32 * dt + r) * GLP + ks * 32 + hf * 16);
                acc = MFMA32(a, bq, acc);
            }
            float* dst = ((float*)(wsq + WS_GLA)) + (size_t)u * 8192 + 32 * dt + r;
#pragma unroll
            for (int i = 0; i < 16; ++i) dst[(32 * et + crow(i, hf)) * 64] = acc[i];
        }
        __syncthreads();
    }
}
DI void gla_g2(Frame& F, const float* gbase, unsigned* sbase) {
    unsigned char* const wsq = ws_opaque();
    if (F.tid >= 256) return;
    for (int ch = F.bid * 256 + F.tid; ch < 65536; ch += F.G * 256) {
        const int d = ch & 63, e = (ch >> 6) & 127, h = (ch >> 13) & 3, b = ch >> 15;
        float st = 0.f;
        const float* gp = gbase + (size_t)((b * 256) * 4 + h) * 8192 + e * 64 + d;
        unsigned* sp = sbase + (((size_t)((b * 256) * 4 + h) * 8192 + e * 64 + d) >> 1);
        const float* dp = ((const float*)(wsq + WS_DECAY)) + ((b * 256) * 4 + h) * 64 + d;
        float dlA[16], dcA[16], dlB[16], dcB[16];
#pragma unroll
        for (int k = 0; k < 16; ++k) { dlA[k] = gp[(size_t)k * 32768]; dcA[k] = dp[k * 256]; }
        for (int n0 = 0; n0 < 256; n0 += 32) {
#pragma unroll
            for (int k = 0; k < 16; ++k) { dlB[k] = gp[(size_t)(n0 + 16 + k) * 32768]; dcB[k] = dp[(n0 + 16 + k) * 256]; }
#pragma unroll
            for (int k = 0; k < 16; ++k) { const float nb = __shfl_xor(st, 1); if ((d & 1) == 0) sp[(size_t)(n0 + k) * 16384] = cvtpk(st, nb); st = st * dcA[k] + dlA[k]; }
            if (n0 + 32 < 256) {
#pragma unroll
                for (int k = 0; k < 16; ++k) { dlA[k] = gp[(size_t)(n0 + 32 + k) * 32768]; dcA[k] = dp[(n0 + 32 + k) * 256]; }
            }
#pragma unroll
            for (int k = 0; k < 16; ++k) { const float nb = __shfl_xor(st, 1); if ((d & 1) == 0) sp[(size_t)(n0 + 16 + k) * 16384] = cvtpk(st, nb); st = st * dcB[k] + dlB[k]; }
        }
    }
}
DI bf16x8 f8_to_bf16x8(const f32x4 a, const f32x4 b) { v4u p; p.x = cvtpk(a.x, a.y); p.y = cvtpk(a.z, a.w); p.z = cvtpk(b.x, b.y); p.w = cvtpk(b.z, b.w); return __builtin_bit_cast(bf16x8, p); }
struct G3A { f32x4 gl4[4]; v4u qv, kv; v4u vr[2]; };
DI void gla_g3(Frame& F, int l, size_t out_off) {
    unsigned char* const wsq = ws_opaque();
    gla_stage_wg(F, l);
    constexpr int UB = 64 * GLP * 2 + 128 * GLP + 1024;
    const int w = F.wave, lane = F.lane, r = lane & 31, hf = lane >> 5;
    const float* gn = IN_gla_norm + (size_t)l * 128;
    const int et = w >> 1, it = w & 1, ii = 32 * it + r;
    auto unit_of = [&](int u0, int p) { return (p == 0 || u0 + F.G < 2048) ? u0 + p * F.G : u0; };
    auto loadA = [&](int u, G3A& x) { const int h = u & 3, n = (u >> 2) & 255, b = u >> 10; const size_t m0 = (size_t)b * SEQ + n * 64;
        gla_gates_ld(wsq, m0, lane, x.gl4);
        x.qv = *(const v4u*)(((const bf16*)(wsq + WS_QKG)) + (m0 + lane) * 512 + h * 64 + 8 * w); x.kv = *(const v4u*)(((const bf16*)(wsq + WS_QKG)) + (m0 + lane) * 512 + 256 + h * 64 + 8 * w);
        gla_vt_ld(wsq, m0, h, w, lane, x.vr); };
    auto loadB = [&](int u, bf16x8 (&sf)[4], u32x2_t (&rw)[4]) { const int h = u & 3, n = (u >> 2) & 255, b = u >> 10; const size_t m0 = (size_t)b * SEQ + n * 64;
        const bf16* sp = ((const bf16*)OUTP) + (size_t)u * 8192 + (32 * et + r) * 64 + 8 * hf;
#pragma unroll
        for (int ks = 0; ks < 4; ++ks) sf[ks] = *(const bf16x8*)(sp + 16 * ks);
#pragma unroll
        for (int q = 0; q < 4; ++q) rw[q] = *(const u32x2_t*)(((const bf16*)(wsq + WS_RG)) + (m0 + ii) * 512 + h * 128 + 32 * et + 8 * q + 4 * hf); };
    G3A in[2]; bf16x8 sf[2][4]; u32x2_t rw[2][4];
    if (F.bid < 2048) {
#pragma unroll
        for (int p = 0; p < 2; ++p) { loadA(unit_of(F.bid, p), in[p]); loadB(unit_of(F.bid, p), sf[p], rw[p]); } }
    for (int u0 = F.bid; u0 < 2048; u0 += 2 * F.G) {
        const int un = u0 + 2 * F.G; const bool has_next = un < 2048;
#pragma unroll
        for (int p = 0; p < 2; ++p) {
            const int u = unit_of(u0, p);
            LAS unsigned char* QS = F.lds + RING_OFF + p * UB; LAS unsigned char* KS = QS + 64 * GLP; LAS unsigned char* VT = KS + 64 * GLP;
            const int h = u & 3;
            float bcv[8], blv[8]; gla_gates_c(F, in[p].gl4, h, w, lane, bcv, blv);
            { float qv[8], kf[8];
              unpack8(in[p].qv, qv); unpack8(in[p].kv, kf);
              float qo[8], ko[8];
#pragma unroll
              for (int e = 0; e < 8; ++e) { qo[e] = qv[e] * 0.125f * fexp(bcv[e]); ko[e] = kf[e] * fexp(-bcv[e]); }
              v4u qp, kp; qp.x = cvtpk(qo[0], qo[1]); qp.y = cvtpk(qo[2], qo[3]); qp.z = cvtpk(qo[4], qo[5]); qp.w = cvtpk(qo[6], qo[7]);
              kp.x = cvtpk(ko[0], ko[1]); kp.y = cvtpk(ko[2], ko[3]); kp.z = cvtpk(ko[4], ko[5]); kp.w = cvtpk(ko[6], ko[7]);
              *(LAS v4u*)(QS + lane * GLP + 16 * w) = qp; *(LAS v4u*)(KS + lane * GLP + 16 * w) = kp; }
            gla_vt_st(in[p].vr, w, lane, VT);
        }
        if (has_next) {
#pragma unroll
            for (int p = 0; p < 2; ++p) loadA(unit_of(un, p), in[p]); }
        LDS_BARRIER();
        f32x16 acc[2];
#pragma unroll
        for (int p = 0; p < 2; ++p) {
            const LAS unsigned char* QS = F.lds + RING_OFF + p * UB; const LAS unsigned char* KS = QS + 64 * GLP; const LAS unsigned char* VT = KS + 64 * GLP; LAS float* red = (LAS float*)(VT + 128 * GLP);
            bf16x8 qf[4];
#pragma unroll
            for (int ks = 0; ks < 4; ++ks) qf[ks] = *(const LAS bf16x8*)(QS + (32 * it + r) * GLP + ks * 32 + hf * 16);
#pragma unroll
            for (int i = 0; i < 16; ++i) acc[p][i] = 0.f;
#pragma unroll
            for (int ks = 0; ks < 4; ++ks) acc[p] = MFMA32(sf[p][ks], qf[ks], acc[p]);
#pragma unroll
            for (int jt = 0; jt < 2; ++jt) {
                if (jt <= it) {
                    f32x16 X;
#pragma unroll
                    for (int i = 0; i < 16; ++i) X[i] = 0.f;
#pragma unroll
                    for (int ks = 0; ks < 4; ++ks) { const bf16x8 a = *(const LAS bf16x8*)(KS + (32 * jt + r) * GLP + ks * 32 + hf * 16); X = MFMA32(a, qf[ks], X); }
                    if (jt == it) {
#pragma unroll
                        for (int i = 0; i < 16; ++i) X[i] = (crow(i, hf) <= r) ? X[i] : 0.f;
                    }
                    const LAS unsigned char* vr = VT + (32 * et + r) * GLP + (32 * jt + 4 * hf) * 2;
                    { const u32x2_t lo = *(const LAS u32x2_t*)vr, hi = *(const LAS u32x2_t*)(vr + 16); const v4u av = {lo.x, lo.y, hi.x, hi.y}; acc[p] = MFMA32(__builtin_bit_cast(bf16x8, av), pack8<0>(X), acc[p]); }
                    { const u32x2_t lo = *(const LAS u32x2_t*)(vr + 32), hi = *(const LAS u32x2_t*)(vr + 48); const v4u av = {lo.x, lo.y, hi.x, hi.y}; acc[p] = MFMA32(__builtin_bit_cast(bf16x8, av), pack8<1>(X), acc[p]); }
                }
            }
            float ss = 0.f;
#pragma unroll
            for (int i = 0; i < 16; ++i) ss += acc[p][i] * acc[p][i];
            ss += __shfl_xor(ss, 32);
            if (hf == 0) red[et * 64 + 32 * it + r] = ss;
        }
        LDS_BARRIER();
#pragma unroll
        for (int p = 0; p < 2; ++p) {
            const int u = unit_of(u0, p);
            const LAS float* red = (const LAS float*)(F.lds + RING_OFF + p * UB + 64 * GLP * 2 + 128 * GLP);
            const int h = u & 3, n = (u >> 2) & 255, b = u >> 10; const size_t m0 = (size_t)b * SEQ + n * 64;
            const float tot = (red[ii] + red[64 + ii]) + (red[128 + ii] + red[192 + ii]);
            const float rs = 1.0f / sqrtf(tot * (1.0f / 128.0f) + EPS);
#pragma unroll
            for (int q = 0; q < 4; ++q) {
                const int e0 = 32 * et + 8 * q + 4 * hf;
                const size_t idx = (m0 + ii) * 512 + h * 128 + e0;
                const u32x2_t rwv = rw[p][q];
                const f32x4 g4 = *(const f32x4*)(gn + e0);
                const float r0 = pg8::bf_lo(rwv.x), r1 = pg8::bf_hi(rwv.x), r2 = pg8::bf_lo(rwv.y), r3 = pg8::bf_hi(rwv.y);
                const float y0 = acc[p][4 * q] * rs * g4.x * (r0 * __builtin_amdgcn_rcpf(1.0f + fexp(-r0))), y1 = acc[p][4 * q + 1] * rs * g4.y * (r1 * __builtin_amdgcn_rcpf(1.0f + fexp(-r1)));
                const float y2 = acc[p][4 * q + 2] * rs * g4.z * (r2 * __builtin_amdgcn_rcpf(1.0f + fexp(-r2))), y3 = acc[p][4 * q + 3] * rs * g4.w * (r3 * __builtin_amdgcn_rcpf(1.0f + fexp(-r3)));
                u32x2_t o; o.x = cvtpk(y0, y1); o.y = cvtpk(y2, y3);
                *(u32x2_t*)(((bf16*)(wsq + out_off)) + idx) = o;
            }
        }
        if (has_next) {
#pragma unroll
            for (int p = 0; p < 2; ++p) loadB(unit_of(un, p), sf[p], rw[p]); }
        LDS_BARRIER();
    }
}

struct Args { const void* in[23]; float* out; unsigned char* ws; };
#define PG8_SP2 true
#define PG8_ALIGN true
constexpr int RSTD_TAB_OFF = RING_OFF + pg8::STAGE_BYTES;
static_assert(RSTD_TAB_OFF + pg8::RSTD_CAP * 1024 <= LDS_BYTES, "rstd table");
DI pg8::RstdTab rstd_prep(Frame& F, const pg8::StaticOrder& S, const float* ssq) {
    LAS float* tab = (LAS float*)(F.lds + RSTD_TAB_OFF);
    const int r = F.tid & 255, i0 = F.tid >> 8;
    float v[pg8::RSTD_CAP / 2];
#pragma unroll
    for (int k = 0; k < pg8::RSTD_CAP / 2; ++k) { pg8::Unit u; const bool ok = S.next(2 * k + i0, u); v[k] = pg8::row_rstd(ssq, ok ? (size_t)u.pm * 256 + r : (size_t)r); }
#pragma unroll
    for (int k = 0; k < pg8::RSTD_CAP / 2; ++k) tab[(2 * k + i0) * 256 + r] = v[k];
    __syncthreads();
    return pg8::RstdTab{(const LAS float*)tab};
}
__global__ void __launch_bounds__(NWAVES * 64, 2) mk_fwd(Args args) {
    extern __shared__ __attribute__((aligned(16))) unsigned char lds[];
    Frame F;
    F.lds = (LAS unsigned char*)lds;
    F.MISC = (volatile LAS unsigned*)(F.lds + MISC_OFF);
    F.tid = threadIdx.x; F.lane = F.tid & 63; F.wave = __builtin_amdgcn_readfirstlane(F.tid >> 6);
    F.G = gridDim.x; F.bid = blockIdx.x;
    unsigned char* wsq = ws_opaque();
    F.ctl = (gu32*)(wsq + WS_CTL);
    if (F.tid < 256) ((LAS unsigned*)(F.lds + LDSCTL_OFF))[F.tid] = 0u;
    __syncthreads();
    (void)xcd_barrier_post((unsigned*)(F.ctl + CW_BAR), F.MISC + 8);
#define NBAR_ 1
#define TS_REC() do {} while (0)
#define GRID_BAR() do { for (int nb_ = 0; nb_ < NBAR_; ++nb_) { XcdBarrier bb_; bb_.bar = (unsigned*)((gu32*)(ws_opaque() + WS_CTL) + CW_BAR); bb_.x = xb_xcc_id(); bb_.st = F.MISC + 8; xcd_barrier(bb_); } wsq = ws_opaque(); asm volatile("" : "+v"(F.tid)); F.lane = F.tid & 63; F.wave = __builtin_amdgcn_readfirstlane(F.tid >> 6); TS_REC(); } while (0)
    using pg8::Gemm; using pg8::StaticOrder; using pg8::gemm_phase;
    int ts_n = 0; (void)ts_n;
    TS_REC();
    const int bid = (int)blockIdx.x;

    p0_prologue(F);
    cast_rows_bf16(F, IN_x, ((bf16*)(wsq + WS_A16)), ((float*)(wsq + WS_SSQ0)));
    GRID_BAR();
    for (int l = 0; l < DEPTH; ++l) {
        { Gemm g{((bf16*)(wsq + WS_A16)), wptr(F, l, W_IN), M, NIN, D}; StaticOrder S; S.init(M, NIN, F.G, bid);
          for (S.cnt = pg8::RSTD_CAP; ; S.i0 += pg8::RSTD_CAP) { pg8::Unit u0; if (!S.next(0, u0)) break;
          pg8::EpiProj E{((bf16*)(wsq + WS_U)), ((bf16*)(wsq + WS_Q)), ((bf16*)(wsq + WS_KV)), ((bf16*)(wsq + WS_QKG)), ((bf16*)(wsq + WS_VG)), ((bf16*)(wsq + WS_RG)), ((float*)(wsq + WS_SMALL)), ((float*)(wsq + WS_ROPE)), rstd_prep(F, S, (const float*)(wsq + WS_SSQ0)), M, ((bf16*)(wsq + WS_VST)), ((bf16*)(wsq + WS_VWT)), SEQ};
          gemm_phase<pg8::EpiProj, StaticOrder, PG8_ALIGN, PG8_SP2>(F.lds + RING_OFF, g, S, E, F.tid); } }
        GRID_BAR();
        pool_phase(F); compress_phase(F, l); gla_g1(F, l);
        GRID_BAR();
        gla_g2(F, (const float*)(wsq + WS_GLA), (unsigned*)OUTP);
        nsa_phase(F, WS_Q);
        GRID_BAR();
        gla_g3(F, l, WS_RG);
        GRID_BAR();
        { pg8::GateBranchOrder S; S.init(M, D, F.G, bid);
          pg8::Gemm2 g{{((bf16*)(wsq + WS_A16)), ((bf16*)(wsq + WS_POOLED))}, {wptr(F, l, W_GM), wptr(F, l, W_BR)}, {D, 512}};
          bf16* const gtile = ((bf16*)(wsq + WS_GM)) + (size_t)F.bid * 131072;
          pg8::EpiSigN E0{gtile, NGM, rstd_prep(F, S.S0, (const float*)(wsq + WS_SSQ0))};
          pg8::EpiBranchR E1{((bf16*)(wsq + WS_MG)), gtile, gtile + 65536, M / 256};
          pg8::gemm_stream2<pg8::EpiSigN, pg8::EpiBranchR, pg8::GateBranchOrder>(F.lds + RING_OFF, g, S, E0, E1, F.tid); }
        GRID_BAR();
        { Gemm g{((bf16*)(wsq + WS_MG)), wptr(F, l, W_O), M, D, D}; StaticOrder S; S.init(M, D, F.G, bid);
          pg8::EpiStream<0, false> E{((bf16*)(wsq + WS_A16)), nullptr, ((float*)(wsq + WS_SSQ1)), pg8::RstdTab{nullptr}, nullptr};
          gemm_phase<pg8::EpiStream<0, false>, StaticOrder, PG8_ALIGN, PG8_SP2>(F.lds + RING_OFF, g, S, E, F.tid); }
        GRID_BAR();
        { Gemm g{((bf16*)(wsq + WS_A16)), wptr(F, l, W_1), M, FF, D}; StaticOrder S; S.init(M, FF, F.G, bid);
          for (S.cnt = pg8::RSTD_CAP; ; S.i0 += pg8::RSTD_CAP) { pg8::Unit u0; if (!S.next(0, u0)) break;
          pg8::EpiRelu2N E{((bf16*)(wsq + WS_HID)), FF, rstd_prep(F, S, (const float*)(wsq + WS_SSQ1))};
          gemm_phase<pg8::EpiRelu2N, StaticOrder, PG8_ALIGN, PG8_SP2>(F.lds + RING_OFF, g, S, E, F.tid); } }
        cvt_p16(F, l);
        GRID_BAR();
        { Gemm g{((bf16*)(wsq + WS_HID)), wptr(F, l, W_2), M, D, FF}; StaticOrder S; S.init(M, D, F.G, bid);
          pg8::EpiStream<0, true> E{((bf16*)(wsq + WS_A16)), ((bf16*)(wsq + WS_HB2)), ((float*)(wsq + WS_SSQ2)), pg8::RstdTab{nullptr}, nullptr};
          gemm_phase<pg8::EpiStream<0, true>, StaticOrder, PG8_ALIGN, PG8_SP2>(F.lds + RING_OFF, g, S, E, F.tid); }
        GRID_BAR();
        { pg8::PlePairOrder S; S.init(M, D, F.G, bid);
          int kp = PLE; asm volatile("" : "+s"(kp));
          pg8::Gemm2 g{{((bf16*)(wsq + WS_P16)), ((bf16*)(wsq + WS_HB2))}, {wptr(F, l, W_PP), wptr(F, l, W_PG)}, {kp, D}};
          bf16* const ptile = ((bf16*)(wsq + WS_GM)) + (size_t)F.bid * 131072;
          pg8::EpiTile E0{ptile};
          pg8::EpiStream<1, true> E1{((bf16*)(wsq + WS_HB2)), ((bf16*)(wsq + WS_A16)), ((float*)(wsq + WS_SSQ0)), rstd_prep(F, S.S0, (const float*)(wsq + WS_SSQ2)), ptile};
          pg8::gemm_stream2<pg8::EpiTile, pg8::EpiStream<1, true>, pg8::PlePairOrder>(F.lds + RING_OFF, g, S, E0, E1, F.tid); }
        GRID_BAR();
    }
    final_norm(F, ((const bf16*)(wsq + WS_A16)), ((const float*)(wsq + WS_SSQ0)), IN_norm_final, OUTP);
}

extern "C" void kernel_launch(void* const* d_in, const int* in_sizes, int n_in, void* d_out, int out_size, void* d_ws, size_t ws_size, hipStream_t stream) {
    static int grid = 0;
    if (grid == 0) {
        if (n_in != 23 || out_size != M * D || ws_size < WS_END) { fprintf(stderr, "kernel_launch: unexpected problem (n_in %d, out %d, ws %zu)\n", n_in, out_size, ws_size); grid = -1; return; }
        int dev = 0, cus = 0, per_cu = 0;
        if (hipGetDevice(&dev) != hipSuccess || hipDeviceGetAttribute(&cus, hipDeviceAttributeMultiprocessorCount, dev) != hipSuccess) { grid = -1; return; }
        if (hipFuncSetAttribute((const void*)mk_fwd, hipFuncAttributeMaxDynamicSharedMemorySize, LDS_BYTES) != hipSuccess) { fprintf(stderr, "kernel_launch: hipFuncSetAttribute failed\n"); grid = -1; return; }
        if (hipOccupancyMaxActiveBlocksPerMultiprocessor(&per_cu, (const void*)mk_fwd, NWAVES * 64, LDS_BYTES) != hipSuccess || per_cu < 1) fprintf(stderr, "kernel_launch: occupancy query reports %d\n", per_cu);
        (void)hipGetLastError();
        if ((M / 256) * (D / 256) > cus * pg8::RSTD_CAP) { fprintf(stderr, "kernel_launch: %d CUs: a workgroup's deal of output tiles exceeds the rstd table\n", cus); grid = -1; return; }
        grid = cus;
    }
    if (grid < 0) return;
    if (hipMemsetAsync((char*)d_ws + WS_CTL, 0, CTL_ZERO_BYTES, stream) != hipSuccess) return;
    Args a{};
    for (int i = 0; i < 23; ++i) a.in[i] = d_in[i];
    a.out = (float*)d_out; a.ws = (unsigned char*)d_ws;
    hipLaunchKernelGGL(mk_fwd, dim3(grid), dim3(NWAVES * 64), LDS_BYTES, stream, a);
}
```

```cpp
#include <hip/hip_runtime.h>
#include <cstdio>
#include <cstdint>
#include <cmath>
namespace pg8 {
#define PG8_LAS __attribute__((address_space(3)))
typedef unsigned short bf16_t;
typedef short bf16x8 __attribute__((ext_vector_type(8)));
typedef float f32x4 __attribute__((ext_vector_type(4)));
typedef unsigned u32x4 __attribute__((ext_vector_type(4)));
constexpr int BM = 256, BK = 64, HALF = 128, HTB = HALF * BK * 2  , STAGE_BYTES = 8 * HTB, NXCD = 8, WGM = 8;

__host__ __device__ __forceinline__ int lds_byte(int r, int c) { const int st = (r >> 4) * 2 + (c >> 5), rr = r & 15, cc = c & 31, ob = rr * 64 + cc * 2; return st * 1024 + (ob ^ (((ob >> 9) & 1) << 5)); }
__host__ __device__ __forceinline__ void stage_rc(int b, int& R, int& C) { const int st = b / 1024, sb = b % 1024, swz = sb ^ (((sb >> 9) & 1) << 5); R = (st >> 1) * 16 + swz / 64; C = (st & 1) * 32 + (swz % 64) / 2; }
__host__ __device__ __forceinline__ int perm32(int rho) { const int n = rho >> 4, i = rho & 15; return 8 * (i >> 2) + 4 * n + (i & 3); }

template <class E> struct ABlocked { static constexpr bool v = false; };
struct Unit { int pm, pn, idx, g; };
struct Gemm { const bf16_t* A; const bf16_t* Bt; int M, N, K; };
struct Gemm2 { const bf16_t* A[2]; const bf16_t* Bt[2]; int K[2]; };

struct StaticOrder {
    int nM, nN, nwg, G, c, i0, cnt;
    __host__ __device__ void init(int M, int N, int G_, int c_) { nM = M / BM; nN = N / BM; nwg = nM * nN; G = G_; c = c_; i0 = 0; cnt = 1 << 30; }
    __host__ __device__ __forceinline__ bool next(int i, Unit& u) const {
        if (i >= cnt) return false;
        const int L = (i + i0) * G + c; if (L >= nwg) return false;
        int wgid = L; { const int q = nwg / NXCD, r = nwg % NXCD, xcd = wgid % NXCD, off = wgid / NXCD; wgid = (xcd < r ? xcd * (q + 1) : r * (q + 1) + (xcd - r) * q) + off; }
        const int nig = WGM * nN, gid = wgid / nig, fm = gid * WGM, gsz = (nM - fm) < WGM ? (nM - fm) : WGM;
        u.pm = fm + ((wgid % nig) % gsz); u.pn = (wgid % nig) / gsz; u.idx = i; u.g = 0; return true;
    }
    __device__ __forceinline__ void a_ready(const Unit&) const {}
    __device__ __forceinline__ void done(const Unit&) const {}
};

typedef float f32x2 __attribute__((ext_vector_type(2)));
typedef __bf16 bf16x2_pk __attribute__((ext_vector_type(2)));
__device__ __forceinline__ unsigned cvt_pk_bf16(float lo, float hi) { const f32x2 v = {lo, hi}; return __builtin_bit_cast(unsigned, __builtin_convertvector(v, bf16x2_pk)); }
__device__ __forceinline__ f32x2 gelu_pk(f32x2 v) {
    const f32x2 av = __builtin_elementwise_abs(v), d = av * 0.2316418882f + 1.0f;
    f32x2 t; t.x = __builtin_amdgcn_rcpf(d.x); t.y = __builtin_amdgcn_rcpf(d.y);
    f32x2 q = t * 0.5307027145f + (-0.7265760135f); q = q * t + 0.7107068705f; q = q * t + (-0.142248368f); q = q * t + 0.127414796f; q = q * t;
    const f32x2 s = (v * v) * (-0.72134752044f);
    f32x2 e; e.x = __builtin_amdgcn_exp2f(s.x); e.y = __builtin_amdgcn_exp2f(s.y);
    const f32x2 m = v * (q * e), r = v - m;
    f32x2 o; o.x = v.x < 0.f ? m.x : r.x; o.y = v.y < 0.f ? m.y : r.y; return o;
}

template <int ACT  > struct EpiBf16 {
    static constexpr bool PERM = true, AFTER_DRAIN = false; static_assert(ACT == 0 || ACT == 1, "EpiBf16: ACT is 0 (none) or 1 (gelu_pk)");
    bf16_t* O; int ldc; const float* bias; int split_cols; size_t split_stride; float scale0;
    __device__ __forceinline__ void operator()(const f32x4 (&acc)[2][2][4][2], const Unit& u, int wr, int wc, int fr, int fq) const {
        const int row0 = u.pm * BM + wr * 64 + fr; int colt = u.pn * BM; bf16_t* base = O;
        float sc = 1.f; if (split_cols) { const int t = colt / split_cols; base += (size_t)t * split_stride; colt -= t * split_cols; if (t == 0) sc = scale0; }
        const int col0 = colt + wc * 32 + 8 * fq, bcol0 = u.pn * BM + wc * 32 + 8 * fq;
        f32x4 bv[2][2];
#pragma unroll
        for (int bj = 0; bj < 2; ++bj)
#pragma unroll
            for (int n = 0; n < 2; ++n) bv[bj][n] = bias ? *(const f32x4*)(bias + bcol0 + bj * HALF + 4 * n) : (f32x4){0.f, 0.f, 0.f, 0.f};
#pragma unroll
        for (int ai = 0; ai < 2; ++ai)
#pragma unroll
            for (int m = 0; m < 4; ++m) { bf16_t* rowp = base + (size_t)(row0 + ai * HALF + m * 16) * ldc + col0;
#pragma unroll
                for (int bj = 0; bj < 2; ++bj) { f32x4 v0 = acc[ai][bj][m][0] + bv[bj][0], v1 = acc[ai][bj][m][1] + bv[bj][1];
                    if (ACT == 1) { f32x2 a = gelu_pk((f32x2){v0[0], v0[1]}), b = gelu_pk((f32x2){v0[2], v0[3]}), c = gelu_pk((f32x2){v1[0], v1[1]}), d = gelu_pk((f32x2){v1[2], v1[3]});
                        v0 = (f32x4){a.x, a.y, b.x, b.y}; v1 = (f32x4){c.x, c.y, d.x, d.y}; }
                    v0 = v0 * sc; v1 = v1 * sc; u32x4 w; w.x = cvt_pk_bf16(v0[0], v0[1]); w.y = cvt_pk_bf16(v0[2], v0[3]); w.z = cvt_pk_bf16(v1[0], v1[1]); w.w = cvt_pk_bf16(v1[2], v1[3]);
                    *(u32x4*)(rowp + bj * HALF) = w; } }
    }
};
template <class Epi, class Sched, bool ALIGN_EPI = false, bool SP2 = false>
__device__ __forceinline__ void gemm_phase(PG8_LAS unsigned char* lds, const Gemm g, const Sched& S, const Epi& E, int tid_in) {
    int tid_ = tid_in; asm volatile("" : "+v"(tid_));
    const int tid = tid_, wid = __builtin_amdgcn_readfirstlane(tid >> 6), lane = tid & 63, wr = wid >> 2, wc = wid & 3, fr = lane & 15, fq = lane >> 4;
    const int K = g.K, nt = K / BK;
    unsigned voffA[2], voffB[2];
#pragma unroll
    for (int i = 0; i < 2; ++i) { int R, C; stage_rc(tid * 16 + i * 8192, R, C); const int Rb = Epi::PERM ? ((R & ~31) + perm32(R & 31)) : R;
        voffA[i] = (unsigned)(R * (ABlocked<Epi>::v ? BK : K) + C) * 2u; voffB[i] = (unsigned)(Rb * BK + C) * 2u; }
    const size_t kstep = (size_t)(BK * 2);
    const size_t hstep = (size_t)HALF * K * 2;
    const size_t kstepB = (size_t)(BM * BK * 2), hstepB = (size_t)(HALF * BK * 2);
    const size_t kstepA = ABlocked<Epi>::v ? (size_t)(BM * BK * 2) : kstep, hstepA = ABlocked<Epi>::v ? (size_t)(HALF * BK * 2) : hstep;
    const size_t tstep = 2 * hstep;
    const unsigned ldsw = (unsigned)wid * 1024u;
    const int aoff = lds_byte(wr * 64 + fr, fq * 8), boff = lds_byte(wc * 32 + fr, fq * 8);
#define PG8_SA(b, h) (((b) * 2 + (h)) * HTB)
#define PG8_SB(b, h) ((4 + (b) * 2 + (h)) * HTB)
#define PG8_STAGE(bufoff, gbase, voff) do { _Pragma("unroll") for (int _i = 0; _i < 2; ++_i) \
        __builtin_amdgcn_global_load_lds((const unsigned*)((const char*)(gbase) + (voff)[_i]), (PG8_LAS unsigned*)(lds + (bufoff) + ldsw + _i * 8192), 16, 0, 0); } while (0)
#define PG8_LDA(dst, b, h) do { _Pragma("unroll") for (int m = 0; m < 4; ++m) _Pragma("unroll") for (int k = 0; k < 2; ++k) dst[m][k] = *(const PG8_LAS bf16x8*)(lds + PG8_SA(b, h) + aoff + m * 2048 + k * 1024); } while (0)
#define PG8_LDB(dst, b, h) do { _Pragma("unroll") for (int n = 0; n < 2; ++n) _Pragma("unroll") for (int k = 0; k < 2; ++k) dst[n][k] = *(const PG8_LAS bf16x8*)(lds + PG8_SB(b, h) + boff + n * 2048 + k * 1024); } while (0)
#define PG8_MMA(ai, bj, At, Bt) do { __builtin_amdgcn_s_setprio(1); _Pragma("unroll") for (int m = 0; m < 4; ++m) _Pragma("unroll") for (int n = 0; n < 2; ++n) _Pragma("unroll") for (int k = 0; k < 2; ++k) \
        acc[ai][bj][m][n] = __builtin_amdgcn_mfma_f32_16x16x32_bf16(Bt[n][k], At[m][k], acc[ai][bj][m][n], 0, 0, 0); __builtin_amdgcn_s_setprio(0); } while (0)
#define PG8_WAIT_V(n) asm volatile("s_waitcnt vmcnt(" #n ")" ::: "memory")
#define PG8_WAIT_L(n) asm volatile("s_waitcnt lgkmcnt(" #n ")" ::: "memory")
#define PG8_BAR __builtin_amdgcn_s_barrier()
#define PG8_SCHED __builtin_amdgcn_sched_barrier(0)
    Unit cur, nxt; int ui = 0;
    if (!S.next(0, cur)) return;
    f32x4 acc[2][2][4][2];
#pragma unroll
    for (int a = 0; a < 2; ++a)
#pragma unroll
        for (int b = 0; b < 2; ++b)
#pragma unroll
            for (int m = 0; m < 4; ++m)
#pragma unroll
                for (int n = 0; n < 2; ++n) acc[a][b][m][n] = (f32x4){0.f, 0.f, 0.f, 0.f};
    bf16x8 At[4][2], B0[2][2], B1[2][2];
    const char* cA = (const char*)g.A + (size_t)cur.pm * tstep; const char* cB = (const char*)g.Bt + (size_t)cur.pn * tstep;
    S.a_ready(cur);
    if constexpr (SP2) {
        PG8_STAGE(PG8_SB(0, 0), cB, voffB); PG8_STAGE(PG8_SB(0, 1), cB + hstepB, voffB); PG8_STAGE(PG8_SA(0, 0), cA, voffA); PG8_STAGE(PG8_SA(0, 1), cA + hstepA, voffA);
        if (wr == 1) PG8_BAR;
        PG8_WAIT_V(2); PG8_BAR;
        PG8_STAGE(PG8_SB(1, 0), cB + kstepB, voffB); PG8_STAGE(PG8_SA(1, 0), cA + kstepA, voffA); PG8_STAGE(PG8_SB(1, 1), cB + hstepB + kstepB, voffB);
        PG8_WAIT_V(6); PG8_BAR;
    } else {
        PG8_STAGE(PG8_SB(0, 0), cB, voffB); PG8_STAGE(PG8_SA(0, 0), cA, voffA); PG8_STAGE(PG8_SB(0, 1), cB + hstepB, voffB); PG8_STAGE(PG8_SA(0, 1), cA + hstepA, voffA);
        if (wr == 1) PG8_BAR;
        PG8_WAIT_V(4); PG8_BAR;
        PG8_STAGE(PG8_SB(1, 0), cB + kstepB, voffB); PG8_STAGE(PG8_SA(1, 0), cA + kstepA, voffA); PG8_STAGE(PG8_SB(1, 1), cB + hstepB + kstepB, voffB);
        PG8_WAIT_V(6); PG8_BAR;
    }
    for (;;) {
        const bool has_next = S.next(ui + 1, nxt);
        const char* nA = has_next ? (const char*)g.A + (size_t)nxt.pm * tstep : cA; const char* nB = has_next ? (const char*)g.Bt + (size_t)nxt.pn * tstep : cB;
        for (int t = 0; t < nt; t += 2) {
            const bool last = (t == nt - 2);
            const char* a1 = cA + (size_t)(t + 1) * kstepA;
            const char* a2 = last ? nA : cA + (size_t)(t + 2) * kstepA; const char* b2 = last ? nB : cB + (size_t)(t + 2) * kstepB;
            const char* a3 = a2 + kstepA; const char* b3 = b2 + kstepB;
            if (last && has_next) S.a_ready(nxt);
            if constexpr (SP2) {
            PG8_LDB(B0, 0, 0); PG8_LDB(B1, 0, 1); PG8_SCHED; PG8_LDA(At, 0, 0); PG8_STAGE(PG8_SA(1, 1), a1 + hstepA, voffA);
            PG8_WAIT_V(8); PG8_WAIT_L(0); PG8_BAR; PG8_MMA(0, 0, At, B0); PG8_MMA(0, 1, At, B1); PG8_BAR; PG8_SCHED;
            PG8_LDA(At, 0, 1); PG8_STAGE(PG8_SB(0, 0), b2, voffB); PG8_STAGE(PG8_SB(0, 1), b2 + hstepB, voffB); PG8_STAGE(PG8_SA(0, 0), a2, voffA);
            PG8_WAIT_V(8); PG8_WAIT_L(0); PG8_BAR; PG8_MMA(1, 0, At, B0); PG8_MMA(1, 1, At, B1); PG8_BAR; PG8_SCHED;
            PG8_LDB(B0, 1, 0); PG8_LDB(B1, 1, 1); PG8_SCHED; PG8_LDA(At, 1, 0); PG8_STAGE(PG8_SA(0, 1), a2 + hstepA, voffA);
            PG8_WAIT_V(8); PG8_WAIT_L(0); PG8_BAR; PG8_MMA(0, 0, At, B0); PG8_MMA(0, 1, At, B1); PG8_BAR; PG8_SCHED;
            PG8_LDA(At, 1, 1); PG8_STAGE(PG8_SB(1, 0), b3, voffB); PG8_STAGE(PG8_SB(1, 1), b3 + hstepB, voffB); PG8_STAGE(PG8_SA(1, 0), a3, voffA);
            PG8_WAIT_V(8); PG8_WAIT_L(0); PG8_BAR; PG8_MMA(1, 0, At, B0); PG8_MMA(1, 1, At, B1); PG8_BAR; PG8_SCHED;
            } else {
            PG8_LDB(B0, 0, 0); PG8_SCHED; PG8_LDA(At, 0, 0); PG8_STAGE(PG8_SA(1, 1), a1 + hstepA, voffA);
            PG8_WAIT_L(8); PG8_BAR; PG8_WAIT_L(0); PG8_MMA(0, 0, At, B0); PG8_BAR; PG8_SCHED;
            PG8_LDB(B1, 0, 1); PG8_STAGE(PG8_SB(0, 0), b2, voffB);
            PG8_BAR; PG8_WAIT_L(0); PG8_MMA(0, 1, At, B1); PG8_BAR;
            PG8_LDA(At, 0, 1); PG8_STAGE(PG8_SA(0, 0), a2, voffA);
            PG8_BAR; PG8_WAIT_L(0); PG8_MMA(1, 0, At, B0); PG8_BAR; PG8_SCHED;
            PG8_STAGE(PG8_SB(0, 1), b2 + hstepB, voffB);
            PG8_WAIT_V(6); PG8_BAR; PG8_MMA(1, 1, At, B1); PG8_BAR;
            PG8_LDB(B0, 1, 0); PG8_SCHED; PG8_LDA(At, 1, 0); PG8_STAGE(PG8_SA(0, 1), a2 + hstepA, voffA);
            PG8_WAIT_L(8); PG8_BAR; PG8_WAIT_L(0); PG8_MMA(0, 0, At, B0); PG8_BAR; PG8_SCHED;
            PG8_LDB(B1, 1, 1); PG8_STAGE(PG8_SB(1, 0), b3, voffB);
            PG8_BAR; PG8_WAIT_L(0); PG8_MMA(0, 1, At, B1); PG8_BAR;
            PG8_LDA(At, 1, 1); PG8_STAGE(PG8_SA(1, 0), a3, voffA);
            PG8_BAR; PG8_WAIT_L(0); PG8_MMA(1, 0, At, B0); PG8_BAR; PG8_SCHED;
            PG8_STAGE(PG8_SB(1, 1), b3 + hstepB, voffB);
            PG8_WAIT_V(6); PG8_BAR; PG8_MMA(1, 1, At, B1); PG8_BAR;
            }
        }
        if constexpr (ALIGN_EPI) { if (wr == 0) PG8_BAR; }
        if constexpr (!Epi::AFTER_DRAIN) { E(acc, cur, wr, wc, fr, fq); S.done(cur); }
        if (!has_next) break;
#pragma unroll
        for (int a = 0; a < 2; ++a)
#pragma unroll
            for (int b = 0; b < 2; ++b)
#pragma unroll
                for (int m = 0; m < 4; ++m)
#pragma unroll
                    for (int n = 0; n < 2; ++n) acc[a][b][m][n] = (f32x4){0.f, 0.f, 0.f, 0.f};
        cur = nxt; cA = nA; cB = nB; ++ui;
        if constexpr (ALIGN_EPI) { if (wr == 1) PG8_BAR; }
    }
    PG8_WAIT_V(0);
    if constexpr (!ALIGN_EPI) { if (wr == 0) PG8_BAR; }
    PG8_BAR;
    if constexpr (Epi::AFTER_DRAIN) { E.fused(acc, cur, wr, wc, fr, fq, lds, wid, lane); S.done(cur); }
#undef PG8_SA
#undef PG8_SB
#undef PG8_STAGE
#undef PG8_LDA
#undef PG8_LDB
#undef PG8_MMA
#undef PG8_WAIT_V
#undef PG8_WAIT_L
#undef PG8_BAR
#undef PG8_SCHED
}

template <class Epi0, class Epi1, class Sched>
__device__ __forceinline__ void gemm_stream2(PG8_LAS unsigned char* lds, const Gemm2 g, const Sched& S, const Epi0& E0, const Epi1& E1, int tid_in) {
    static_assert(Epi0::PERM == Epi1::PERM && !Epi0::AFTER_DRAIN && !Epi1::AFTER_DRAIN, "gemm_stream2: same accumulator layout, in-loop epilogues");
    int tid_ = tid_in; asm volatile("" : "+v"(tid_));
    const int tid = tid_, wid = __builtin_amdgcn_readfirstlane(tid >> 6), lane = tid & 63, wr = wid >> 2, wc = wid & 3, fr = lane & 15, fq = lane >> 4;
    int rA[2], rB[2], cC[2];
#pragma unroll
    for (int i = 0; i < 2; ++i) { int R, C; stage_rc(tid * 16 + i * 8192, R, C); rA[i] = R; rB[i] = Epi0::PERM ? ((R & ~31) + perm32(R & 31)) : R; cC[i] = C; }
    const size_t kstep = (size_t)(BK * 2);
    const size_t kstepB = (size_t)(BM * BK * 2), hstepB = (size_t)(HALF * BK * 2);
    const unsigned ldsw = (unsigned)wid * 1024u;
    const int aoff = lds_byte(wr * 64 + fr, fq * 8), boff = lds_byte(wc * 32 + fr, fq * 8);
#define PG8_SA(b, h) (((b) * 2 + (h)) * HTB)
#define PG8_SB(b, h) ((4 + (b) * 2 + (h)) * HTB)
#define PG8_STAGE(bufoff, gbase, voff) do { _Pragma("unroll") for (int _i = 0; _i < 2; ++_i) \
        __builtin_amdgcn_global_load_lds((const unsigned*)((const char*)(gbase) + (voff)[_i]), (PG8_LAS unsigned*)(lds + (bufoff) + ldsw + _i * 8192), 16, 0, 0); } while (0)
#define PG8_LDA(dst, b, h) do { _Pragma("unroll") for (int m = 0; m < 4; ++m) _Pragma("unroll") for (int k = 0; k < 2; ++k) dst[m][k] = *(const PG8_LAS bf16x8*)(lds + PG8_SA(b, h) + aoff + m * 2048 + k * 1024); } while (0)
#define PG8_LDB(dst, b, h) do { _Pragma("unroll") for (int n = 0; n < 2; ++n) _Pragma("unroll") for (int k = 0; k < 2; ++k) dst[n][k] = *(const PG8_LAS bf16x8*)(lds + PG8_SB(b, h) + boff + n * 2048 + k * 1024); } while (0)
#define PG8_MMA(ai, bj, At, Bt) do { __builtin_amdgcn_s_setprio(1); _Pragma("unroll") for (int m = 0; m < 4; ++m) _Pragma("unroll") for (int n = 0; n < 2; ++n) _Pragma("unroll") for (int k = 0; k < 2; ++k) \
        acc[ai][bj][m][n] = __builtin_amdgcn_mfma_f32_16x16x32_bf16(Bt[n][k], At[m][k], acc[ai][bj][m][n], 0, 0, 0); __builtin_amdgcn_s_setprio(0); } while (0)
#define PG8_WAIT_V(n) asm volatile("s_waitcnt vmcnt(" #n ")" ::: "memory")
#define PG8_WAIT_L(n) asm volatile("s_waitcnt lgkmcnt(" #n ")" ::: "memory")
#define PG8_BAR __builtin_amdgcn_s_barrier()
#define PG8_SCHED __builtin_amdgcn_sched_barrier(0)
    Unit cur, nxt; int ui = 0;
    if (!S.next(0, cur)) return;
    f32x4 acc[2][2][4][2];
#pragma unroll
    for (int a = 0; a < 2; ++a)
#pragma unroll
        for (int b = 0; b < 2; ++b)
#pragma unroll
            for (int m = 0; m < 4; ++m)
#pragma unroll
                for (int n = 0; n < 2; ++n) acc[a][b][m][n] = (f32x4){0.f, 0.f, 0.f, 0.f};
    bf16x8 At[4][2], B0[2][2], B1[2][2];
    int Kc = cur.g ? g.K[1] : g.K[0];
    size_t hsc = (size_t)HALF * Kc * 2;
    const char* cA = (const char*)(cur.g ? g.A[1] : g.A[0]) + (size_t)cur.pm * 2 * hsc; const char* cB = (const char*)(cur.g ? g.Bt[1] : g.Bt[0]) + (size_t)cur.pn * 2 * hsc;
    unsigned vAc[2], vBc[2];
#pragma unroll
    for (int i = 0; i < 2; ++i) { vAc[i] = (unsigned)(rA[i] * Kc + cC[i]) * 2u; vBc[i] = (unsigned)(rB[i] * BK + cC[i]) * 2u; }
    PG8_STAGE(PG8_SB(0, 0), cB, vBc); PG8_STAGE(PG8_SB(0, 1), cB + hstepB, vBc); PG8_STAGE(PG8_SA(0, 0), cA, vAc); PG8_STAGE(PG8_SA(0, 1), cA + hsc, vAc);
    if (wr == 1) PG8_BAR;
    PG8_WAIT_V(2); PG8_BAR;
    PG8_STAGE(PG8_SB(1, 0), cB + kstepB, vBc); PG8_STAGE(PG8_SA(1, 0), cA + kstep, vAc); PG8_STAGE(PG8_SB(1, 1), cB + hstepB + kstepB, vBc);
    PG8_WAIT_V(6); PG8_BAR;
    for (;;) {
        const bool has_next = S.next(ui + 1, nxt);
        const int Kn = has_next ? (nxt.g ? g.K[1] : g.K[0]) : Kc;
        const size_t hsn = (size_t)HALF * Kn * 2;
        const char* nA = has_next ? (const char*)(nxt.g ? g.A[1] : g.A[0]) + (size_t)nxt.pm * 2 * hsn : cA; const char* nB = has_next ? (const char*)(nxt.g ? g.Bt[1] : g.Bt[0]) + (size_t)nxt.pn * 2 * hsn : cB;
        unsigned vAn[2], vBn[2];
#pragma unroll
        for (int i = 0; i < 2; ++i) { vAn[i] = (unsigned)(rA[i] * Kn + cC[i]) * 2u; vBn[i] = (unsigned)(rB[i] * BK + cC[i]) * 2u; }
        const int nt = Kc / BK;
        for (int t = 0; t < nt; t += 2) {
            const bool last = (t == nt - 2);
            const char* a1 = cA + (size_t)(t + 1) * kstep;
            const char* a2 = last ? nA : cA + (size_t)(t + 2) * kstep; const char* b2 = last ? nB : cB + (size_t)(t + 2) * kstepB;
            const char* a3 = a2 + kstep; const char* b3 = b2 + kstepB;
            const size_t hs2 = last ? hsn : hsc;
            unsigned vA2[2], vB2[2];
#pragma unroll
            for (int i = 0; i < 2; ++i) { vA2[i] = last ? vAn[i] : vAc[i]; vB2[i] = last ? vBn[i] : vBc[i]; }
            PG8_LDB(B0, 0, 0); PG8_LDB(B1, 0, 1); PG8_SCHED; PG8_LDA(At, 0, 0); PG8_STAGE(PG8_SA(1, 1), a1 + hsc, vAc);
            PG8_WAIT_V(8); PG8_WAIT_L(0); PG8_BAR; PG8_MMA(0, 0, At, B0); PG8_MMA(0, 1, At, B1); PG8_BAR; PG8_SCHED;
            PG8_LDA(At, 0, 1); PG8_STAGE(PG8_SB(0, 0), b2, vB2); PG8_STAGE(PG8_SB(0, 1), b2 + hstepB, vB2); PG8_STAGE(PG8_SA(0, 0), a2, vA2);
            PG8_WAIT_V(8); PG8_WAIT_L(0); PG8_BAR; PG8_MMA(1, 0, At, B0); PG8_MMA(1, 1, At, B1); PG8_BAR; PG8_SCHED;
            PG8_LDB(B0, 1, 0); PG8_LDB(B1, 1, 1); PG8_SCHED; PG8_LDA(At, 1, 0); PG8_STAGE(PG8_SA(0, 1), a2 + hs2, vA2);
            PG8_WAIT_V(8); PG8_WAIT_L(0); PG8_BAR; PG8_MMA(0, 0, At, B0); PG8_MMA(0, 1, At, B1); PG8_BAR; PG8_SCHED;
            PG8_LDA(At, 1, 1); PG8_STAGE(PG8_SB(1, 0), b3, vB2); PG8_STAGE(PG8_SB(1, 1), b3 + hstepB, vB2); PG8_STAGE(PG8_SA(1, 0), a3, vA2);
            PG8_WAIT_V(8); PG8_WAIT_L(0); PG8_BAR; PG8_MMA(1, 0, At, B0); PG8_MMA(1, 1, At, B1); PG8_BAR; PG8_SCHED;
        }
        if (wr == 0) PG8_BAR;
        if (cur.g == 0) E0(acc, cur, wr, wc, fr, fq); else E1(acc, cur, wr, wc, fr, fq);
        if (!has_next) break;
#pragma unroll
        for (int a = 0; a < 2; ++a)
#pragma unroll
            for (int b = 0; b < 2; ++b)
#pragma unroll
                for (int m = 0; m < 4; ++m)
#pragma unroll
                    for (int n = 0; n < 2; ++n) acc[a][b][m][n] = (f32x4){0.f, 0.f, 0.f, 0.f};
        cur = nxt; cA = nA; cB = nB; Kc = Kn; hsc = hsn; ++ui;
#pragma unroll
        for (int i = 0; i < 2; ++i) { vAc[i] = vAn[i]; vBc[i] = vBn[i]; }
        if (wr == 1) PG8_BAR;
    }
    PG8_WAIT_V(0);
    PG8_BAR;
#undef PG8_SA
#undef PG8_SB
#undef PG8_STAGE
#undef PG8_LDA
#undef PG8_LDB
#undef PG8_MMA
#undef PG8_WAIT_V
#undef PG8_WAIT_L
#undef PG8_BAR
#undef PG8_SCHED
}
}
namespace pg8 {
typedef unsigned u32x2 __attribute__((ext_vector_type(2)));
__device__ __forceinline__ float bf_lo(unsigned w) { return __builtin_bit_cast(float, w << 16); }
__device__ __forceinline__ float bf_hi(unsigned w) { return __builtin_bit_cast(float, w & 0xffff0000u); }
__device__ __forceinline__ float sigm_l2(float y) { return __builtin_amdgcn_rcpf(1.0f + __builtin_amdgcn_exp2f(y)); }
__device__ __forceinline__ float sigm(float x) { return __builtin_amdgcn_rcpf(1.0f + __expf(-x)); }

__device__ __forceinline__ float row_rstd(const float* ssq, size_t row) {
    const f32x4 a = *(const f32x4*)(ssq + row * 16), b = *(const f32x4*)(ssq + row * 16 + 4), c = *(const f32x4*)(ssq + row * 16 + 8), d = *(const f32x4*)(ssq + row * 16 + 12);
    const float s = ((a.x + a.y) + (a.z + a.w)) + ((b.x + b.y) + (b.z + b.w)) + ((c.x + c.y) + (c.z + c.w)) + ((d.x + d.y) + (d.z + d.w));
    return 1.0f / sqrtf(s * (1.0f / 1024.0f) + 1e-6f);
}
constexpr int RSTD_CAP = 12;
struct RstdTab { const PG8_LAS float* tab;
    __device__ __forceinline__ float get(const Unit& u, int lrow) const { return tab[u.idx * 256 + lrow]; } };
struct EpiProj {
    static constexpr bool PERM = true, AFTER_DRAIN = false;
    bf16_t *U, *Q, *KV, *QKG, *VG, *RG; float* SMALL; const float* rope; RstdTab RS; int Mrows; bf16_t *VST, *VWT; int seq;
    __device__ __forceinline__ void operator()(const f32x4 (&acc)[2][2][4][2], const Unit& u, int wr, int wc, int fr, int fq) const {
        const int pn = u.pn, row0 = u.pm * BM + wr * 64 + fr;
        if (pn == 13) {
            if (wc < 2) {
#pragma unroll
                for (int ai = 0; ai < 2; ++ai)
#pragma unroll
                    for (int m = 0; m < 4; ++m) { const size_t row = (size_t)(row0 + ai * HALF + m * 16); const float rs = RS.get(u, wr * 64 + fr + ai * HALF + m * 16); float* rp = SMALL + row * 64 + wc * 32 + 8 * fq;
                        *(f32x4*)rp = acc[ai][0][m][0] * rs; *(f32x4*)(rp + 4) = acc[ai][0][m][1] * rs; }
            }
            return;
        }
        bf16_t* base; int ld, colt; bool isq = false, iskv = false;
        if (pn < 2) { base = U; ld = 512; colt = pn * 256; }
        else if (pn < 4) { base = Q; ld = 512; colt = (pn - 2) * 256; isq = true; }
        else if (pn < 7) { base = KV; ld = 768; colt = (pn - 4) * 256; iskv = true; }
        else if (pn < 9) { base = QKG; ld = 512; colt = (pn - 7) * 256; }
        else if (pn < 11) { base = VG; ld = 512; colt = (pn - 9) * 256; }
        else { base = RG; ld = 512; colt = (pn - 11) * 256; }
        const int col0 = colt + wc * 32 + 8 * fq;
        const float sc = isq ? 0.125f * 1.4426950408889634f : 1.0f;
        const bool ropew = (isq || iskv) && ((wc & 1) == 0);
#pragma unroll
        for (int ap = 0; ap < 4; ++ap) {
            const int ai = ap >> 1;
            f32x4 rc[2][4];
#pragma unroll
            for (int mm = 0; mm < 2; ++mm)
#pragma unroll
                for (int q = 0; q < 4; ++q) rc[mm][q] = (ropew && fq < 2) ? *(const f32x4*)(rope + (size_t)(row0 + ai * HALF + (2 * (ap & 1) + mm) * 16) * 16 + 4 * q) : (f32x4){0.f, 0.f, 0.f, 0.f};
            float rsr[2];
#pragma unroll
            for (int mm = 0; mm < 2; ++mm) rsr[mm] = RS.get(u, wr * 64 + fr + ai * HALF + (2 * (ap & 1) + mm) * 16) * sc;
#pragma unroll
            for (int mm = 0; mm < 2; ++mm) {
                const int m = 2 * (ap & 1) + mm;
                const int row = row0 + ai * HALF + m * 16;
                bf16_t* rowp = base + (size_t)row * ld + col0;
#pragma unroll
                for (int bj = 0; bj < 2; ++bj) {
                    f32x4 v0 = acc[ai][bj][m][0] * rsr[mm], v1 = acc[ai][bj][m][1] * rsr[mm];
                    if (ropew && (isq || bj == 0)) {
                        f32x4 o0, o1;
#pragma unroll
                        for (int e = 0; e < 4; ++e) { o0[e] = __shfl_xor(v0[e], 16); o1[e] = __shfl_xor(v1[e], 16); }
                        if (fq < 2) {
                            const float sg = (fq == 0) ? -1.0f : 1.0f;
                            v0 = v0 * rc[mm][0] + (o0 * rc[mm][2]) * sg; v1 = v1 * rc[mm][1] + (o1 * rc[mm][3]) * sg;
                        }
                    }
                    u32x4 w; w.x = cvt_pk_bf16(v0[0], v0[1]); w.y = cvt_pk_bf16(v0[2], v0[3]); w.z = cvt_pk_bf16(v1[0], v1[1]); w.w = cvt_pk_bf16(v1[2], v1[3]);
                    if (iskv && bj == 1 && pn >= 5) {
                        const int bb = row / seq, tl = row - bb * seq;
                        bf16_t* vt = (pn == 5 ? VST : VWT) + ((size_t)((bb * 2 + (wc >> 1)) * (seq >> 6) + (tl >> 6)) * 64 + 32 * (wc & 1) + 8 * fq) * 64 + (tl & 63);
                        vt[0 * 64] = (bf16_t)(w.x & 0xffffu); vt[1 * 64] = (bf16_t)(w.x >> 16); vt[2 * 64] = (bf16_t)(w.y & 0xffffu); vt[3 * 64] = (bf16_t)(w.y >> 16);
                        vt[4 * 64] = (bf16_t)(w.z & 0xffffu); vt[5 * 64] = (bf16_t)(w.z >> 16); vt[6 * 64] = (bf16_t)(w.w & 0xffffu); vt[7 * 64] = (bf16_t)(w.w >> 16); }
                    else if (iskv) *(u32x4*)(KV + ((size_t)((2 * (pn - 4) + bj) * 2 + (wc >> 1)) * Mrows + row) * 64 + 32 * (wc & 1) + 8 * fq) = w;
                    else *(u32x4*)(rowp + bj * HALF) = w;
                }
            }
        }
    }
};

template <int FN> struct EpiAct {
    static constexpr bool PERM = true, AFTER_DRAIN = false;
    bf16_t* O; int ldc;
    __device__ __forceinline__ void operator()(const f32x4 (&acc)[2][2][4][2], const Unit& u, int wr, int wc, int fr, int fq) const {
        const int row0 = u.pm * BM + wr * 64 + fr, col0 = u.pn * BM + wc * 32 + 8 * fq;
#pragma unroll
        for (int ai = 0; ai < 2; ++ai)
#pragma unroll
            for (int m = 0; m < 4; ++m) { bf16_t* rowp = O + (size_t)(row0 + ai * HALF + m * 16) * ldc + col0;
#pragma unroll
                for (int bj = 0; bj < 2; ++bj) { f32x4 v0 = acc[ai][bj][m][0], v1 = acc[ai][bj][m][1];
                    if (FN == 1) {
#pragma unroll
                        for (int e = 0; e < 4; ++e) { v0[e] = sigm(v0[e]); v1[e] = sigm(v1[e]); } }
                    if (FN == 2) {
#pragma unroll
                        for (int e = 0; e < 4; ++e) { const float a = fmaxf(v0[e], 0.f), b = fmaxf(v1[e], 0.f); v0[e] = a * a; v1[e] = b * b; } }
                    u32x4 w; w.x = cvt_pk_bf16(v0[0], v0[1]); w.y = cvt_pk_bf16(v0[2], v0[3]); w.z = cvt_pk_bf16(v1[0], v1[1]); w.w = cvt_pk_bf16(v1[2], v1[3]);
                    *(u32x4*)(rowp + bj * HALF) = w; } }
    }
};

template <bool FIRST> struct EpiBranch {
    static constexpr bool PERM = true, AFTER_DRAIN = false;
    bf16_t* MG; const bf16_t* GM; int kofs;
    __device__ __forceinline__ void operator()(const f32x4 (&acc)[2][2][4][2], const Unit& u, int wr, int wc, int fr, int fq) const {
        const int row0 = u.pm * BM + wr * 64 + fr, col0 = u.pn * BM + wc * 32 + 8 * fq;
#pragma unroll
        for (int ai = 0; ai < 2; ++ai) {
            u32x4 gw[4][2], ow[4][2];
#pragma unroll
            for (int m = 0; m < 4; ++m)
#pragma unroll
                for (int bj = 0; bj < 2; ++bj) { const size_t row = (size_t)(row0 + ai * HALF + m * 16);
                    gw[m][bj] = *(const u32x4*)(GM + row * 3072 + kofs + col0 + bj * HALF);
                    if (!FIRST) ow[m][bj] = *(const u32x4*)(MG + row * 1024 + col0 + bj * HALF); }
#pragma unroll
            for (int m = 0; m < 4; ++m)
#pragma unroll
                for (int bj = 0; bj < 2; ++bj) { const size_t row = (size_t)(row0 + ai * HALF + m * 16);
                    f32x4 v0 = acc[ai][bj][m][0], v1 = acc[ai][bj][m][1]; const u32x4 g = gw[m][bj];
                    v0[0] *= bf_lo(g.x); v0[1] *= bf_hi(g.x); v0[2] *= bf_lo(g.y); v0[3] *= bf_hi(g.y);
                    v1[0] *= bf_lo(g.z); v1[1] *= bf_hi(g.z); v1[2] *= bf_lo(g.w); v1[3] *= bf_hi(g.w);
                    if (!FIRST) { const u32x4 o = ow[m][bj];
                        v0[0] += bf_lo(o.x); v0[1] += bf_hi(o.x); v0[2] += bf_lo(o.y); v0[3] += bf_hi(o.y);
                        v1[0] += bf_lo(o.z); v1[1] += bf_hi(o.z); v1[2] += bf_lo(o.w); v1[3] += bf_hi(o.w); }
                    u32x4 w; w.x = cvt_pk_bf16(v0[0], v0[1]); w.y = cvt_pk_bf16(v0[2], v0[3]); w.z = cvt_pk_bf16(v1[0], v1[1]); w.w = cvt_pk_bf16(v1[2], v1[3]);
                    *(u32x4*)(MG + row * 1024 + col0 + bj * HALF) = w; }
        }
    }
};

struct BranchOrder {
    StaticOrder S0; int per, nM;
    __device__ __forceinline__ void init(int M, int N, int G, int c) { S0.init(M, N, G, c); nM = M / BM; per = 0; Unit u; while (S0.next(per, u)) ++per; }
    __device__ __forceinline__ bool next(int i, Unit& u) const {
        if (i >= 3 * per) return false;
        const int k = (i >= 2 * per) ? 2 : ((i >= per) ? 1 : 0);
        if (!S0.next(i - k * per, u)) return false;
        u.pm += k * nM; u.pn += 4 * k; u.idx = i; return true;
    }
    __device__ __forceinline__ void a_ready(const Unit&) const {}
    __device__ __forceinline__ void done(const Unit&) const {}
};
struct GateBranchOrder {
    StaticOrder S0; int per, nM;
    __device__ __forceinline__ void init(int M, int N, int G, int c) { S0.init(M, N, G, c); nM = M / BM; per = 0; Unit u; while (S0.next(per, u)) ++per; }
    __device__ __forceinline__ bool next(int i, Unit& u) const {
        if (i >= 6 * per) return false;
        const int j = i / 6, r = i - 6 * j, k = r >> 1;
        if (!S0.next(j, u)) return false;
        if (r & 1) { u.g = 1; u.pm += k * nM; u.pn += 4 * k; u.idx = i; }
        else { u.g = 0; u.pn += 4 * k; u.idx = j; }
        return true;
    }
};
struct PlePairOrder {
    StaticOrder S0; int per;
    __device__ __forceinline__ void init(int M, int N, int G, int c) { S0.init(M, N, G, c); per = 0; Unit u; while (S0.next(per, u)) ++per; }
    __device__ __forceinline__ bool next(int i, Unit& u) const {
        if (i >= 2 * per) return false;
        const int j = i >> 1;
        if (!S0.next(j, u)) return false;
        u.g = i & 1; u.idx = j; return true;
    }
};
struct EpiTile {
    static constexpr bool PERM = true, AFTER_DRAIN = false;
    bf16_t* T;
    __device__ __forceinline__ void operator()(const f32x4 (&acc)[2][2][4][2], const Unit& u, int wr, int wc, int fr, int fq) const {
        int lofs = (wr * 64 + fr) * 256 + wc * 32 + 8 * fq; asm volatile("" : "+v"(lofs));
#pragma unroll
        for (int ai = 0; ai < 2; ++ai)
#pragma unroll
            for (int m = 0; m < 4; ++m)
#pragma unroll
                for (int bj = 0; bj < 2; ++bj) { const f32x4 v0 = acc[ai][bj][m][0], v1 = acc[ai][bj][m][1];
                    u32x4 w; w.x = cvt_pk_bf16(v0[0], v0[1]); w.y = cvt_pk_bf16(v0[2], v0[3]); w.z = cvt_pk_bf16(v1[0], v1[1]); w.w = cvt_pk_bf16(v1[2], v1[3]);
                    *(u32x4*)(T + lofs + (ai * HALF + m * 16) * 256 + bj * HALF) = w; }
    }
};
struct EpiBranchR {
    static constexpr bool PERM = true, AFTER_DRAIN = false;
    bf16_t* MG; const bf16_t* GM; bf16_t* PS; int nM;
    __device__ __forceinline__ void operator()(const f32x4 (&acc)[2][2][4][2], const Unit& u, int wr, int wc, int fr, int fq) const {
        const int k = (u.pm >= 2 * nM) ? 2 : ((u.pm >= nM) ? 1 : 0), pm = u.pm - k * nM, pn = u.pn - 4 * k;
        const int row0 = pm * BM + wr * 64 + fr, col0 = pn * BM + wc * 32 + 8 * fq;
        int lofs = (wr * 64 + fr) * 256 + wc * 32 + 8 * fq; asm volatile("" : "+v"(lofs));
        int mofs = (wr * 64 + fr) * BK + (wc & 1) * 32 + 8 * fq + (wc >> 1) * (BM * BK); asm volatile("" : "+v"(mofs));
#pragma unroll
        for (int ai = 0; ai < 2; ++ai) {
            u32x4 gw[4][2], ow[4][2];
#pragma unroll
            for (int m = 0; m < 4; ++m)
#pragma unroll
                for (int bj = 0; bj < 2; ++bj) { const size_t row = (size_t)(row0 + ai * HALF + m * 16);
                    gw[m][bj] = *(const u32x4*)(GM + lofs + (ai * HALF + m * 16) * 256 + bj * HALF);
                    ow[m][bj] = (k != 0) ? *(const u32x4*)(PS + lofs + (ai * HALF + m * 16) * 256 + bj * HALF) : (u32x4){0u, 0u, 0u, 0u}; }
#pragma unroll
            for (int m = 0; m < 4; ++m)
#pragma unroll
                for (int bj = 0; bj < 2; ++bj) { const size_t row = (size_t)(row0 + ai * HALF + m * 16);
                    f32x4 v0 = acc[ai][bj][m][0], v1 = acc[ai][bj][m][1]; const u32x4 g = gw[m][bj], o = ow[m][bj];
                    v0[0] = v0[0] * bf_lo(g.x) + bf_lo(o.x); v0[1] = v0[1] * bf_hi(g.x) + bf_hi(o.x); v0[2] = v0[2] * bf_lo(g.y) + bf_lo(o.y); v0[3] = v0[3] * bf_hi(g.y) + bf_hi(o.y);
                    v1[0] = v1[0] * bf_lo(g.z) + bf_lo(o.z); v1[1] = v1[1] * bf_hi(g.z) + bf_hi(o.z); v1[2] = v1[2] * bf_lo(g.w) + bf_lo(o.w); v1[3] = v1[3] * bf_hi(g.w) + bf_hi(o.w);
                    u32x4 w; w.x = cvt_pk_bf16(v0[0], v0[1]); w.y = cvt_pk_bf16(v0[2], v0[3]); w.z = cvt_pk_bf16(v1[0], v1[1]); w.w = cvt_pk_bf16(v1[2], v1[3]);
                    if (k == 2) *(u32x4*)(MG + (size_t)pm * (1024 * BM) + (size_t)(pn * 4 + bj * 2) * (BM * BK) + mofs + (ai * HALF + m * 16) * BK) = w; else *(u32x4*)(PS + lofs + (ai * HALF + m * 16) * 256 + bj * HALF) = w; }
        }
    }
};

struct EpiRes {
    static constexpr bool PERM = false, AFTER_DRAIN = false;
    const float* in; float* out;
    __device__ __forceinline__ void operator()(const f32x4 (&acc)[2][2][4][2], const Unit& u, int wr, int wc, int fr, int fq) const {
        const int row0 = u.pm * BM + wr * 64 + fr, col0 = u.pn * BM + wc * 32 + 4 * fq;
#pragma unroll
        for (int ai = 0; ai < 2; ++ai)
#pragma unroll
            for (int m = 0; m < 4; ++m) { const size_t off = (size_t)(row0 + ai * HALF + m * 16) * 1024 + col0;
#pragma unroll
                for (int bj = 0; bj < 2; ++bj)
#pragma unroll
                    for (int n = 0; n < 2; ++n) { const f32x4 b = *(const f32x4*)(in + off + bj * HALF + n * 16); *(f32x4*)(out + off + bj * HALF + n * 16) = b + acc[ai][bj][m][n]; } }
    }
};

struct EpiPle {
    static constexpr bool PERM = false, AFTER_DRAIN = false;
    float* h; const bf16_t* PP;
    __device__ __forceinline__ void operator()(const f32x4 (&acc)[2][2][4][2], const Unit& u, int wr, int wc, int fr, int fq) const {
        const int row0 = u.pm * BM + wr * 64 + fr, col0 = u.pn * BM + wc * 32 + 4 * fq;
#pragma unroll
        for (int ai = 0; ai < 2; ++ai)
#pragma unroll
            for (int m = 0; m < 4; ++m) { const size_t off = (size_t)(row0 + ai * HALF + m * 16) * 1024 + col0;
#pragma unroll
                for (int bj = 0; bj < 2; ++bj)
#pragma unroll
                    for (int n = 0; n < 2; ++n) { const size_t o = off + bj * HALF + n * 16; const u32x2 pw = *(const u32x2*)(PP + o); const f32x4 b = *(const f32x4*)(h + o); const f32x4 a = acc[ai][bj][m][n];
                        f32x4 r; r[0] = b[0] + sigm(a[0]) * bf_lo(pw.x); r[1] = b[1] + sigm(a[1]) * bf_hi(pw.x); r[2] = b[2] + sigm(a[2]) * bf_lo(pw.y); r[3] = b[3] + sigm(a[3]) * bf_hi(pw.y);
                        *(f32x4*)(h + o) = r; } }
    }
};
struct EpiResN {
    static constexpr bool PERM = false, AFTER_DRAIN = false;
    const float* in; float* out; bf16_t* HB; float* SSQ;
    __device__ __forceinline__ void operator()(const f32x4 (&acc)[2][2][4][2], const Unit& u, int wr, int wc, int fr, int fq) const {
        const int row0 = u.pm * BM + wr * 64 + fr, col0 = u.pn * BM + wc * 32 + 4 * fq;
#pragma unroll
        for (int ai = 0; ai < 2; ++ai) {
            f32x4 iv[4][2][2];
#pragma unroll
            for (int m = 0; m < 4; ++m)
#pragma unroll
                for (int bj = 0; bj < 2; ++bj)
#pragma unroll
                    for (int n = 0; n < 2; ++n) iv[m][bj][n] = *(const f32x4*)(in + (size_t)(row0 + ai * HALF + m * 16) * 1024 + col0 + bj * HALF + n * 16);
#pragma unroll
            for (int m = 0; m < 4; ++m) { const size_t row = (size_t)(row0 + ai * HALF + m * 16); const size_t off = row * 1024 + col0; float ss = 0.f;
#pragma unroll
                for (int bj = 0; bj < 2; ++bj)
#pragma unroll
                    for (int n = 0; n < 2; ++n) { const size_t o = off + bj * HALF + n * 16; const f32x4 v = iv[m][bj][n] + acc[ai][bj][m][n]; *(f32x4*)(out + o) = v;
                        u32x2 w; w.x = cvt_pk_bf16(v[0], v[1]); w.y = cvt_pk_bf16(v[2], v[3]); *(u32x2*)(HB + o) = w;
                        ss += (v[0] * v[0] + v[1] * v[1]) + (v[2] * v[2] + v[3] * v[3]); }
                ss += __shfl_xor(ss, 16); ss += __shfl_xor(ss, 32);
                if (fq == 0) SSQ[row * 16 + u.pn * 4 + wc] = ss; }
        }
    }
};
template <bool NORS> struct EpiRelu2NT {
    static constexpr bool PERM = true, AFTER_DRAIN = false;
    bf16_t* O; int ldc; RstdTab RS;
    __device__ __forceinline__ void operator()(const f32x4 (&acc)[2][2][4][2], const Unit& u, int wr, int wc, int fr, int fq) const {
        const int row0 = u.pm * BM + wr * 64 + fr, col0 = u.pn * BM + wc * 32 + 8 * fq;
#pragma unroll
        for (int ai = 0; ai < 2; ++ai) {
            float rs[4];
#pragma unroll
            for (int m = 0; m < 4; ++m) rs[m] = NORS ? 1.0f : RS.get(u, wr * 64 + fr + ai * HALF + m * 16);
#pragma unroll
            for (int m = 0; m < 4; ++m) { bf16_t* rowp = O + (size_t)u.pm * ((size_t)ldc * BM) + (size_t)(u.pn * 4 + (wc >> 1)) * (BM * BK) + (wr * 64 + fr + ai * HALF + m * 16) * BK + (wc & 1) * 32 + 8 * fq;
#pragma unroll
                for (int bj = 0; bj < 2; ++bj) { f32x4 v0 = acc[ai][bj][m][0] * rs[m], v1 = acc[ai][bj][m][1] * rs[m];
#pragma unroll
                    for (int e = 0; e < 4; ++e) { v0[e] = fmaxf(v0[e], 0.f); v1[e] = fmaxf(v1[e], 0.f); }
                    v0 = v0 * v0; v1 = v1 * v1;
                    u32x4 w; w.x = cvt_pk_bf16(v0[0], v0[1]); w.y = cvt_pk_bf16(v0[2], v0[3]); w.z = cvt_pk_bf16(v1[0], v1[1]); w.w = cvt_pk_bf16(v1[2], v1[3]);
                    *(u32x4*)(rowp + bj * (2 * BM * BK)) = w; } }
        }
    }
};
typedef EpiRelu2NT<false> EpiRelu2N;
struct EpiPleN {
    static constexpr bool PERM = false, AFTER_DRAIN = false;
    float* h; const bf16_t* PP; const float* SSQ;
    __device__ __forceinline__ void operator()(const f32x4 (&acc)[2][2][4][2], const Unit& u, int wr, int wc, int fr, int fq) const {
        const int row0 = u.pm * BM + wr * 64 + fr, col0 = u.pn * BM + wc * 32 + 4 * fq;
#pragma unroll
        for (int ai = 0; ai < 2; ++ai)
#pragma unroll
            for (int mp = 0; mp < 2; ++mp) {
                float rs[2]; f32x4 hv[2][2][2]; u32x2 pw[2][2][2];
#pragma unroll
                for (int mm = 0; mm < 2; ++mm) { const size_t row = (size_t)(row0 + ai * HALF + (2 * mp + mm) * 16); rs[mm] = row_rstd(SSQ, row);
#pragma unroll
                    for (int bj = 0; bj < 2; ++bj)
#pragma unroll
                        for (int n = 0; n < 2; ++n) { const size_t o = row * 1024 + col0 + bj * HALF + n * 16; hv[mm][bj][n] = *(const f32x4*)(h + o); pw[mm][bj][n] = *(const u32x2*)(PP + o); } }
#pragma unroll
                for (int mm = 0; mm < 2; ++mm) { const int m = 2 * mp + mm; const size_t row = (size_t)(row0 + ai * HALF + m * 16);
#pragma unroll
                    for (int bj = 0; bj < 2; ++bj)
#pragma unroll
                        for (int n = 0; n < 2; ++n) { const size_t o = row * 1024 + col0 + bj * HALF + n * 16; const f32x4 a = acc[ai][bj][m][n] * rs[mm], b = hv[mm][bj][n]; const u32x2 p = pw[mm][bj][n];
                            f32x4 r; r[0] = b[0] + sigm(a[0]) * bf_lo(p.x); r[1] = b[1] + sigm(a[1]) * bf_hi(p.x); r[2] = b[2] + sigm(a[2]) * bf_lo(p.y); r[3] = b[3] + sigm(a[3]) * bf_hi(p.y);
                            *(f32x4*)(h + o) = r; } }
            }
    }
};
struct EpiSigN {
    static constexpr bool PERM = true, AFTER_DRAIN = false;
    bf16_t* O; int ldc; RstdTab RS;
    __device__ __forceinline__ void operator()(const f32x4 (&acc)[2][2][4][2], const Unit& u, int wr, int wc, int fr, int fq) const {
        int lofs = (wr * 64 + fr) * 256 + wc * 32 + 8 * fq; asm volatile("" : "+v"(lofs));
#pragma unroll
        for (int ai = 0; ai < 2; ++ai) {
            float rs[4];
#pragma unroll
            for (int m = 0; m < 4; ++m) rs[m] = RS.get(u, wr * 64 + fr + ai * HALF + m * 16) * -1.4426950408889634f;
#pragma unroll
            for (int m = 0; m < 4; ++m) { bf16_t* rowp = O + lofs + (ai * HALF + m * 16) * 256;
#pragma unroll
                for (int bj = 0; bj < 2; ++bj) { f32x4 v0 = acc[ai][bj][m][0] * rs[m], v1 = acc[ai][bj][m][1] * rs[m];
#pragma unroll
                    for (int e = 0; e < 4; ++e) { v0[e] = sigm_l2(v0[e]); v1[e] = sigm_l2(v1[e]); }
                    u32x4 w; w.x = cvt_pk_bf16(v0[0], v0[1]); w.y = cvt_pk_bf16(v0[2], v0[3]); w.z = cvt_pk_bf16(v1[0], v1[1]); w.w = cvt_pk_bf16(v1[2], v1[3]);
                    *(u32x4*)(rowp + bj * HALF) = w; } }
        }
    }
};
template <int MODE, bool MIRROR> struct EpiStream {
    static constexpr bool PERM = true, AFTER_DRAIN = false;
    bf16_t* H; bf16_t* H2; float* SSQo; RstdTab RSi; const bf16_t* PP;
    __device__ __forceinline__ void operator()(const f32x4 (&acc)[2][2][4][2], const Unit& u, int wr, int wc, int fr, int fq) const {
        const int row0 = u.pm * BM + wr * 64 + fr, col0 = u.pn * BM + wc * 32 + 8 * fq;
        int lofs = (wr * 64 + fr) * 256 + wc * 32 + 8 * fq; if (MODE == 1) asm volatile("" : "+v"(lofs));
        constexpr int NB = (MODE == 1) ? 2 : 4;
#pragma unroll
        for (int bt = 0; bt < 8 / NB; ++bt) {
            u32x4 hw[NB][2], pw[NB][2]; float rs[NB];
#pragma unroll
            for (int mm = 0; mm < NB; ++mm) { const int rg = bt * NB + mm, ai = rg >> 2, m = rg & 3; const size_t row = (size_t)(row0 + ai * HALF + m * 16);
                rs[mm] = (MODE == 1) ? RSi.get(u, wr * 64 + fr + ai * HALF + m * 16) * -1.4426950408889634f : 1.0f;
#pragma unroll
                for (int bj = 0; bj < 2; ++bj) { hw[mm][bj] = *(const u32x4*)(H + row * 1024 + col0 + bj * HALF); if (MODE == 1) pw[mm][bj] = *(const u32x4*)(PP + lofs + (ai * HALF + m * 16) * 256 + bj * HALF); } }
#pragma unroll
            for (int mm = 0; mm < NB; ++mm) { const int rg = bt * NB + mm, ai = rg >> 2, m = rg & 3; const size_t row = (size_t)(row0 + ai * HALF + m * 16); float ss = 0.f;
#pragma unroll
                for (int bj = 0; bj < 2; ++bj) { f32x4 v0 = acc[ai][bj][m][0], v1 = acc[ai][bj][m][1]; const u32x4 hh = hw[mm][bj];
                    if (MODE == 1) { const u32x4 p = pw[mm][bj]; v0 = v0 * rs[mm]; v1 = v1 * rs[mm];
                        v0[0] = sigm_l2(v0[0]) * bf_lo(p.x); v0[1] = sigm_l2(v0[1]) * bf_hi(p.x); v0[2] = sigm_l2(v0[2]) * bf_lo(p.y); v0[3] = sigm_l2(v0[3]) * bf_hi(p.y);
                        v1[0] = sigm_l2(v1[0]) * bf_lo(p.z); v1[1] = sigm_l2(v1[1]) * bf_hi(p.z); v1[2] = sigm_l2(v1[2]) * bf_lo(p.w); v1[3] = sigm_l2(v1[3]) * bf_hi(p.w); }
                    v0[0] += bf_lo(hh.x); v0[1] += bf_hi(hh.x); v0[2] += bf_lo(hh.y); v0[3] += bf_hi(hh.y); v1[0] += bf_lo(hh.z); v1[1] += bf_hi(hh.z); v1[2] += bf_lo(hh.w); v1[3] += bf_hi(hh.w);
                    u32x4 w; w.x = cvt_pk_bf16(v0[0], v0[1]); w.y = cvt_pk_bf16(v0[2], v0[3]); w.z = cvt_pk_bf16(v1[0], v1[1]); w.w = cvt_pk_bf16(v1[2], v1[3]);
                    *(u32x4*)((MIRROR ? H2 : H) + row * 1024 + col0 + bj * HALF) = w;
                    const float r0 = bf_lo(w.x), r1 = bf_hi(w.x), r2 = bf_lo(w.y), r3 = bf_hi(w.y), r4 = bf_lo(w.z), r5 = bf_hi(w.z), r6 = bf_lo(w.w), r7 = bf_hi(w.w);
                    ss += ((r0 * r0 + r1 * r1) + (r2 * r2 + r3 * r3)) + ((r4 * r4 + r5 * r5) + (r6 * r6 + r7 * r7)); }
                ss += __shfl_xor(ss, 16); ss += __shfl_xor(ss, 32);
                if (fq == 0) SSQo[row * 16 + u.pn * 4 + wc] = ss; }
        }
    }
};
template <> struct ABlocked<EpiStream<0, true>> { static constexpr bool v = true; };
template <> struct ABlocked<EpiStream<0, false>> { static constexpr bool v = true; };
}
#define GAS __attribute__((address_space(1)))
#define LAS __attribute__((address_space(3)))
typedef unsigned short bf16;
typedef unsigned v4u __attribute__((ext_vector_type(4)));
typedef float f32x4 __attribute__((ext_vector_type(4)));
typedef short bf16x8 __attribute__((ext_vector_type(8)));
typedef GAS unsigned gu32;
typedef GAS unsigned long long gu64;
#define RLX_AGENT __ATOMIC_RELAXED, __HIP_MEMORY_SCOPE_AGENT
#define LDS_WAIT() asm volatile("s_waitcnt lgkmcnt(0)" ::: "memory")
#define VM_WAIT() asm volatile("s_waitcnt vmcnt(0)" ::: "memory")
__device__ __forceinline__ unsigned long long rt() { return __builtin_amdgcn_s_memrealtime(); }
__device__ __forceinline__ unsigned f2bf(float f) { unsigned u = __builtin_bit_cast(unsigned, f); return (u + 0x7fffu + ((u >> 16) & 1u)) >> 16; }
__device__ __forceinline__ unsigned pk2(float lo, float hi) { return f2bf(lo) | (f2bf(hi) << 16); }

#define XB_TMO      128
#define XB_XCNT(j)  (256  + 64 * (j))
#define XB_XSUB(j)  (1280 + 64 * (j))
#define XB_XGEN(j)  (2304 + 64 * (j))
#define XB_TOP      3328
#define XB_TOPGEN   3392
#define XCD_BAR_WORDS 3456
#define XB_SPIN_CAP (1u << 18)

__device__ __forceinline__ unsigned xb_ld(unsigned* p)              { return __hip_atomic_load(p, __ATOMIC_RELAXED, __HIP_MEMORY_SCOPE_AGENT); }
__device__ __forceinline__ unsigned xb_add(unsigned* p, unsigned v) { return __hip_atomic_fetch_add(p, v, __ATOMIC_RELAXED, __HIP_MEMORY_SCOPE_AGENT); }
__device__ __forceinline__ unsigned xb_xcc_id() { return (unsigned)__builtin_amdgcn_s_getreg((3 << 11) | 20) & 0xFu; }
#define XB_SPIN(cond, bar) do { unsigned _sp = 0; while (cond) { __builtin_amdgcn_s_sleep(1); \
    if ((++_sp & 255u) == 0u) { if (xb_ld(&(bar)[XB_TMO])) break; if (_sp > XB_SPIN_CAP) { atomicAdd(&(bar)[XB_TMO], 1u); break; } } } } while (0)

struct XcdBarrier {
    unsigned* bar; unsigned x;
    volatile LAS unsigned* st;
};

__device__ __forceinline__ XcdBarrier xcd_barrier_post(unsigned* bar, volatile LAS unsigned* st) {
    XcdBarrier b; b.bar = bar; b.x = xb_xcc_id(); b.st = st;
    if (threadIdx.x == 0) (void)xb_add(&bar[XB_XCNT(b.x)], 1u);
    return b;
}
__device__ __forceinline__ void xcd_barrier_complete(unsigned* bar, unsigned x, unsigned& nloc, unsigned& nx) {
    const unsigned G = gridDim.x * gridDim.y * gridDim.z;
    unsigned sum, cnt, mine, sp = 0u;
    for (;;) {
        sum = 0u; cnt = 0u; mine = 0u;
#pragma unroll 1
        for (unsigned j = 0; j < 16; ++j) { const unsigned c = xb_ld(&bar[XB_XCNT(j)]); sum += c; cnt += (c > 0u) ? 1u : 0u; mine = (j == x) ? c : mine; }
        if (sum == G) break;
        __builtin_amdgcn_s_sleep(1);
        if ((++sp & 255u) == 0u) { if (xb_ld(&bar[XB_TMO])) break; if (sp > XB_SPIN_CAP) { atomicAdd(&bar[XB_TMO], 1u); break; } }
    }
    nloc = mine > 0u ? mine : 1u; nx = cnt > 0u ? cnt : 1u;
}

__device__ __forceinline__ void xcd_barrier(const XcdBarrier& b) {
    asm volatile("s_waitcnt vmcnt(0)" ::: "memory");
    __syncthreads();
    if (threadIdx.x == 0) {
        unsigned* bar = b.bar;
        __builtin_amdgcn_s_waitcnt(0);
        unsigned nloc = b.st[0], nx = b.st[1];
        if (nloc == 0u) { xcd_barrier_complete(bar, b.x, nloc, nx); b.st[0] = nloc; b.st[1] = nx; }
        const unsigned old = xb_add(&bar[XB_XSUB(b.x)], 1u);
        const unsigned gen = old / nloc;
        if (old + 1u == (gen + 1u) * nloc) {
            __builtin_amdgcn_fence(__ATOMIC_RELEASE, "agent");
            asm volatile("s_waitcnt vmcnt(0)" ::: "memory");
            const unsigned og = xb_add(&bar[XB_TOP], 1u);
            const unsigned tg = og / nx, want = (tg + 1u) * nx;
            if (og + 1u != want) XB_SPIN(xb_ld(&bar[XB_TOP]) < want, bar);
            __builtin_amdgcn_fence(__ATOMIC_ACQUIRE, "agent");
            xb_add(&bar[XB_XGEN(b.x)], 1u);
            asm volatile("s_waitcnt vmcnt(0)" ::: "memory");
        } else {
            XB_SPIN(xb_ld(&bar[XB_XGEN(b.x)]) == gen, bar);
            __builtin_amdgcn_fence(__ATOMIC_ACQUIRE, "agent");
            asm volatile("s_waitcnt vmcnt(0)" ::: "memory");
        }
    }
    __syncthreads();
}
constexpr int NWAVES = 8;
constexpr int BATCH = 2, SEQ = 16384, M = BATCH * SEQ, D = 1024, DEPTH = 2;
constexpr int INW = 6440;
constexpr int NIN = 3584;
constexpr int NGM = 3072, FF = 4096, PLE = 256;
constexpr int NCMP = 1023;
constexpr float EPS = 1e-6f;
#define DI __device__ __forceinline__

constexpr size_t MiB = 1u << 20;
constexpr size_t WS_CTL = 0, CTL_ZERO_BYTES = 1 * MiB;
constexpr size_t WS_ROPE = 1 * MiB;
constexpr size_t WS_KCMP = 3 * MiB, WS_VCMP = 3 * MiB + 512 * 1024;
constexpr size_t WS_DECAY = 4 * MiB;
constexpr size_t WS_W = 8 * MiB;
constexpr size_t W_IN = 0, W_GM = 7 * MiB, W_BR = 13 * MiB, W_O = 16 * MiB, W_1 = 18 * MiB, W_2 = 26 * MiB, W_PG = 34 * MiB, W_PP = 36 * MiB, W_LAYER = 36 * MiB + 512 * 1024;
constexpr size_t WS_A16 = 88 * MiB;
constexpr size_t WS_SMALL = 152 * MiB;
constexpr size_t WS_POOLED = 160 * MiB;
constexpr size_t WS_Q = 192 * MiB;
constexpr size_t WS_RG = 224 * MiB;
constexpr size_t WS_U = 256 * MiB, WS_KV = 288 * MiB, WS_QKG = 336 * MiB, WS_VG = 368 * MiB, WS_GLA = 400 * MiB;
constexpr size_t WS_GM = 256 * MiB;
constexpr size_t WS_HID = 160 * MiB;
constexpr size_t WS_VST = 496 * MiB, WS_VWT = 504 * MiB, WS_VCT = 5 * MiB;
constexpr size_t WS_YP = 464 * MiB;
constexpr size_t WS_WCT = 81 * MiB;
constexpr size_t WS_CPOS = 82 * MiB;
constexpr size_t WS_SSQ0 = 6 * MiB, WS_SSQ1 = 83 * MiB, WS_SSQ2 = 85 * MiB;
constexpr size_t WS_MG = 448 * MiB;
constexpr size_t WS_HB2 = WS_MG;
constexpr size_t WS_PP = 160 * MiB;
constexpr size_t WS_P16 = 416 * MiB;
constexpr size_t WS_END = 512 * MiB;
static_assert(WS_W + 2 * W_LAYER <= WS_A16 && WS_GLA + (size_t)2048 * 8192 * 4 <= WS_END && WS_GM + (size_t)M * NGM * 2 <= WS_HB2 && WS_HID + (size_t)M * FF * 2 <= WS_HB2 && WS_PP + (size_t)M * D * 2 <= WS_END && WS_HB2 + (size_t)M * D * 2 <= WS_END, "d_ws map");
constexpr int CW_BAR = 4096;

constexpr int LDS_BYTES = 147456;
constexpr int LDSCTL_OFF = 0, MISC_OFF = LDSCTL_OFF + 320;
constexpr int RING_OFF = 1024, RING_BYTES = LDS_BYTES - RING_OFF;
static_assert(MISC_OFF + 128 <= RING_OFF && RING_BYTES >= 131072, "LDS map");

typedef const void* __attribute__((address_space(4))) kaptr_t;
DI const void* ka_in(int i) { const kaptr_t* ka = (const kaptr_t*)__builtin_amdgcn_kernarg_segment_ptr(); return (const void*)*(volatile const kaptr_t*)(ka + i); }
#define IN_x ((const float*)ka_in(0))
#define IN_p ((const float*)ka_in(1))
#define IN_positions ((const int*)ka_in(2))
#define IN_norm_mix ((const float*)ka_in(3))
#define IN_w_in ((const float*)ka_in(4))
#define IN_pool_w ((const float*)ka_in(5))
#define IN_pool_scale ((const float*)ka_in(6))
#define IN_cmp_pos_k ((const float*)ka_in(7))
#define IN_cmp_w_k ((const float*)ka_in(8))
#define IN_cmp_pos_v ((const float*)ka_in(9))
#define IN_cmp_w_v ((const float*)ka_in(10))
#define IN_gla_w_gate ((const float*)ka_in(11))
#define IN_gla_b_gate ((const float*)ka_in(12))
#define IN_gla_norm ((const float*)ka_in(13))
#define IN_w_branch ((const float*)ka_in(14))
#define IN_w_out ((const float*)ka_in(15))
#define IN_norm_ffn ((const float*)ka_in(16))
#define IN_w_ff1 ((const float*)ka_in(17))
#define IN_w_ff2 ((const float*)ka_in(18))
#define IN_norm_ple ((const float*)ka_in(19))
#define IN_w_ple_gate ((const float*)ka_in(20))
#define IN_w_ple_proj ((const float*)ka_in(21))
#define IN_norm_final ((const float*)ka_in(22))
DI unsigned char* ws_opaque() { return (unsigned char*)ka_in(24); }
#define OUTP ((float*)ka_in(23))
struct Frame {
    LAS unsigned char* lds;
    volatile LAS unsigned* MISC;
    gu32* ctl;
    int tid, lane, wave, G, bid;
};
DI bf16* wptr_(unsigned char* wsq, int l, size_t off) { return (bf16*)(wsq + WS_W + (size_t)l * W_LAYER + off); }
#define wptr(F, l, off) wptr_(wsq, l, off)
DI float bf2f(bf16 b) { return __builtin_bit_cast(float, (unsigned)b << 16); }
DI void unpack8(const v4u w, float (&f)[8]) { f[0] = pg8::bf_lo(w.x); f[1] = pg8::bf_hi(w.x); f[2] = pg8::bf_lo(w.y); f[3] = pg8::bf_hi(w.y); f[4] = pg8::bf_lo(w.z); f[5] = pg8::bf_hi(w.z); f[6] = pg8::bf_lo(w.w); f[7] = pg8::bf_hi(w.w); }
DI float wave_sum(float v) {
#pragma unroll
    for (int o = 1; o < 64; o <<= 1) v += __shfl_xor(v, o);
    return v;
}
DI float wave_max(float v) {
#pragma unroll
    for (int o = 1; o < 64; o <<= 1) v = fmaxf(v, __shfl_xor(v, o));
    return v;
}

struct TrDesc { const float* W; const float* gain; bf16* WT; int ld, K, Ndst, mapoff; };
DI int map_win(int n) {
    if (n < 1792) return n;
    if (n < 2816) return n + 24;
    if (n < 3328) return n + 40;
    if (n < 3352) return n - 3328 + 1792;
    if (n < 3368) return n - 3352 + 2840;
    return -1;
}
DI void tr_load(const TrDesc& d, int it, int lane, float (&wv)[32]) {
    const int nblk = d.Ndst / 32, kb = it / nblk, nb = it % nblk, k0 = 64 * kb, n0 = 32 * nb;
    const int n = n0 + (lane & 31), sc = d.mapoff < 0 ? map_win(n) : n + d.mapoff;
#pragma unroll
    for (int i = 0; i < 32; ++i) { const int kk = 2 * i + (lane >> 5); wv[i] = sc >= 0 ? d.W[(size_t)(k0 + kk) * d.ld + sc] : 0.f; }
}
DI void tr_store(const TrDesc& d, int it, LAS float* scr, int lane, const float (&wv)[32]) {
    const int nblk = d.Ndst / 32, kb = it / nblk, nb = it % nblk, k0 = 64 * kb, n0 = 32 * nb;
#pragma unroll
    for (int i = 0; i < 32; ++i) { const int kk = 2 * i + (lane >> 5); const float gk = d.gain ? d.gain[k0 + kk] : 1.0f; scr[kk * 33 + (lane & 31)] = wv[i] * gk; }
    LDS_WAIT(); asm volatile("" ::: "memory");
    const int c = lane & 7;
#pragma unroll
    for (int j = 0; j < 4; ++j) { const int nn = (lane >> 3) + 8 * j; const LAS float* s = scr + (8 * c) * 33 + nn;
        v4u o; o.x = pk2(s[0 * 33], s[1 * 33]); o.y = pk2(s[2 * 33], s[3 * 33]); o.z = pk2(s[4 * 33], s[5 * 33]); o.w = pk2(s[6 * 33], s[7 * 33]);
        const int n = n0 + nn;
        if (d.Ndst == 64) *(v4u*)(d.WT + (size_t)n * d.K + k0 + 8 * c) = o;
        else *(v4u*)(d.WT + (size_t)(n >> 8) * ((size_t)256 * d.K) + (size_t)kb * (256 * 64) + (n & 255) * 64 + 8 * c) = o; }
    LDS_WAIT(); asm volatile("" ::: "memory");
}
DI void p0_prologue(Frame& F) {
    unsigned char* const wsq = ws_opaque();
    { constexpr int I_IN = 16 * 112, I_GM = 16 * 96, I_BR = 8 * 32, I_O = 16 * 32, I_1 = 16 * 128, I_2 = 64 * 32, I_PG = 16 * 32, I_PP = 4 * 32, I_CT = 32 * 2;
      constexpr int PER_LAYER = I_IN + I_GM + 2 * I_BR + I_O + I_1 + I_2 + I_PG + I_PP + 2 * I_CT;
      LAS float* scr = (LAS float*)(F.lds + RING_OFF + F.wave * 16384);
      const int gw = F.bid * NWAVES + F.wave, NGW = F.G * NWAVES, lane = F.lane;
      auto desc = [&](int gi, TrDesc& dout, int& rout) {
          const int l = gi / PER_LAYER; int r = gi % PER_LAYER; TrDesc d;
          if (r < I_IN) d = TrDesc{IN_w_in + (size_t)l * D * INW, IN_norm_mix + (size_t)l * D, wptr(F, l, W_IN), INW, D, NIN, -1};
          else if ((r -= I_IN) < I_GM) d = TrDesc{IN_w_in + (size_t)l * D * INW, IN_norm_mix + (size_t)l * D, wptr(F, l, W_GM), INW, D, NGM, 3368};
          else if ((r -= I_GM) < I_BR) d = TrDesc{IN_w_branch + ((size_t)l * 3 + 1) * 512 * D, nullptr, wptr(F, l, W_BR) + (size_t)1 * D * 512, D, 512, D, 0};
          else if ((r -= I_BR) < I_BR) d = TrDesc{IN_w_branch + ((size_t)l * 3 + 2) * 512 * D, nullptr, wptr(F, l, W_BR) + (size_t)2 * D * 512, D, 512, D, 0};
          else if ((r -= I_BR) < I_O) d = TrDesc{IN_w_out + (size_t)l * D * D, nullptr, wptr(F, l, W_O), D, D, D, 0};
          else if ((r -= I_O) < I_1) d = TrDesc{IN_w_ff1 + (size_t)l * D * FF, IN_norm_ffn + (size_t)l * D, wptr(F, l, W_1), FF, D, FF, 0};
          else if ((r -= I_1) < I_2) d = TrDesc{IN_w_ff2 + (size_t)l * FF * D, nullptr, wptr(F, l, W_2), D, FF, D, 0};
          else if ((r -= I_2) < I_PG) d = TrDesc{IN_w_ple_gate + (size_t)l * D * D, IN_norm_ple + (size_t)l * D, wptr(F, l, W_PG), D, D, D, 0};
          else if ((r -= I_PG) < I_PP) d = TrDesc{IN_w_ple_proj + (size_t)l * PLE * D, nullptr, wptr(F, l, W_PP), D, PLE, D, 0};
          else if ((r -= I_PP) < I_CT) d = TrDesc{IN_cmp_w_k + (size_t)l * 2048 * 64, nullptr, ((bf16*)(wsq + WS_WCT)) + (size_t)(l * 2 + 0) * 64 * 2048, 64, 2048, 64, 0};
          else { r -= I_CT; d = TrDesc{IN_cmp_w_v + (size_t)l * 2048 * 64, nullptr, ((bf16*)(wsq + WS_WCT)) + (size_t)(l * 2 + 1) * 64 * 2048, 64, 2048, 64, 0}; }
          dout = d; rout = r;
      };
      float wvA[32], wvB[32]; TrDesc dA, dB; int rA = 0, rB = 0;
      int gi = gw;
      if (gi < DEPTH * PER_LAYER) { desc(gi, dA, rA); tr_load(dA, rA, lane, wvA); }
      for (; gi < DEPTH * PER_LAYER; gi += 2 * NGW) {
          const bool hasB = gi + NGW < DEPTH * PER_LAYER, hasA2 = gi + 2 * NGW < DEPTH * PER_LAYER;
          if (hasB) { desc(gi + NGW, dB, rB); tr_load(dB, rB, lane, wvB); }
          tr_store(dA, rA, scr, lane, wvA);
          if (hasA2) { desc(gi + 2 * NGW, dA, rA); tr_load(dA, rA, lane, wvA); }
          if (hasB) tr_store(dB, rB, scr, lane, wvB);
      } }
    for (int it = F.bid; it < DEPTH * 4 * 16 * 2; it += F.G) {
        const int l = it >> 7, g = (it >> 5) & 3, nb = (it >> 1) & 15, c0 = ((it & 1) * 8 + F.wave) * 8, n = nb * 64 + F.lane;
        const float* pw = IN_pool_w + (((size_t)l * 4 + g) * 128 + c0) * 128; const float* psc = IN_pool_scale + (size_t)l * 512 + g * 128;
        const float* wb = IN_w_branch + (size_t)l * 3 * 512 * D + (size_t)(g * 128) * D + n;
        LAS float* sp = (LAS float*)(F.lds + RING_OFF + F.wave * 16384);
#pragma unroll
        for (int j = 0; j < 4; ++j) ((LAS pg8::f32x4*)sp)[F.lane + 64 * j] = ((const pg8::f32x4*)pw)[F.lane + 64 * j];
        float a[8];
#pragma unroll
        for (int c = 0; c < 8; ++c) a[c] = 0.f;
#pragma unroll 1
        for (int dh = 0; dh < 128; dh += 32) {
            float wv[32];
#pragma unroll
            for (int d = 0; d < 32; ++d) wv[d] = wb[(size_t)(dh + d) * D];
#pragma unroll
            for (int d = 0; d < 32; ++d) wv[d] *= psc[dh + d];
            LDS_WAIT(); asm volatile("" ::: "memory");
#pragma unroll
            for (int d = 0; d < 32; d += 4)
#pragma unroll
                for (int c = 0; c < 8; ++c) { const pg8::f32x4 pv = *(const LAS pg8::f32x4*)(sp + c * 128 + dh + d); a[c] += (pv[0] * wv[d] + pv[1] * wv[d + 1]) + (pv[2] * wv[d + 2] + pv[3] * wv[d + 3]); }
        }
        v4u o; o.x = pk2(a[0], a[1]); o.y = pk2(a[2], a[3]); o.z = pk2(a[4], a[5]); o.w = pk2(a[6], a[7]);
        *(v4u*)(wptr(F, l, W_BR) + (size_t)(n >> 8) * (256 * 512) + (size_t)((g * 128 + c0) >> 6) * (256 * 64) + (n & 255) * 64 + ((g * 128 + c0) & 63)) = o;
        LDS_WAIT(); asm volatile("" ::: "memory");
    }
    for (int o = F.bid; o < 2 * DEPTH * 64; o += F.G) {
        const int l = o >> 7, which = (o >> 6) & 1, e = o & 63;
        const float* Wc = (which ? IN_cmp_w_v : IN_cmp_w_k) + (size_t)l * 2048 * 64; const float* Pc = (which ? IN_cmp_pos_v : IN_cmp_pos_k) + (size_t)l * 2048;
        float a = 0.f;
#pragma unroll
        for (int j = 0; j < 4; ++j) { const int f = F.tid + 512 * j; a += Pc[f] * Wc[(size_t)f * 64 + e]; }
        a = wave_sum(a);
        LAS float* red = (LAS float*)(F.lds + RING_OFF + 131072);
        if (F.lane == 0) red[F.wave] = a;
        __syncthreads();
        if (F.tid == 0) { float t = 0.f;
#pragma unroll
            for (int p = 0; p < 8; ++p) t += red[p];
            ((float*)(wsq + WS_CPOS))[o] = t; }
        __syncthreads();
    }
    for (int it = F.bid * 512 + F.tid; it < M * 8; it += F.G * 512) {
        const int m = it >> 3, i = it & 7;
        const float pos = (float)IN_positions[m];
        const float inv = (float)exp(-(double)i * 0.125 * 13.122363377404328);
        const float ang = pos * inv; double sn, cs; sincos((double)ang, &sn, &cs);
        ((float*)(wsq + WS_ROPE))[(size_t)m * 16 + i] = (float)cs; ((float*)(wsq + WS_ROPE))[(size_t)m * 16 + 8 + i] = (float)sn;
    }
}

DI void cast_rows_bf16(Frame& F, const float* x, bf16* h16, float* ssq) {
    const int gw = F.bid * NWAVES + F.wave, NGW = F.G * NWAVES;
    for (int m0 = gw; m0 < M; m0 += 2 * NGW) {
        f32x4 v[2][4];
#pragma unroll
        for (int rr = 0; rr < 2; ++rr) { const int m = m0 + rr * NGW < M ? m0 + rr * NGW : m0;
#pragma unroll
            for (int j = 0; j < 4; ++j) v[rr][j] = *((const f32x4*)(x + (size_t)m * D) + F.lane + 64 * j); }
#pragma unroll
        for (int rr = 0; rr < 2; ++rr) { const int m = m0 + rr * NGW; if (m >= M) break;
            unsigned long long* o8 = (unsigned long long*)(h16 + (size_t)m * D) + F.lane; float s = 0.f;
#pragma unroll
            for (int j = 0; j < 4; ++j) { const unsigned lo = pk2(v[rr][j].x, v[rr][j].y), hi = pk2(v[rr][j].z, v[rr][j].w); o8[64 * j] = (unsigned long long)lo | ((unsigned long long)hi << 32);
                const float a = pg8::bf_lo(lo), b = pg8::bf_hi(lo), c = pg8::bf_lo(hi), d = pg8::bf_hi(hi); s += (a * a + b * b) + (c * c + d * d); }
            s = wave_sum(s);
            if (F.lane < 16) ssq[(size_t)m * 16 + F.lane] = (F.lane == 0) ? s : 0.f; }
    }
}
DI void final_norm(Frame& F, const bf16* h16, const float* ssq, const float* gain, float* out) {
    const int gw = F.bid * NWAVES + F.wave, NGW = F.G * NWAVES;
    f32x4 gv[4];
#pragma unroll
    for (int j = 0; j < 4; ++j) gv[j] = *((const f32x4*)gain + F.lane + 64 * j);
    for (int m0 = gw; m0 < M; m0 += 2 * NGW) {
        unsigned long long hw[2][4]; float rs[2];
#pragma unroll
        for (int rr = 0; rr < 2; ++rr) { const int m = m0 + rr * NGW < M ? m0 + rr * NGW : m0; rs[rr] = pg8::row_rstd(ssq, (size_t)m);
#pragma unroll
            for (int j = 0; j < 4; ++j) hw[rr][j] = *((const unsigned long long*)(h16 + (size_t)m * D) + F.lane + 64 * j); }
#pragma unroll
        for (int rr = 0; rr < 2; ++rr) { const int m = m0 + rr * NGW; if (m >= M) break;
            f32x4* o = (f32x4*)(out + (size_t)m * D) + F.lane;
#pragma unroll
            for (int j = 0; j < 4; ++j) { const unsigned lo = (unsigned)hw[rr][j], hi = (unsigned)(hw[rr][j] >> 32);
                f32x4 v; v.x = pg8::bf_lo(lo); v.y = pg8::bf_hi(lo); v.z = pg8::bf_lo(hi); v.w = pg8::bf_hi(hi); o[64 * j] = v * rs[rr] * gv[j]; } }
    }
}
DI void cvt_p16(Frame& F, int l) {
    unsigned char* const wsq = ws_opaque();
    const f32x4* src = (const f32x4*)(IN_p + (size_t)l * M * PLE); unsigned long long* dst = (unsigned long long*)((bf16*)(wsq + WS_P16));
    constexpr int n = M * PLE / 4; const int st = F.G * 512;
    for (int i = F.bid * 512 + F.tid; i < n; i += 4 * st) {
        f32x4 v[4];
#pragma unroll
        for (int k = 0; k < 4; ++k) { const int ii = i + k * st; v[k] = ii < n ? src[ii] : (f32x4){0.f, 0.f, 0.f, 0.f}; }
#pragma unroll
        for (int k = 0; k < 4; ++k) { const int ii = i + k * st; if (ii < n) dst[ii] = (unsigned long long)pk2(v[k].x, v[k].y) | ((unsigned long long)pk2(v[k].z, v[k].w) << 32); }
    }
}

template <int W, int T> DI void pool_item(const bf16* U, bf16* P, int m0, int col8) {
    const int tl0 = m0 & (SEQ - 1);
    v4u pre[W - 1], cur[T];
#pragma unroll
    for (int k = 1; k < W; ++k) pre[k - 1] = (tl0 - k >= 0) ? *(const v4u*)(U + (size_t)(m0 - k) * 512 + col8) : (v4u){0u, 0u, 0u, 0u};
#pragma unroll
    for (int t = 0; t < T; ++t) cur[t] = *(const v4u*)(U + (size_t)(m0 + t) * 512 + col8);
    float s[8];
#pragma unroll
    for (int e = 0; e < 8; ++e) s[e] = 0.f;
#pragma unroll
    for (int k = 1; k < W; ++k) { float f[8]; unpack8(pre[k - 1], f);
#pragma unroll
        for (int e = 0; e < 8; ++e) s[e] += f[e]; }
#pragma unroll
    for (int t = 0; t < T; ++t) {
        const int tl = tl0 + t; float c[8]; unpack8(cur[t], c);
#pragma unroll
        for (int e = 0; e < 8; ++e) s[e] += c[e];
        const float ic = 1.0f / (float)((tl + 1 < W) ? tl + 1 : W);
        v4u o; o.x = pk2(s[0] * ic - c[0], s[1] * ic - c[1]); o.y = pk2(s[2] * ic - c[2], s[3] * ic - c[3]); o.z = pk2(s[4] * ic - c[4], s[5] * ic - c[5]); o.w = pk2(s[6] * ic - c[6], s[7] * ic - c[7]);
        *(v4u*)(P + (size_t)(m0 + t) * 512 + col8) = o;
        float d[8]; unpack8((t - W + 1 >= 0) ? cur[(t - W + 1 >= 0) ? t - W + 1 : 0] : pre[(t - W + 1 >= 0) ? 0 : W - 2 - t], d);
#pragma unroll
        for (int e = 0; e < 8; ++e) s[e] -= d[e];
    }
}
DI void pool_phase(Frame& F) {
    unsigned char* const wsq = ws_opaque();
    const bf16* U = (const bf16*)(wsq + WS_U); bf16* P = (bf16*)(wsq + WS_POOLED);
    const int g = F.wave & 3, cvl = F.lane & 15, tq = F.lane >> 4;
    for (int cg = F.bid * 2 + (F.wave >> 2); cg < M / 64; cg += F.G * 2) {
        const int m0 = (cg * 4 + tq) * 16, col8 = (g * 16 + cvl) * 8;
#pragma unroll 1
        for (int hf = 0; hf < 2; ++hf) {
            if (g == 0) pool_item<2, 8>(U, P, m0 + 8 * hf, col8); else if (g == 1) pool_item<4, 8>(U, P, m0 + 8 * hf, col8); else if (g == 2) pool_item<8, 8>(U, P, m0 + 8 * hf, col8); else pool_item<16, 8>(U, P, m0 + 8 * hf, col8); }
    }
}

typedef float f32x16 __attribute__((ext_vector_type(16)));
typedef float f32x2_t __attribute__((ext_vector_type(2)));
typedef __bf16 bf16x2_t __attribute__((ext_vector_type(2)));
typedef unsigned u32x2_t __attribute__((ext_vector_type(2)));
#define MFMA32(a, b, c) __builtin_amdgcn_mfma_f32_32x32x16_bf16((a), (b), (c), 0, 0, 0)
DI unsigned cvtpk(float lo, float hi) { const f32x2_t v = {lo, hi}; const bf16x2_t b = __builtin_convertvector(v, bf16x2_t); return __builtin_bit_cast(unsigned, b); }
DI int crow(int i, int h) { return (i & 3) + 8 * (i >> 2) + 4 * h; }
DI float ex2(float x) { return __builtin_amdgcn_exp2f(x); }
#define MAX_TAIL "\n\tv_max3_f32 %0, %0, %4, %5\n\tv_max3_f32 %0, %0, %6, %7\n\tv_max3_f32 %0, %0, %8, %9\n\tv_max3_f32 %0, %0, %10, %11\n\tv_max3_f32 %0, %0, %12, %13\n\tv_max3_f32 %0, %0, %14, %15"
DI float max16_x4(const f32x4 (&S)[4]) {
    float m;
    asm("s_nop 7\n\tv_max3_f32 %0, %1, %2, %3" MAX_TAIL "\n\tv_max_f32 %0, %0, %16" : "=&v"(m)
        : "v"(S[0][0]), "v"(S[0][1]), "v"(S[0][2]), "v"(S[0][3]), "v"(S[1][0]), "v"(S[1][1]), "v"(S[1][2]), "v"(S[1][3]), "v"(S[2][0]), "v"(S[2][1]), "v"(S[2][2]), "v"(S[2][3]), "v"(S[3][0]), "v"(S[3][1]), "v"(S[3][2]), "v"(S[3][3]));
    return m;
}
DI float max16_x16(const f32x16& S) {
    float m;
    asm("s_nop 11\n\tv_max3_f32 %0, %1, %2, %3" MAX_TAIL "\n\tv_max_f32 %0, %0, %16" : "=&v"(m)
        : "v"(S[0]), "v"(S[1]), "v"(S[2]), "v"(S[3]), "v"(S[4]), "v"(S[5]), "v"(S[6]), "v"(S[7]), "v"(S[8]), "v"(S[9]), "v"(S[10]), "v"(S[11]), "v"(S[12]), "v"(S[13]), "v"(S[14]), "v"(S[15]));
    return m;
}
DI float max17_x16(float seed, const f32x16& S) {
    float m;
    asm("s_nop 11\n\tv_max3_f32 %0, %17, %1, %2\n\tv_max3_f32 %0, %0, %3, %4" "\n\tv_max3_f32 %0, %0, %5, %6\n\tv_max3_f32 %0, %0, %7, %8\n\tv_max3_f32 %0, %0, %9, %10\n\tv_max3_f32 %0, %0, %11, %12\n\tv_max3_f32 %0, %0, %13, %14\n\tv_max3_f32 %0, %0, %15, %16" : "=&v"(m)
        : "v"(S[0]), "v"(S[1]), "v"(S[2]), "v"(S[3]), "v"(S[4]), "v"(S[5]), "v"(S[6]), "v"(S[7]), "v"(S[8]), "v"(S[9]), "v"(S[10]), "v"(S[11]), "v"(S[12]), "v"(S[13]), "v"(S[14]), "v"(S[15]), "v"(seed));
    return m;
}
constexpr int NSA_KB = 8192, NSA_BLK = 16384, NSA_STAGE = 2 * NSA_BLK;
constexpr int NSA_OFF_IMP = 2 * NSA_STAGE, NSA_OFF_SELB = 4 * NSA_STAGE, NSA_LDS_END = NSA_OFF_SELB + 2 * 2048;
static_assert(NSA_LDS_END <= RING_BYTES && NSA_OFF_IMP + 65536 <= NSA_OFF_SELB, "NSA LDS map");
DI int swz(int row, int g) { return row * 128 + ((g ^ ((row >> 1) & 7)) << 4); }
enum { MODE_CMP1 = 0, MODE_CMP2 = 1, MODE_SEL = 2, MODE_WIN = 3 };
#define LDS_BARRIER() asm volatile("s_waitcnt lgkmcnt(0)\n\ts_barrier" ::: "memory")

struct NsaCol {
    int tcol, cnt;
    float m, l;
};
DI void qk_tile(const LAS unsigned char* kb, const bf16x8 (&qf)[4], int lane, float cinit, f32x16& S0, f32x16& S1) {
    const int r = lane & 31, h = lane >> 5;
#pragma unroll
    for (int i = 0; i < 16; ++i) { S0[i] = cinit; S1[i] = cinit; }
#pragma unroll
    for (int ks = 0; ks < 4; ++ks) {
        const bf16x8 a0 = *(const LAS bf16x8*)(kb + swz(r, 2 * ks + h));
        const bf16x8 a1 = *(const LAS bf16x8*)(kb + swz(32 + r, 2 * ks + h));
        S0 = MFMA32(a0, qf[ks], S0); S1 = MFMA32(a1, qf[ks], S1);
    }
}
template <int S> DI bf16x8 pack8(const f32x16& x) {
    v4u p; p.x = cvtpk(x[8 * S + 0], x[8 * S + 1]); p.y = cvtpk(x[8 * S + 2], x[8 * S + 3]); p.z = cvtpk(x[8 * S + 4], x[8 * S + 5]); p.w = cvtpk(x[8 * S + 6], x[8 * S + 7]);
    return __builtin_bit_cast(bf16x8, p);
}
template <int KS> DI void pv_step(const LAS unsigned char* vb, const bf16x8 pf, int r, int h, f32x16& O0, f32x16& O1) {
#pragma unroll
    for (int dh = 0; dh < 2; ++dh) {
        const u32x2_t lo = *(const LAS u32x2_t*)(vb + swz(32 * dh + r, 2 * KS) + 8 * h), hi = *(const LAS u32x2_t*)(vb + swz(32 * dh + r, 2 * KS + 1) + 8 * h);
        const v4u av = {lo.x, lo.y, hi.x, hi.y};
        const bf16x8 a = __builtin_bit_cast(bf16x8, av);
        if (dh == 0) O0 = MFMA32(a, pf, O0); else O1 = MFMA32(a, pf, O1);
    }
}
DI void pv_tile(const LAS unsigned char* vb, const f32x16& P0, const f32x16& P1, int lane, f32x16& O0, f32x16& O1) {
    const int r = lane & 31, h = lane >> 5;
    pv_step<0>(vb, pack8<0>(P0), r, h, O0, O1); pv_step<1>(vb, pack8<1>(P0), r, h, O0, O1);
    pv_step<2>(vb, pack8<0>(P1), r, h, O0, O1); pv_step<3>(vb, pack8<1>(P1), r, h, O0, O1);
}

template <int MODE>
DI void nsa_block(const LAS unsigned char* kb, int lane, int i, int c, int rowbase, bool mybit, const bf16x8 (&qf)[4], NsaCol& col, float inv_l, float& carry, f32x16& O0, f32x16& O1, LAS float* impw) {
    const int h = lane >> 5, hh = lane & 3;
    const LAS unsigned char* vb = kb + NSA_KB;
    const float ms0 = (MODE == MODE_SEL && !mybit) ? INFINITY : ((col.m == -INFINITY) ? 0.f : col.m);
    f32x16 S0, S1; qk_tile(kb, qf, lane, -ms0, S0, S1);
    const int kbase = (MODE == MODE_WIN) ? (rowbase + 64 * i) : 64 * i;
    bool masked;
    if (MODE == MODE_CMP1 || MODE == MODE_CMP2) masked = (kbase + 63 >= 4 * c - 1);
    else if (MODE == MODE_SEL) masked = (i == c);
    else masked = !((kbase + 63 <= 64 * c) && (kbase > 64 * c + 63 - 512));
    if (masked) {
#pragma unroll
        for (int r = 0; r < 16; ++r) {
            const int k0 = kbase + crow(r, h), k1 = k0 + 32;
            bool v0, v1;
            if (MODE == MODE_CMP1 || MODE == MODE_CMP2) { v0 = k0 < col.cnt; v1 = k1 < col.cnt; }
            else if (MODE == MODE_SEL) { v0 = k0 <= col.tcol; v1 = k1 <= col.tcol; }
            else { v0 = (k0 <= col.tcol) && (k0 > col.tcol - 512); v1 = (k1 <= col.tcol) && (k1 > col.tcol - 512); }
            S0[r] = v0 ? S0[r] : -INFINITY; S1[r] = v1 ? S1[r] : -INFINITY;
        }
    }
    if (MODE == MODE_CMP2) {
#pragma unroll
        for (int r = 0; r < 16; ++r) { S0[r] = ex2(S0[r]) * inv_l; S1[r] = ex2(S1[r]) * inv_l; }
#pragma unroll
        for (int u = 0; u < 8; ++u) {
            float G, L;
            if (u < 4) { G = (S0[4 * u] + S0[4 * u + 1]) + (S0[4 * u + 2] + S0[4 * u + 3]); L = S0[4 * u + 3]; }
            else { G = (S1[4 * (u - 4)] + S1[4 * (u - 4) + 1]) + (S1[4 * (u - 4) + 2] + S1[4 * (u - 4) + 3]); L = S1[4 * (u - 4) + 3]; }
            G += __shfl_xor(G, 1); G += __shfl_xor(G, 2); L += __shfl_xor(L, 1); L += __shfl_xor(L, 2);
            const float Lx = __shfl_xor(L, 32);
            const float prev = (h == 1) ? Lx : carry;
            if (hh == 0) impw[((lane & 31) >> 2) * 256 + 16 * i + 2 * u + h] = G + prev;
            carry = Lx;
        }
        pv_tile(vb, S0, S1, lane, O0, O1);
    } else {
        float mx = max17_x16(max16_x16(S0), S1);
        f32x16 P0, P1;
#pragma unroll
        for (int r = 0; r < 16; ++r) { P0[r] = ex2(S0[r]); P1[r] = ex2(S1[r]); }
        const bool fresh = (col.m == -INFINITY);
        const float thr = fresh ? -INFINITY : 8.0f;
        if (__any(mx > thr)) {
            mx = fmaxf(mx, __shfl_xor(mx, 32));
            const bool need = mx > thr;
            const float dm = need ? mx : 0.f;
            const float alpha = need ? (fresh ? 0.f : ex2(-mx)) : 1.0f;
            col.l *= alpha; if (need) col.m = ms0 + mx;
#pragma unroll
            for (int r = 0; r < 16; ++r) { P0[r] = ex2(S0[r] - dm); P1[r] = ex2(S1[r] - dm); }
            if (MODE != MODE_CMP1) {
#pragma unroll
                for (int r = 0; r < 16; ++r) { O0[r] *= alpha; O1[r] *= alpha; }
            }
        }
        float ls = 0.f;
#pragma unroll
        for (int r = 0; r < 16; ++r) { S0[r] = P0[r]; S1[r] = P1[r]; ls += P0[r] + P1[r]; }
        col.l += ls;
        if (MODE != MODE_CMP1) pv_tile(vb, S0, S1, lane, O0, O1);
    }
}

struct NsaSrc { const bf16* Kth; const bf16* Vth; size_t kstep, vstep; int nt; };
DI void nsa_src_init(NsaSrc& S, const bf16* Krow0, size_t kpitch, const bf16* Vblk0, int nt, int tid) {
    const int row = tid >> 3, k = (tid & 7) ^ ((row >> 1) & 7);
    S.Kth = Krow0 + (size_t)row * kpitch + k * 8; S.kstep = 64 * kpitch; S.Vth = Vblk0 + row * 64 + k * 8; S.vstep = 4096; S.nt = nt;
}
template <bool NEEDV> DI void nsa_dma(const NsaSrc& S, int i, LAS unsigned char* blk, int w) {
    const int ic = i < S.nt ? i : S.nt - 1;
    __builtin_amdgcn_global_load_lds((const unsigned*)(S.Kth + (size_t)ic * S.kstep), (LAS unsigned*)(blk + w * 1024), 16, 0, 0);
    if (NEEDV) __builtin_amdgcn_global_load_lds((const unsigned*)(S.Vth + (size_t)ic * S.vstep), (LAS unsigned*)(blk + NSA_KB + w * 1024), 16, 0, 0);
}
template <int MODE, bool CHAIN_OUT = false, bool CHAIN_IN = false>
DI void nsa_tiles(Frame& F, unsigned char* wsq, int b, int g, int c, int nt, int i0, const bf16x8 (&qf)[4], NsaCol& col, float inv_l, f32x16& O0, f32x16& O1, LAS float* impw) {
    const int tid = F.tid, lane = F.lane, w = F.wave;
    constexpr bool NEEDV = (MODE != MODE_CMP1);
    NsaSrc S; int rowbase = 0;
    if (MODE == MODE_CMP1 || MODE == MODE_CMP2)
        nsa_src_init(S, ((const bf16*)(wsq + WS_KCMP)) + ((size_t)b * 1024 * 2 + g) * 64, 128, ((const bf16*)(wsq + WS_VCT)) + (size_t)((b * 2 + g) * 16) * 4096, nt, tid);
    else { rowbase = 64 * (c - 8 + i0);
        nsa_src_init(S, ((const bf16*)(wsq + WS_KV)) + ((size_t)(4 * 2 + g) * M + (size_t)b * SEQ + rowbase) * 64, 64, ((const bf16*)(wsq + WS_VWT)) + (size_t)((b * 2 + g) * 256 + (c - 8 + i0)) * 4096, nt, tid); }
    LAS unsigned char* ring = F.lds + RING_OFF;
    const int nst = (nt + 1) >> 1;
    const int par = CHAIN_IN ? (nst & 1) : 0;
    if (!CHAIN_IN) { nsa_dma<NEEDV>(S, 0, ring, w); nsa_dma<NEEDV>(S, 1, ring + NSA_BLK, w);
        asm volatile("s_waitcnt vmcnt(0)\n\ts_barrier" ::: "memory"); }
    float carry = 0.f;
    for (int s = 0; s < nst; ++s) {
        const int pb = (s + par) & 1;
        if (s + 1 < nst) { nsa_dma<NEEDV>(S, 2 * s + 2, ring + (pb ^ 1) * NSA_STAGE, w); nsa_dma<NEEDV>(S, 2 * s + 3, ring + (pb ^ 1) * NSA_STAGE + NSA_BLK, w); }
        else if (CHAIN_OUT) { nsa_dma<true>(S, 0, ring + (pb ^ 1) * NSA_STAGE, w); nsa_dma<true>(S, 1, ring + (pb ^ 1) * NSA_STAGE + NSA_BLK, w); }
#pragma unroll
        for (int bb = 0; bb < 2; ++bb) {
            const int i = 2 * s + bb;
            if (i < nt) nsa_block<MODE>(ring + pb * NSA_STAGE + bb * NSA_BLK, lane, i, c, rowbase, true, qf, col, inv_l, carry, O0, O1, impw);
        }
        asm volatile("s_waitcnt vmcnt(0) lgkmcnt(0)\n\ts_barrier" ::: "memory");
    }
}

#define MFMA16(a, b, c) __builtin_amdgcn_mfma_f32_16x16x32_bf16((a), (b), (c), 0, 0, 0)
struct Sel16 { float m, l; int tcol; f32x4 O0, O1, O2, O3; bf16x8 q0, q1; };
DI void sel16_qk(Sel16& G, bool bit, const bf16x8 (&kf)[4][2], int q4, int i, int c, f32x4 (&S)[4]) {
    const float ms0 = !bit ? INFINITY : ((G.m == -INFINITY) ? 0.f : G.m);
    const bf16x8 q0 = G.q0, q1 = G.q1;
#pragma unroll
    for (int t = 0; t < 4; ++t) { S[t] = (f32x4){-ms0, -ms0, -ms0, -ms0}; S[t] = MFMA16(kf[t][0], q0, S[t]); S[t] = MFMA16(kf[t][1], q1, S[t]); }
    if (i == c) {
#pragma unroll
        for (int t = 0; t < 4; ++t)
#pragma unroll
            for (int e = 0; e < 4; ++e) S[t][e] = (64 * c + 16 * t + 4 * q4 + e <= G.tcol) ? S[t][e] : -INFINITY;
    }
    float mx = max16_x4(S);
    f32x4 P[4];
#pragma unroll
    for (int t = 0; t < 4; ++t) { P[t][0] = ex2(S[t][0]); P[t][1] = ex2(S[t][1]); P[t][2] = ex2(S[t][2]); P[t][3] = ex2(S[t][3]); }
    const bool fresh = (G.m == -INFINITY);
    const float thr = fresh ? -INFINITY : 8.0f;
    if (__any(mx > thr)) {
        mx = fmaxf(mx, __shfl_xor(mx, 16)); mx = fmaxf(mx, __shfl_xor(mx, 32));
        const bool need = mx > thr;
        const float dm = need ? mx : 0.f, alpha = need ? (fresh ? 0.f : ex2(-mx)) : 1.0f;
        G.l *= alpha; if (need) G.m = ms0 + mx;
#pragma unroll
        for (int t = 0; t < 4; ++t) { P[t][0] = ex2(S[t][0] - dm); P[t][1] = ex2(S[t][1] - dm); P[t][2] = ex2(S[t][2] - dm); P[t][3] = ex2(S[t][3] - dm); }
        G.O0 *= alpha; G.O1 *= alpha; G.O2 *= alpha; G.O3 *= alpha;
    }
    float ls = 0.f;
#pragma unroll
    for (int t = 0; t < 4; ++t) { S[t] = P[t]; ls += (P[t][0] + P[t][1]) + (P[t][2] + P[t][3]); }
    G.l += ls;
}
DI void sel16_pv(Sel16& G, const bf16x8 (&vf)[4][2], const f32x4 (&S)[4]) {
#pragma unroll
    for (int ks2 = 0; ks2 < 2; ++ks2) {
        v4u pw; pw.x = cvtpk(S[2 * ks2][0], S[2 * ks2][1]); pw.y = cvtpk(S[2 * ks2][2], S[2 * ks2][3]); pw.z = cvtpk(S[2 * ks2 + 1][0], S[2 * ks2 + 1][1]); pw.w = cvtpk(S[2 * ks2 + 1][2], S[2 * ks2 + 1][3]);
        const bf16x8 pf = __builtin_bit_cast(bf16x8, pw);
        G.O0 = MFMA16(vf[0][ks2], pf, G.O0); G.O1 = MFMA16(vf[1][ks2], pf, G.O1); G.O2 = MFMA16(vf[2][ks2], pf, G.O2); G.O3 = MFMA16(vf[3][ks2], pf, G.O3);
    }
}
struct SelBits { bool bit, act; };
DI SelBits sel_bits(Sel16& G, const LAS unsigned* selw, int i) { const unsigned wd = selw[i >> 5]; SelBits r; r.bit = (wd >> (i & 31)) & 1u;
    r.act = __ballot(r.bit) != 0ull; return r; }
DI void sel16_block(const LAS unsigned char* kb, int c16, int q4, int i, int c0, Sel16& GA, const SelBits sA, Sel16& GB, const SelBits sB, Sel16& GC, const SelBits sC, Sel16& GD, const SelBits sD) {
    if (!(sA.act || sB.act || sC.act || sD.act)) return;
    const LAS unsigned char* vb = kb + NSA_KB;
    f32x4 SA[4], SB[4], SC[4], SD[4];
    { bf16x8 kf[4][2];
#pragma unroll
      for (int t = 0; t < 4; ++t)
#pragma unroll
          for (int ks = 0; ks < 2; ++ks) kf[t][ks] = *(const LAS bf16x8*)(kb + swz(16 * t + c16, 4 * ks + q4));
      if (sA.act) sel16_qk(GA, sA.bit, kf, q4, i, c0, SA);
      if (sB.act) sel16_qk(GB, sB.bit, kf, q4, i, c0, SB);
      if (sC.act) sel16_qk(GC, sC.bit, kf, q4, i, c0 + 1, SC);
      if (sD.act) sel16_qk(GD, sD.bit, kf, q4, i, c0 + 1, SD); }
    asm volatile("" ::: "memory");
    { bf16x8 vf[4][2];
#pragma unroll
      for (int dt = 0; dt < 4; ++dt)
#pragma unroll
          for (int ks2 = 0; ks2 < 2; ++ks2) { const int row = 16 * dt + c16;
              const u32x2_t lo = *(const LAS u32x2_t*)(vb + swz(row, 4 * ks2 + (q4 >> 1)) + 8 * (q4 & 1)), hi = *(const LAS u32x2_t*)(vb + swz(row, 4 * ks2 + 2 + (q4 >> 1)) + 8 * (q4 & 1));
              const v4u av = {lo.x, lo.y, hi.x, hi.y}; vf[dt][ks2] = __builtin_bit_cast(bf16x8, av); }
      if (sA.act) sel16_pv(GA, vf, SA);
      if (sB.act) sel16_pv(GB, vf, SB);
      if (sC.act) sel16_pv(GC, vf, SC);
      if (sD.act) sel16_pv(GD, vf, SD); }
    asm volatile("" ::: "memory");
}
constexpr int SEL_STAGE = 4 * NSA_BLK;
DI void nsa_stage_sel16(Frame& F, const NsaSrc& S, int s, int nst, int c0, Sel16& GA, Sel16& GB, Sel16& GC, Sel16& GD, const LAS unsigned* sel0, const LAS unsigned* sel1) {
    LAS unsigned char* ring = F.lds + RING_OFF;
    const int lane = F.lane, c16 = lane & 15, q4 = lane >> 4, w = F.wave;
    if (s + 1 < nst) { LAS unsigned char* nb = ring + ((s + 1) & 1) * SEL_STAGE;
#pragma unroll
        for (int bb = 0; bb < 4; ++bb) nsa_dma<true>(S, 4 * s + 4 + bb, nb + bb * NSA_BLK, w); }
#pragma unroll 1
    for (int bb = 0; bb < 4; ++bb) {
        const int i = 4 * s + bb;
        if (i < S.nt) {
            const LAS unsigned char* kb = ring + (s & 1) * SEL_STAGE + bb * NSA_BLK;
            const SelBits sA = sel_bits(GA, sel0 + (c16 >> 2) * 8, i), sB = sel_bits(GB, sel0 + (4 + (c16 >> 2)) * 8, i);
            const SelBits sC = sel_bits(GC, sel1 + (c16 >> 2) * 8, i), sD = sel_bits(GD, sel1 + (4 + (c16 >> 2)) * 8, i);
            sel16_block(kb, c16, q4, i, c0, GA, sA, GB, sB, GC, sC, GD, sD);
        }
    }
    asm volatile("s_waitcnt vmcnt(0) lgkmcnt(0)\n\ts_barrier" ::: "memory");
}
DI void sel16_init(Sel16& G, unsigned char* wsq, int b, int g, int tcol, int hh, int q4) {
    G.tcol = tcol; const size_t mr = (size_t)b * SEQ + tcol;
    const bf16* Qr = ((const bf16*)(wsq + WS_Q)) + mr * 512 + (g * 4 + hh) * 64 + 8 * q4;
    G.q0 = *(const bf16x8*)Qr; G.q1 = *(const bf16x8*)(Qr + 32);
    G.m = -INFINITY; G.l = 0.f; const f32x4 z = {0.f, 0.f, 0.f, 0.f}; G.O0 = z; G.O1 = z; G.O2 = z; G.O3 = z;
}
DI void sel16_finish(Sel16& G, unsigned char* wsq, int b, int g, int hh, int q4, size_t out_off) {
    float l = G.l; l += __shfl_xor(l, 16); l += __shfl_xor(l, 32);
    const float g1 = pg8::sigm(((const float*)(wsq + WS_SMALL))[((size_t)b * SEQ + G.tcol) * 64 + (g * 4 + hh) * 3 + 1]);
    const float il = l > 0.f ? g1 / l : 0.f;
    const size_t base = ((size_t)b * SEQ + G.tcol) * 512 + (g * 4 + hh) * 64 + 4 * q4;
    const bf16* yp = ((const bf16*)(wsq + WS_YP)) + base; bf16* op = ((bf16*)(wsq + out_off)) + base;
    u32x2_t y[4];
#pragma unroll
    for (int dt = 0; dt < 4; ++dt) y[dt] = *(const u32x2_t*)(yp + 16 * dt);
    const f32x4 o[4] = {G.O0, G.O1, G.O2, G.O3};
#pragma unroll
    for (int dt = 0; dt < 4; ++dt) { u32x2_t w; w.x = cvtpk(pg8::bf_lo(y[dt].x) + il * o[dt][0], pg8::bf_hi(y[dt].x) + il * o[dt][1]); w.y = cvtpk(pg8::bf_lo(y[dt].y) + il * o[dt][2], pg8::bf_hi(y[dt].y) + il * o[dt][3]);
        *(u32x2_t*)(op + 16 * dt) = w; }
}
DI void nsa_selpair(Frame& F, unsigned char* wsq, int b, int g, int c0, size_t out_off) {
    const int tid = F.tid, lane = F.lane, w = F.wave, c16 = lane & 15, q4 = lane >> 4, hh = c16 & 3;
    NsaSrc S;
    nsa_src_init(S, ((const bf16*)(wsq + WS_KV)) + ((size_t)(2 * 2 + g) * M + (size_t)b * SEQ) * 64, 64, ((const bf16*)(wsq + WS_VST)) + (size_t)((b * 2 + g) * 256) * 4096, c0 + 2, tid);
    Sel16 GA, GB, GC, GD;
    sel16_init(GA, wsq, b, g, 64 * c0 + 8 * w + (c16 >> 2), hh, q4); sel16_init(GB, wsq, b, g, 64 * c0 + 8 * w + 4 + (c16 >> 2), hh, q4);
    sel16_init(GC, wsq, b, g, 64 * (c0 + 1) + 8 * w + (c16 >> 2), hh, q4); sel16_init(GD, wsq, b, g, 64 * (c0 + 1) + 8 * w + 4 + (c16 >> 2), hh, q4);
    asm volatile("s_waitcnt vmcnt(0)" ::: "memory");
    const LAS unsigned* sel0 = (const LAS unsigned*)(F.lds + RING_OFF + NSA_OFF_SELB) + w * 64; const LAS unsigned* sel1 = sel0 + 512;
    const int nst = (S.nt + 3) >> 2;
    { LAS unsigned char* ring = F.lds + RING_OFF;
#pragma unroll
      for (int bb = 0; bb < 4; ++bb) nsa_dma<true>(S, bb, ring + bb * NSA_BLK, w); }
    asm volatile("s_waitcnt vmcnt(0)\n\ts_barrier" ::: "memory");
    for (int s = 0; s < nst; ++s) nsa_stage_sel16(F, S, s, nst, c0, GA, GB, GC, GD, sel0, sel1);
    unsigned char* const w2 = ws_opaque();
    sel16_finish(GA, w2, b, g, hh, q4, out_off); sel16_finish(GB, w2, b, g, hh, q4, out_off);
    sel16_finish(GC, w2, b, g, hh, q4, out_off); sel16_finish(GD, w2, b, g, hh, q4, out_off);
}

DI void nsa_pre(Frame& F, unsigned char* wsq, int b, int g, int c, int slot) {
    const int lane = F.lane, w = F.wave, h = lane >> 5, colx = lane & 31, qi = colx >> 2, hh = colx & 3;
    NsaCol col; col.tcol = 64 * c + 8 * w + qi; col.cnt = col.tcol >= 31 ? ((col.tcol - 31) >> 4) + 1 : 0;
#define NSA_GATE(k) pg8::sigm(((const float*)(ws_opaque() + WS_SMALL))[((size_t)b * SEQ + col.tcol) * 64 + (g * 4 + hh) * 3 + (k)])
    LAS float* impw = (LAS float*)(F.lds + RING_OFF + NSA_OFF_IMP) + w * 2048;
    LAS unsigned* selb = (LAS unsigned*)(F.lds + RING_OFF + NSA_OFF_SELB) + slot * 512 + w * 64;
    LAS float* rpark = (LAS float*)(F.lds + RING_OFF) + w * 2048;
    { f32x16 O0, O1;
#pragma unroll
      for (int r = 0; r < 16; ++r) { O0[r] = 0.f; O1[r] = 0.f; }
      const int ntc = (4 * c + 3 + 63) >> 6;
      const bf16* Qp = ((const bf16*)(ws_opaque() + WS_Q)) + ((size_t)b * SEQ + col.tcol) * 512 + (g * 4 + hh) * 64;
      bf16x8 qf[4];
#pragma unroll
      for (int ks = 0; ks < 4; ++ks) qf[ks] = *(const bf16x8*)(Qp + 16 * ks + 8 * h);
      col.m = -INFINITY; col.l = 0.f;
      nsa_tiles<MODE_CMP1, true, false>(F, ws_opaque(), b, g, c, ntc, 0, qf, col, 0.f, O0, O1, impw);
      col.l += __shfl_xor(col.l, 32);
      const float inv_l = col.l > 0.f ? 1.0f / col.l : 0.f;
      nsa_tiles<MODE_CMP2, false, true>(F, ws_opaque(), b, g, c, ntc, 0, qf, col, inv_l, O0, O1, impw);
      const float g0 = NSA_GATE(0);
#pragma unroll
      for (int r = 0; r < 16; ++r) { rpark[r * 64 + lane] = g0 * O0[r]; rpark[(16 + r) * 64 + lane] = g0 * O1[r]; } }
    asm volatile("s_waitcnt lgkmcnt(0)" ::: "memory");
    { const int nforced = c >= 2 ? 3 : c + 1, K = 16 - nforced, ncand = c + 1 - nforced;
      constexpr int TKQ = 4;
      for (int q0 = 0; q0 < 8; q0 += TKQ) {
      unsigned kx[TKQ][4]; unsigned T[TKQ];
#pragma unroll
      for (int q = 0; q < TKQ; ++q) {
#pragma unroll
          for (int jj = 0; jj < 4; ++jj) { const int j = lane + 64 * jj; const bool cd = (j <= c) && !((j == 0) || (j == c) || (j == c - 1));
              kx[q][jj] = cd ? (__float_as_uint(impw[(q0 + q) * 256 + j]) + 1u) : 0u; }
          T[q] = 1u; }
      if (ncand > K) {
#pragma unroll
          for (int q = 0; q < TKQ; ++q) T[q] = 0u;
          int cntT[TKQ];
#pragma unroll
          for (int q = 0; q < TKQ; ++q) cntT[q] = 256;
          for (int bit = 30; bit >= 0; --bit) {
              bool alldone = true;
#pragma unroll
              for (int q = 0; q < TKQ; ++q) {
                  if (cntT[q] != K) {
                      const unsigned cand = T[q] | (1u << bit);
                      int cnt = __popcll(__ballot(kx[q][0] >= cand));
                      if (c >= 64) cnt += __popcll(__ballot(kx[q][1] >= cand));
                      if (c >= 128) cnt += __popcll(__ballot(kx[q][2] >= cand)) + ((c >= 192) ? __popcll(__ballot(kx[q][3] >= cand)) : 0);
                      if (cnt >= K) { T[q] = cand; cntT[q] = cnt; }
                  }
                  alldone = alldone && (cntT[q] == K);
              }
              if (alldone) break;
          }
      }
#pragma unroll
      for (int q = 0; q < TKQ; ++q) {
          int quota = 1 << 20;
          if (ncand > K) quota = K - (__popcll(__ballot(kx[q][0] > T[q])) + __popcll(__ballot(kx[q][1] > T[q])) + __popcll(__ballot(kx[q][2] > T[q])) + __popcll(__ballot(kx[q][3] > T[q])));
          int base = 0;
#pragma unroll
          for (int jj = 0; jj < 4; ++jj) {
              const int j = lane + 64 * jj; const bool fr = (j <= c) && ((j == 0) || (j == c) || (j == c - 1)), cd = kx[q][jj] != 0u;
              const unsigned long long eqm = __ballot(cd && kx[q][jj] == T[q]);
              const int rank = base + (int)__builtin_amdgcn_mbcnt_hi((unsigned)(eqm >> 32), __builtin_amdgcn_mbcnt_lo((unsigned)eqm, 0u));
              const bool sel = fr || (cd && (kx[q][jj] > T[q] || (kx[q][jj] == T[q] && rank < quota)));
              const unsigned long long sm = __ballot(sel);
              if (lane == 0) { selb[(q0 + q) * 8 + 2 * jj] = (unsigned)sm; selb[(q0 + q) * 8 + 2 * jj + 1] = (unsigned)(sm >> 32); }
              base += __popcll(eqm);
          }
      } } }
    asm volatile("s_waitcnt lgkmcnt(0)" ::: "memory");
#pragma unroll
    for (int r = 0; r < 32; ++r) impw[r * 64 + lane] = rpark[r * 64 + lane];
    asm volatile("s_waitcnt lgkmcnt(0)" ::: "memory");
    __syncthreads();
    f32x16 O0, O1;
#pragma unroll
    for (int r = 0; r < 16; ++r) { O0[r] = 0.f; O1[r] = 0.f; }
    col.m = -INFINITY; col.l = 0.f;
    { const int i0 = c < 8 ? 8 - c : 0;
      const bf16* Qp = ((const bf16*)(ws_opaque() + WS_Q)) + ((size_t)b * SEQ + col.tcol) * 512 + (g * 4 + hh) * 64;
      bf16x8 qf[4];
#pragma unroll
      for (int ks = 0; ks < 4; ++ks) qf[ks] = *(const bf16x8*)(Qp + 16 * ks + 8 * h);
      nsa_tiles<MODE_WIN>(F, ws_opaque(), b, g, c, 9 - i0, i0, qf, col, 0.f, O0, O1, impw); }
    col.l += __shfl_xor(col.l, 32);
    const float il = col.l > 0.f ? NSA_GATE(2) / col.l : 0.f;
    bf16* Op = ((bf16*)(ws_opaque() + WS_YP)) + ((size_t)b * SEQ + col.tcol) * 512 + (g * 4 + hh) * 64;
#pragma unroll
    for (int u = 0; u < 4; ++u) {
        float y0[4], y1[4];
#pragma unroll
        for (int e = 0; e < 4; ++e) { y0[e] = impw[(4 * u + e) * 64 + lane] + il * O0[4 * u + e]; y1[e] = impw[(16 + 4 * u + e) * 64 + lane] + il * O1[4 * u + e]; }
        u32x2_t w0; w0.x = cvtpk(y0[0], y0[1]); w0.y = cvtpk(y0[2], y0[3]);
        u32x2_t w1; w1.x = cvtpk(y1[0], y1[1]); w1.y = cvtpk(y1[2], y1[3]);
        *(u32x2_t*)(Op + 8 * u + 4 * h) = w0; *(u32x2_t*)(Op + 32 + 8 * u + 4 * h) = w1;
    }
}
DI void nsa_phase(Frame& F, size_t out_off) {
    unsigned char* const wsq = ws_opaque();
    const bool xcd = (F.G == 256);
    const int nit = xcd ? 2 : (512 + F.G - 1) / F.G;
    for (int it = 0; it < nit; ++it) {
        int C, bg;
        if (xcd) { const int x = F.bid & 7, q = F.bid >> 3, k = q * 2 + (x & 1); bg = x >> 1; C = (it == 0) ? 127 - k : k; }
        else { const int idx = it * F.G + ((it & 1) ? (F.G - 1 - F.bid) : F.bid); if (idx >= 512) continue; C = 127 - (idx >> 2); bg = idx & 3; }
        asm volatile("" : "+v"(F.tid)); F.lane = F.tid & 63;
        for (int hf_ = 0; hf_ < 2; ++hf_) nsa_pre(F, wsq, bg >> 1, bg & 1, 2 * C + hf_, hf_);
        asm volatile("s_waitcnt vmcnt(0)" ::: "memory"); __syncthreads();
        asm volatile("" : "+v"(F.tid)); F.lane = F.tid & 63;
        nsa_selpair(F, ws_opaque(), bg >> 1, bg & 1, 2 * C, out_off);
        F.lane = (int)__builtin_amdgcn_mbcnt_hi(~0u, __builtin_amdgcn_mbcnt_lo(~0u, 0u)); F.tid = F.wave * 64 + F.lane;
    }
}

DI void compress_phase(Frame& F, int l) {
    unsigned char* const wsq = ws_opaque();
    constexpr int XP = 144;
    LAS unsigned char* xt = F.lds + RING_OFF; LAS float* red = (LAS float*)(F.lds + RING_OFF + 528 * XP);
    static_assert(528 * 144 + 65536 <= RING_BYTES, "compress LDS map");
    const int w = F.wave, lane = F.lane, tid = F.tid, r = lane & 31, hf = lane >> 5;
    for (int u = F.bid; u < 256; u += F.G) {
        const int which = u & 1, rest = u >> 1, nb = rest & 31, g = (rest >> 5) & 1, b = rest >> 6, n0 = nb * 32;
        const bf16* src = ((const bf16*)(wsq + WS_KV)) + ((size_t)(which * 2 + g) * M + (size_t)b * SEQ) * 64;
        { v4u xv[9];
#pragma unroll
          for (int k = 0; k < 9; ++k) { const int p = tid + 512 * k, tk = (p < 528 * 8 ? p : 0) >> 3, cc = p & 7; int tok = 16 * n0 + tk; tok = tok < SEQ ? tok : SEQ - 1; xv[k] = *(const v4u*)(src + (size_t)tok * 64 + cc * 8); }
#pragma unroll
          for (int k = 0; k < 9; ++k) { const int p = tid + 512 * k; if (p < 528 * 8) *(LAS v4u*)(xt + (p >> 3) * XP + (p & 7) * 16) = xv[k]; } }
        __syncthreads();
        const bf16* WT = ((const bf16*)(wsq + WS_WCT)) + (size_t)(l * 2 + which) * 64 * 2048;
        f32x16 a0, a1;
#pragma unroll
        for (int i = 0; i < 16; ++i) { a0[i] = 0.f; a1[i] = 0.f; }
#pragma unroll 4
        for (int kk = 0; kk < 16; ++kk) { const int ks = 16 * w + kk, li = ks >> 2;
            const bf16x8 af = *(const LAS bf16x8*)(xt + (16 * r + li) * XP + ((ks & 3) * 16 + 8 * hf) * 2);
            const bf16x8 b0 = *(const bf16x8*)(WT + (size_t)r * 2048 + 16 * ks + 8 * hf), b1 = *(const bf16x8*)(WT + (size_t)(32 + r) * 2048 + 16 * ks + 8 * hf);
            a0 = MFMA32(af, b0, a0); a1 = MFMA32(af, b1, a1); }
#pragma unroll
        for (int i = 0; i < 16; ++i) { red[(w * 32 + crow(i, hf)) * 64 + r] = a0[i]; red[(w * 32 + crow(i, hf)) * 64 + 32 + r] = a1[i]; }
        __syncthreads();
        const float* cp = ((const float*)(wsq + WS_CPOS)) + (l * 2 + which) * 64;
#pragma unroll
        for (int q = 0; q < 4; ++q) { const int o = tid + 512 * q, nl = o >> 6, e = o & 63; float s = cp[e];
#pragma unroll
            for (int ww = 0; ww < 8; ++ww) s += red[(ww * 32 + nl) * 64 + e];
            const int n = n0 + nl; const bf16 val = (n < NCMP) ? (bf16)f2bf(s) : (bf16)0;
            if (which) ((bf16*)(wsq + WS_VCT))[(size_t)((b * 2 + g) * 16 + (n >> 6)) * 4096 + e * 64 + (n & 63)] = val;
            else ((bf16*)(wsq + WS_KCMP))[((size_t)(b * 1024 + n) * 2 + g) * 64 + e] = val; }
        __syncthreads();
    }
}

DI void vtrans_phase(Frame& F) {
    unsigned char* const wsq = ws_opaque();
    const int tid = F.tid, row = tid >> 3, cc = tid & 7;
    for (int u0 = F.bid; u0 < 2048; u0 += 4 * F.G) {
        v4u r[4];
#pragma unroll
        for (int q = 0; q < 4; ++q) { const int u = u0 + q * F.G; const int uu = u < 2048 ? u : u0; const int j = uu & 255, g = (uu >> 8) & 1, b = (uu >> 9) & 1, kind = uu >> 10;
            r[q] = *(const v4u*)(((const bf16*)(wsq + WS_KV)) + ((size_t)((kind ? 5 : 3) * 2 + g) * M + (size_t)b * SEQ + 64 * j + row) * 64 + cc * 8); }
#pragma unroll
        for (int q = 0; q < 4; ++q) { LAS unsigned short* tp = (LAS unsigned short*)(F.lds + RING_OFF) + q * (64 * 72) + (8 * cc) * 72 + row;
            tp[0 * 72] = (unsigned short)(r[q].x & 0xffffu); tp[1 * 72] = (unsigned short)(r[q].x >> 16); tp[2 * 72] = (unsigned short)(r[q].y & 0xffffu); tp[3 * 72] = (unsigned short)(r[q].y >> 16);
            tp[4 * 72] = (unsigned short)(r[q].z & 0xffffu); tp[5 * 72] = (unsigned short)(r[q].z >> 16); tp[6 * 72] = (unsigned short)(r[q].w & 0xffffu); tp[7 * 72] = (unsigned short)(r[q].w >> 16); }
        __syncthreads();
#pragma unroll
        for (int q = 0; q < 4; ++q) { const int u = u0 + q * F.G;
            if (u < 2048) { const int j = u & 255, g = (u >> 8) & 1, b = (u >> 9) & 1, kind = u >> 10;
                const v4u o = *(const LAS v4u*)((LAS unsigned short*)(F.lds + RING_OFF) + q * (64 * 72) + row * 72 + cc * 8);
                *(v4u*)(((bf16*)(wsq + (kind ? WS_VWT : WS_VST))) + (size_t)((b * 2 + g) * 256 + j) * 4096 + row * 64 + cc * 8) = o; } }
        __syncthreads();
    }
}

DI float logsig(float z) { return fminf(z, 0.f) - 0.6931471805599453f * __builtin_amdgcn_logf(1.0f + __builtin_amdgcn_exp2f(-1.4426950408889634f * fabsf(z))); }
DI float fexp(float x) { return __builtin_amdgcn_exp2f(1.4426950408889634f * x); }
constexpr int GLP = 144;
template <int CTRL, int ROWS> DI float dpp_or0(float x) { return __builtin_bit_cast(float, __builtin_amdgcn_update_dpp(0, __builtin_bit_cast(int, x), CTRL, ROWS, 0xF, true)); }
DI float wave_scan_incl(float x) {
    x += dpp_or0<0x111, 0xF>(x); x += dpp_or0<0x112, 0xF>(x); x += dpp_or0<0x114, 0xF>(x); x += dpp_or0<0x118, 0xF>(x);
    x += dpp_or0<0x142, 0xA>(x); x += dpp_or0<0x143, 0xC>(x);
    return x;
}
constexpr int GLA_WG_OFF = RING_OFF + 98304;
static_assert(GLA_WG_OFF + 17 * 1024 <= LDS_BYTES, "gate weights in LDS");
DI void gla_stage_wg(Frame& F, int l) {
    LAS float* wgl = (LAS float*)(F.lds + GLA_WG_OFF);
    const float* wg = IN_gla_w_gate + (size_t)l * 16 * 256; const float* bg = IN_gla_b_gate + (size_t)l * 256;
#pragma unroll
    for (int k = 0; k < 2; ++k) ((LAS f32x4*)wgl)[F.tid + 512 * k] = ((const f32x4*)wg)[F.tid + 512 * k];
    if (F.tid < 64) ((LAS f32x4*)wgl)[1024 + F.tid] = ((const f32x4*)bg)[F.tid];
    __syncthreads();
}
DI void gla_gates_c(Frame& F, const f32x4 (&gl4)[4], int h, int w, int lane, float (&bcv)[8], float (&blv)[8]) {
    const LAS float* wgl = (const LAS float*)(F.lds + GLA_WG_OFF) + h * 64 + 8 * w;
    float glr[16];
#pragma unroll
    for (int r4 = 0; r4 < 4; ++r4) { glr[4 * r4] = gl4[r4].x; glr[4 * r4 + 1] = gl4[r4].y; glr[4 * r4 + 2] = gl4[r4].z; glr[4 * r4 + 3] = gl4[r4].w; }
    { const f32x4 b0 = *(const LAS f32x4*)(wgl + 4096), b1 = *(const LAS f32x4*)(wgl + 4096 + 4);
      float z[8] = {b0.x, b0.y, b0.z, b0.w, b1.x, b1.y, b1.z, b1.w};
#pragma unroll
      for (int r = 0; r < 16; ++r) { const f32x4 w0 = *(const LAS f32x4*)(wgl + r * 256), w1 = *(const LAS f32x4*)(wgl + r * 256 + 4);
          z[0] += glr[r] * w0.x; z[1] += glr[r] * w0.y; z[2] += glr[r] * w0.z; z[3] += glr[r] * w0.w; z[4] += glr[r] * w1.x; z[5] += glr[r] * w1.y; z[6] += glr[r] * w1.z; z[7] += glr[r] * w1.w; }
#pragma unroll
      for (int e = 0; e < 8; ++e) bcv[e] = logsig(z[e]) * (1.0f / 16.0f); }
#pragma unroll
    for (int e = 0; e < 8; ++e) bcv[e] = wave_scan_incl(bcv[e]);
#pragma unroll
    for (int e = 0; e < 8; ++e) blv[e] = __builtin_bit_cast(float, __builtin_amdgcn_readlane(__builtin_bit_cast(int, bcv[e]), 63));
}
DI void gla_gates_ld(unsigned char* wsq, size_t m0, int lane, f32x4 (&gl4)[4]) {
#pragma unroll
    for (int r4 = 0; r4 < 4; ++r4) gl4[r4] = *(const f32x4*)(((const float*)(wsq + WS_SMALL)) + (m0 + lane) * 64 + 24 + 4 * r4);
}
DI void gla_gates(Frame& F, unsigned char* wsq, int l, size_t m0, int h, int w, int lane, float (&bcv)[8], float (&blv)[8]) {
    f32x4 gl4[4]; gla_gates_ld(wsq, m0, lane, gl4); gla_gates_c(F, gl4, h, w, lane, bcv, blv);
}
DI void gla_vt_ld(unsigned char* wsq, size_t m0, int h, int w, int lane, v4u (&vr)[2]) {
#pragma unroll
    for (int pp = 0; pp < 2; ++pp) vr[pp] = *(const v4u*)(((const bf16*)(wsq + WS_VG)) + (m0 + lane) * 512 + h * 128 + 8 * (2 * w + pp));
}
DI void gla_vt_st(const v4u (&vr)[2], int w, int lane, LAS unsigned char* VT) {
#pragma unroll
    for (int pp = 0; pp < 2; ++pp) { const int cc = 2 * w + pp; const v4u r = vr[pp];
        LAS unsigned short* tp = (LAS unsigned short*)(VT + (8 * cc) * GLP) + lane;
        tp[0 * (GLP / 2)] = (unsigned short)(r.x & 0xffffu); tp[1 * (GLP / 2)] = (unsigned short)(r.x >> 16); tp[2 * (GLP / 2)] = (unsigned short)(r.y & 0xffffu); tp[3 * (GLP / 2)] = (unsigned short)(r.y >> 16);
        tp[4 * (GLP / 2)] = (unsigned short)(r.z & 0xffffu); tp[5 * (GLP / 2)] = (unsigned short)(r.z >> 16); tp[6 * (GLP / 2)] = (unsigned short)(r.w & 0xffffu); tp[7 * (GLP / 2)] = (unsigned short)(r.w >> 16); }
}
DI void gla_stage_vt(unsigned char* wsq, size_t m0, int h, int w, int lane, LAS unsigned char* VT) { v4u vr[2]; gla_vt_ld(wsq, m0, h, w, lane, vr); gla_vt_st(vr, w, lane, VT); }
DI void gla_g1(Frame& F, int l) {
    unsigned char* const wsq = ws_opaque();
    gla_stage_wg(F, l);
    constexpr int UB = 64 * GLP + 128 * GLP;
    const int w = F.wave, lane = F.lane, r = lane & 31, hf = lane >> 5;
    for (int u0 = F.bid; u0 < 2048; u0 += 2 * F.G) {
#pragma unroll
        for (int p = 0; p < 2; ++p) {
            const int u = (p == 0 || u0 + F.G < 2048) ? u0 + p * F.G : u0;
            LAS unsigned char* KTT = F.lds + RING_OFF + p * UB; LAS unsigned char* VT = KTT + 64 * GLP;
            const int h = u & 3, n = (u >> 2) & 255, b = u >> 10; const size_t m0 = (size_t)b * SEQ + n * 64;
            float bcv[8], blv[8]; gla_gates(F, wsq, l, m0, h, w, lane, bcv, blv);
            { float kf[8]; unpack8(*(const v4u*)(((const bf16*)(wsq + WS_QKG)) + (m0 + lane) * 512 + 256 + h * 64 + 8 * w), kf);
#pragma unroll
              for (int e = 0; e < 8; ++e) ((LAS unsigned short*)(KTT + (8 * w + e) * GLP))[lane] = (unsigned short)f2bf(kf[e] * fexp(blv[e] - bcv[e]));
              if (lane == 0) {
#pragma unroll
                  for (int e = 0; e < 8; ++e) ((float*)(wsq + WS_DECAY))[u * 64 + 8 * w + e] = fexp(blv[e]); } }
            gla_stage_vt(wsq, m0, h, w, lane, VT);
        }
        __syncthreads();
        const int et = w >> 1, dt = w & 1;
#pragma unroll
        for (int p = 0; p < 2; ++p) {
            const int u = (p == 0 || u0 + F.G < 2048) ? u0 + p * F.G : u0;
            const LAS unsigned char* KTT = F.lds + RING_OFF + p * UB; const LAS unsigned char* VT = KTT + 64 * GLP;
            f32x16 acc;
#pragma unroll
            for (int i = 0; i < 16; ++i) acc[i] = 0.f;
#pragma unroll
            for (int ks = 0; ks < 4; ++ks) {
                const bf16x8 a = *(const LAS bf16x8*)(VT + (32 * et + r) * GLP + ks * 32 + hf * 16);
                const bf16x8 bq = *(const LAS bf16x8*)(KTT + (32 * dt + r) * GLP + ks * 32 + hf * 16);
                acc = MFMA32(a, bq, acc);
            }
            float* dst = ((float*)(wsq + WS_GLA)) + (size_t)u * 8192 + 32 * dt + r;
#pragma unroll
            for (int i = 0; i < 16; ++i) dst[(32 * et + crow(i, hf)) * 64] = acc[i];
        }
        __syncthreads();
    }
}
DI void gla_g2(Frame& F, const float* gbase, unsigned* sbase) {
    unsigned char* const wsq = ws_opaque();
    if (F.tid >= 256) return;
    for (int ch = F.bid * 256 + F.tid; ch < 65536; ch += F.G * 256) {
        const int d = ch & 63, e = (ch >> 6) & 127, h = (ch >> 13) & 3, b = ch >> 15;
        float st = 0.f;
        const float* gp = gbase + (size_t)((b * 256) * 4 + h) * 8192 + e * 64 + d;
        unsigned* sp = sbase + (((size_t)((b * 256) * 4 + h) * 8192 + e * 64 + d) >> 1);
        const float* dp = ((const float*)(wsq + WS_DECAY)) + ((b * 256) * 4 + h) * 64 + d;
        float dlA[16], dcA[16], dlB[16], dcB[16];
#pragma unroll
        for (int k = 0; k < 16; ++k) { dlA[k] = gp[(size_t)k * 32768]; dcA[k] = dp[k * 256]; }
        for (int n0 = 0; n0 < 256; n0 += 32) {
#pragma unroll
            for (int k = 0; k < 16; ++k) { dlB[k] = gp[(size_t)(n0 + 16 + k) * 32768]; dcB[k] = dp[(n0 + 16 + k) * 256]; }
#pragma unroll
            for (int k = 0; k < 16; ++k) { const float nb = __shfl_xor(st, 1); if ((d & 1) == 0) sp[(size_t)(n0 + k) * 16384] = cvtpk(st, nb); st = st * dcA[k] + dlA[k]; }
            if (n0 + 32 < 256) {
#pragma unroll
                for (int k = 0; k < 16; ++k) { dlA[k] = gp[(size_t)(n0 + 32 + k) * 32768]; dcA[k] = dp[(n0 + 32 + k) * 256]; }
            }
#pragma unroll
            for (int k = 0; k < 16; ++k) { const float nb = __shfl_xor(st, 1); if ((d & 1) == 0) sp[(size_t)(n0 + 16 + k) * 16384] = cvtpk(st, nb); st = st * dcB[k] + dlB[k]; }
        }
    }
}
DI bf16x8 f8_to_bf16x8(const f32x4 a, const f32x4 b) { v4u p; p.x = cvtpk(a.x, a.y); p.y = cvtpk(a.z, a.w); p.z = cvtpk(b.x, b.y); p.w = cvtpk(b.z, b.w); return __builtin_bit_cast(bf16x8, p); }
struct G3A { f32x4 gl4[4]; v4u qv, kv; v4u vr[2]; };
DI void gla_g3(Frame& F, int l, size_t out_off) {
    unsigned char* const wsq = ws_opaque();
    gla_stage_wg(F, l);
    constexpr int UB = 64 * GLP * 2 + 128 * GLP + 1024;
    const int w = F.wave, lane = F.lane, r = lane & 31, hf = lane >> 5;
    const float* gn = IN_gla_norm + (size_t)l * 128;
    const int et = w >> 1, it = w & 1, ii = 32 * it + r;
    auto unit_of = [&](int u0, int p) { return (p == 0 || u0 + F.G < 2048) ? u0 + p * F.G : u0; };
    auto loadA = [&](int u, G3A& x) { const int h = u & 3, n = (u >> 2) & 255, b = u >> 10; const size_t m0 = (size_t)b * SEQ + n * 64;
        gla_gates_ld(wsq, m0, lane, x.gl4);
        x.qv = *(const v4u*)(((const bf16*)(wsq + WS_QKG)) + (m0 + lane) * 512 + h * 64 + 8 * w); x.kv = *(const v4u*)(((const bf16*)(wsq + WS_QKG)) + (m0 + lane) * 512 + 256 + h * 64 + 8 * w);
        gla_vt_ld(wsq, m0, h, w, lane, x.vr); };
    auto loadB = [&](int u, bf16x8 (&sf)[4], u32x2_t (&rw)[4]) { const int h = u & 3, n = (u >> 2) & 255, b = u >> 10; const size_t m0 = (size_t)b * SEQ + n * 64;
        const bf16* sp = ((const bf16*)OUTP) + (size_t)u * 8192 + (32 * et + r) * 64 + 8 * hf;
#pragma unroll
        for (int ks = 0; ks < 4; ++ks) sf[ks] = *(const bf16x8*)(sp + 16 * ks);
#pragma unroll
        for (int q = 0; q < 4; ++q) rw[q] = *(const u32x2_t*)(((const bf16*)(wsq + WS_RG)) + (m0 + ii) * 512 + h * 128 + 32 * et + 8 * q + 4 * hf); };
    G3A in[2]; bf16x8 sf[2][4]; u32x2_t rw[2][4];
    if (F.bid < 2048) {
#pragma unroll
        for (int p = 0; p < 2; ++p) { loadA(unit_of(F.bid, p), in[p]); loadB(unit_of(F.bid, p), sf[p], rw[p]); } }
    for (int u0 = F.bid; u0 < 2048; u0 += 2 * F.G) {
        const int un = u0 + 2 * F.G; const bool has_next = un < 2048;
#pragma unroll
        for (int p = 0; p < 2; ++p) {
            const int u = unit_of(u0, p);
            LAS unsigned char* QS = F.lds + RING_OFF + p * UB; LAS unsigned char* KS = QS + 64 * GLP; LAS unsigned char* VT = KS + 64 * GLP;
            const int h = u & 3;
            float bcv[8], blv[8]; gla_gates_c(F, in[p].gl4, h, w, lane, bcv, blv);
            { float qv[8], kf[8];
              unpack8(in[p].qv, qv); unpack8(in[p].kv, kf);
              float qo[8], ko[8];
#pragma unroll
              for (int e = 0; e < 8; ++e) { qo[e] = qv[e] * 0.125f * fexp(bcv[e]); ko[e] = kf[e] * fexp(-bcv[e]); }
              v4u qp, kp; qp.x = cvtpk(qo[0], qo[1]); qp.y = cvtpk(qo[2], qo[3]); qp.z = cvtpk(qo[4], qo[5]); qp.w = cvtpk(qo[6], qo[7]);
              kp.x = cvtpk(ko[0], ko[1]); kp.y = cvtpk(ko[2], ko[3]); kp.z = cvtpk(ko[4], ko[5]); kp.w = cvtpk(ko[6], ko[7]);
              *(LAS v4u*)(QS + lane * GLP + 16 * w) = qp; *(LAS v4u*)(KS + lane * GLP + 16 * w) = kp; }
            gla_vt_st(in[p].vr, w, lane, VT);
        }
        if (has_next) {
#pragma unroll
            for (int p = 0; p < 2; ++p) loadA(unit_of(un, p), in[p]); }
        LDS_BARRIER();
        f32x16 acc[2];
#pragma unroll
        for (int p = 0; p < 2; ++p) {
            const LAS unsigned char* QS = F.lds + RING_OFF + p * UB; const LAS unsigned char* KS = QS + 64 * GLP; const LAS unsigned char* VT = KS + 64 * GLP; LAS float* red = (LAS float*)(VT + 128 * GLP);
            bf16x8 qf[4];
#pragma unroll
            for (int ks = 0; ks < 4; ++ks) qf[ks] = *(const LAS bf16x8*)(QS + (32 * it + r) * GLP + ks * 32 + hf * 16);
#pragma unroll
            for (int i = 0; i < 16; ++i) acc[p][i] = 0.f;
#pragma unroll
            for (int ks = 0; ks < 4; ++ks) acc[p] = MFMA32(sf[p][ks], qf[ks], acc[p]);
#pragma unroll
            for (int jt = 0; jt < 2; ++jt) {
                if (jt <= it) {
                    f32x16 X;
#pragma unroll
                    for (int i = 0; i < 16; ++i) X[i] = 0.f;
#pragma unroll
                    for (int ks = 0; ks < 4; ++ks) { const bf16x8 a = *(const LAS bf16x8*)(KS + (32 * jt + r) * GLP + ks * 32 + hf * 16); X = MFMA32(a, qf[ks], X); }
                    if (jt == it) {
#pragma unroll
                        for (int i = 0; i < 16; ++i) X[i] = (crow(i, hf) <= r) ? X[i] : 0.f;
                    }
                    const LAS unsigned char* vr = VT + (32 * et + r) * GLP + (32 * jt + 4 * hf) * 2;
                    { const u32x2_t lo = *(const LAS u32x2_t*)vr, hi = *(const LAS u32x2_t*)(vr + 16); const v4u av = {lo.x, lo.y, hi.x, hi.y}; acc[p] = MFMA32(__builtin_bit_cast(bf16x8, av), pack8<0>(X), acc[p]); }
                    { const u32x2_t lo = *(const LAS u32x2_t*)(vr + 32), hi = *(const LAS u32x2_t*)(vr + 48); const v4u av = {lo.x, lo.y, hi.x, hi.y}; acc[p] = MFMA32(__builtin_bit_cast(bf16x8, av), pack8<1>(X), acc[p]); }
                }
            }
            float ss = 0.f;
#pragma unroll
            for (int i = 0; i < 16; ++i) ss += acc[p][i] * acc[p][i];
            ss += __shfl_xor(ss, 32);
            if (hf == 0) red[et * 64 + 32 * it + r] = ss;
        }
        LDS_BARRIER();
#pragma unroll
        for (int p = 0; p < 2; ++p) {
            const int u = unit_of(u0, p);
            const LAS float* red = (const LAS float*)(F.lds + RING_OFF + p * UB + 64 * GLP * 2 + 128 * GLP);
            const int h = u & 3, n = (u >> 2) & 255, b = u >> 10; const size_t m0 = (size_t)b * SEQ + n * 64;
            const float tot = (red[ii] + red[64 + ii]) + (red[128 + ii] + red[192 + ii]);
            const float rs = 1.0f / sqrtf(tot * (1.0f / 128.0f) + EPS);
#pragma unroll
            for (int q = 0; q < 4; ++q) {
                const int e0 = 32 * et + 8 * q + 4 * hf;
                const size_t idx = (m0 + ii) * 512 + h * 128 + e0;
                const u32x2_t rwv = rw[p][q];
                const f32x4 g4 = *(const f32x4*)(gn + e0);
                const float r0 = pg8::bf_lo(rwv.x), r1 = pg8::bf_hi(rwv.x), r2 = pg8::bf_lo(rwv.y), r3 = pg8::bf_hi(rwv.y);
                const float y0 = acc[p][4 * q] * rs * g4.x * (r0 * __builtin_amdgcn_rcpf(1.0f + fexp(-r0))), y1 = acc[p][4 * q + 1] * rs * g4.y * (r1 * __builtin_amdgcn_rcpf(1.0f + fexp(-r1)));
                const float y2 = acc[p][4 * q + 2] * rs * g4.z * (r2 * __builtin_amdgcn_rcpf(1.0f + fexp(-r2))), y3 = acc[p][4 * q + 3] * rs * g4.w * (r3 * __builtin_amdgcn_rcpf(1.0f + fexp(-r3)));
                u32x2_t o; o.x = cvtpk(y0, y1); o.y = cvtpk(y2, y3);
                *(u32x2_t*)(((bf16*)(wsq + out_off)) + idx) = o;
            }
        }
        if (has_next) {
#pragma unroll
            for (int p = 0; p < 2; ++p) loadB(unit_of(un, p), sf[p], rw[p]); }
        LDS_BARRIER();
    }
}

struct Args { const void* in[23]; float* out; unsigned char* ws; };
#define PG8_SP2 true
#define PG8_ALIGN true
constexpr int RSTD_TAB_OFF = RING_OFF + pg8::STAGE_BYTES;
static_assert(RSTD_TAB_OFF + pg8::RSTD_CAP * 1024 <= LDS_BYTES, "rstd table");
DI pg8::RstdTab rstd_prep(Frame& F, const pg8::StaticOrder& S, const float* ssq) {
    LAS float* tab = (LAS float*)(F.lds + RSTD_TAB_OFF);
    const int r = F.tid & 255, i0 = F.tid >> 8;
    float v[pg8::RSTD_CAP / 2];
#pragma unroll
    for (int k = 0; k < pg8::RSTD_CAP / 2; ++k) { pg8::Unit u; const bool ok = S.next(2 * k + i0, u); v[k] = pg8::row_rstd(ssq, ok ? (size_t)u.pm * 256 + r : (size_t)r); }
#pragma unroll
    for (int k = 0; k < pg8::RSTD_CAP / 2; ++k) tab[(2 * k + i0) * 256 + r] = v[k];
    __syncthreads();
    return pg8::RstdTab{(const LAS float*)tab};
}
__global__ void __launch_bounds__(NWAVES * 64, 2) mk_fwd(Args args) {
    extern __shared__ __attribute__((aligned(16))) unsigned char lds[];
    Frame F;
    F.lds = (LAS unsigned char*)lds;
    F.MISC = (volatile LAS unsigned*)(F.lds + MISC_OFF);
    F.tid = threadIdx.x; F.lane = F.tid & 63; F.wave = __builtin_amdgcn_readfirstlane(F.tid >> 6);
    F.G = gridDim.x; F.bid = blockIdx.x;
    unsigned char* wsq = ws_opaque();
    F.ctl = (gu32*)(wsq + WS_CTL);
    if (F.tid < 256) ((LAS unsigned*)(F.lds + LDSCTL_OFF))[F.tid] = 0u;
    __syncthreads();
    (void)xcd_barrier_post((unsigned*)(F.ctl + CW_BAR), F.MISC + 8);
#define NBAR_ 1
#define TS_REC() do {} while (0)
#define GRID_BAR() do { for (int nb_ = 0; nb_ < NBAR_; ++nb_) { XcdBarrier bb_; bb_.bar = (unsigned*)((gu32*)(ws_opaque() + WS_CTL) + CW_BAR); bb_.x = xb_xcc_id(); bb_.st = F.MISC + 8; xcd_barrier(bb_); } wsq = ws_opaque(); asm volatile("" : "+v"(F.tid)); F.lane = F.tid & 63; F.wave = __builtin_amdgcn_readfirstlane(F.tid >> 6); TS_REC(); } while (0)
    using pg8::Gemm; using pg8::StaticOrder; using pg8::gemm_phase;
    int ts_n = 0; (void)ts_n;
    TS_REC();
    const int bid = (int)blockIdx.x;

    p0_prologue(F);
    cast_rows_bf16(F, IN_x, ((bf16*)(wsq + WS_A16)), ((float*)(wsq + WS_SSQ0)));
    GRID_BAR();
    for (int l = 0; l < DEPTH; ++l) {
        { Gemm g{((bf16*)(wsq + WS_A16)), wptr(F, l, W_IN), M, NIN, D}; StaticOrder S; S.init(M, NIN, F.G, bid);
          for (S.cnt = pg8::RSTD_CAP; ; S.i0 += pg8::RSTD_CAP) { pg8::Unit u0; if (!S.next(0, u0)) break;
          pg8::EpiProj E{((bf16*)(wsq + WS_U)), ((bf16*)(wsq + WS_Q)), ((bf16*)(wsq + WS_KV)), ((bf16*)(wsq + WS_QKG)), ((bf16*)(wsq + WS_VG)), ((bf16*)(wsq + WS_RG)), ((float*)(wsq + WS_SMALL)), ((float*)(wsq + WS_ROPE)), rstd_prep(F, S, (const float*)(wsq + WS_SSQ0)), M, ((bf16*)(wsq + WS_VST)), ((bf16*)(wsq + WS_VWT)), SEQ};
          gemm_phase<pg8::EpiProj, StaticOrder, PG8_ALIGN, PG8_SP2>(F.lds + RING_OFF, g, S, E, F.tid); } }
        GRID_BAR();
        pool_phase(F); compress_phase(F, l); gla_g1(F, l);
        GRID_BAR();
        gla_g2(F, (const float*)(wsq + WS_GLA), (unsigned*)OUTP);
        nsa_phase(F, WS_Q);
        GRID_BAR();
        gla_g3(F, l, WS_RG);
        GRID_BAR();
        { pg8::GateBranchOrder S; S.init(M, D, F.G, bid);
          pg8::Gemm2 g{{((bf16*)(wsq + WS_A16)), ((bf16*)(wsq + WS_POOLED))}, {wptr(F, l, W_GM), wptr(F, l, W_BR)}, {D, 512}};
          bf16* const gtile = ((bf16*)(wsq + WS_GM)) + (size_t)F.bid * 131072;
          pg8::EpiSigN E0{gtile, NGM, rstd_prep(F, S.S0, (const float*)(wsq + WS_SSQ0))};
          pg8::EpiBranchR E1{((bf16*)(wsq + WS_MG)), gtile, gtile + 65536, M / 256};
          pg8::gemm_stream2<pg8::EpiSigN, pg8::EpiBranchR, pg8::GateBranchOrder>(F.lds + RING_OFF, g, S, E0, E1, F.tid); }
        GRID_BAR();
        { Gemm g{((bf16*)(wsq + WS_MG)), wptr(F, l, W_O), M, D, D}; StaticOrder S; S.init(M, D, F.G, bid);
          pg8::EpiStream<0, false> E{((bf16*)(wsq + WS_A16)), nullptr, ((float*)(wsq + WS_SSQ1)), pg8::RstdTab{nullptr}, nullptr};
          gemm_phase<pg8::EpiStream<0, false>, StaticOrder, PG8_ALIGN, PG8_SP2>(F.lds + RING_OFF, g, S, E, F.tid); }
        GRID_BAR();
        { Gemm g{((bf16*)(wsq + WS_A16)), wptr(F, l, W_1), M, FF, D}; StaticOrder S; S.init(M, FF, F.G, bid);
          for (S.cnt = pg8::RSTD_CAP; ; S.i0 += pg8::RSTD_CAP) { pg8::Unit u0; if (!S.next(0, u0)) break;
          pg8::EpiRelu2N E{((bf16*)(wsq + WS_HID)), FF, rstd_prep(F, S, (const float*)(wsq + WS_SSQ1))};
          gemm_phase<pg8::EpiRelu2N, StaticOrder, PG8_ALIGN, PG8_SP2>(F.lds + RING_OFF, g, S, E, F.tid); } }
        cvt_p16(F, l);
        GRID_BAR();
        { Gemm g{((bf16*)(wsq + WS_HID)), wptr(F, l, W_2), M, D, FF}; StaticOrder S; S.init(M, D, F.G, bid);
          pg8::EpiStream<0, true> E{((bf16*)(wsq + WS_A16)), ((bf16*)(wsq + WS_HB2)), ((float*)(wsq + WS_SSQ2)), pg8::RstdTab{nullptr}, nullptr};
          gemm_phase<pg8::EpiStream<0, true>, StaticOrder, PG8_ALIGN, PG8_SP2>(F.lds + RING_OFF, g, S, E, F.tid); }
        GRID_BAR();
        { pg8::PlePairOrder S; S.init(M, D, F.G, bid);
          int kp = PLE; asm volatile("" : "+s"(kp));
          pg8::Gemm2 g{{((bf16*)(wsq + WS_P16)), ((bf16*)(wsq + WS_HB2))}, {wptr(F, l, W_PP), wptr(F, l, W_PG)}, {kp, D}};
          bf16* const ptile = ((bf16*)(wsq + WS_GM)) + (size_t)F.bid * 131072;
          pg8::EpiTile E0{ptile};
          pg8::EpiStream<1, true> E1{((bf16*)(wsq + WS_HB2)), ((bf16*)(wsq + WS_A16)), ((float*)(wsq + WS_SSQ0)), rstd_prep(F, S.S0, (const float*)(wsq + WS_SSQ2)), ptile};
          pg8::gemm_stream2<pg8::EpiTile, pg8::EpiStream<1, true>, pg8::PlePairOrder>(F.lds + RING_OFF, g, S, E0, E1, F.tid); }
        GRID_BAR();
    }
    final_norm(F, ((const bf16*)(wsq + WS_A16)), ((const float*)(wsq + WS_SSQ0)), IN_norm_final, OUTP);
}

extern "C" void kernel_launch(void* const* d_in, const int* in_sizes, int n_in, void* d_out, int out_size, void* d_ws, size_t ws_size, hipStream_t stream) {
    static int grid = 0;
    if (grid == 0) {
        if (n_in != 23 || out_size != M * D || ws_size < WS_END) { fprintf(stderr, "kernel_launch: unexpected problem (n_in %d, out %d, ws %zu)\n", n_in, out_size, ws_size); grid = -1; return; }
        int dev = 0, cus = 0, per_cu = 0;
        if (hipGetDevice(&dev) != hipSuccess || hipDeviceGetAttribute(&cus, hipDeviceAttributeMultiprocessorCount, dev) != hipSuccess) { grid = -1; return; }
        if (hipFuncSetAttribute((const void*)mk_fwd, hipFuncAttributeMaxDynamicSharedMemorySize, LDS_BYTES) != hipSuccess) { fprintf(stderr, "kernel_launch: hipFuncSetAttribute failed\n"); grid = -1; return; }
        if (hipOccupancyMaxActiveBlocksPerMultiprocessor(&per_cu, (const void*)mk_fwd, NWAVES * 64, LDS_BYTES) != hipSuccess || per_cu < 1) fprintf(stderr, "kernel_launch: occupancy query reports %d\n", per_cu);
        (void)hipGetLastError();
        if ((M / 256) * (D / 256) > cus * pg8::RSTD_CAP) { fprintf(stderr, "kernel_launch: %d CUs: a workgroup's deal of output tiles exceeds the rstd table\n", cus); grid = -1; return; }
        grid = cus;
    }
    if (grid < 0) return;
    if (hipMemsetAsync((char*)d_ws + WS_CTL, 0, CTL_ZERO_BYTES, stream) != hipSuccess) return;
    Args a{};
    for (int i = 0; i < 23; ++i) a.in[i] = d_in[i];
    a.out = (float*)d_out; a.ws = (unsigned char*)d_ws;
    hipLaunchKernelGGL(mk_fwd, dim3(grid), dim3(NWAVES * 64), LDS_BYTES, stream, a);
}
```
